# Optimizing an MI355X kernel written in HIP

```python
import math
import jax, jax.numpy as jnp
from jax import lax
import numpy as np

D_MODEL = 2048
BATCH = 4
SEQ = 2048
DEPTH = 1

MEM_LEN = 256
MIX_WIDTH = D_MODEL
MLA_HEADS = 8
QK_NOPE_DIM = 128
QK_ROPE_DIM = 64
V_HEAD_DIM = 128
Q_LORA_RANK = 384
KV_LORA_RANK = 256
ROPE_THETA = 10000.0
Q_BLOCK = 128
SSM_WIDTH = MIX_WIDTH - MLA_HEADS * V_HEAD_DIM
SSM_GROUP = 16
SSM_GROUPS = SSM_WIDTH // SSM_GROUP
SSM_STATE = 64
DT_MIN = 0.001
DT_MAX = 0.1
XATTN_HEADS = 4
XATTN_HEAD_DIM = D_MODEL // XATTN_HEADS
N_EXPERTS = 32
TOP_K = 4
D_FF = D_MODEL
SWIGLU_LIMIT = 7.0
SWIGLU_ALPHA = 1.702
EXPERT_BLOCK = 256
EPS = 1e-6
COL_Q = Q_LORA_RANK
COL_KV = COL_Q + KV_LORA_RANK
COL_KPE = COL_KV + QK_ROPE_DIM
IN_COLS = COL_KPE + SSM_WIDTH

kernel_name = 'hymba_mla_s5_xattn_moe_block'


def rms_norm(x, g):
    xf = x.astype(jnp.float32)
    xf = xf * lax.rsqrt(jnp.mean(xf * xf, axis=-1, keepdims=True) + EPS)
    return (xf * g.astype(jnp.float32)).astype(x.dtype)


def rope(x, cos, sin):
    x1, x2 = jnp.split(x.astype(jnp.float32), 2, axis=-1)
    return jnp.concatenate([x1 * cos - x2 * sin, x2 * cos + x1 * sin], axis=-1).astype(x.dtype)


def mla_group(c_q, c_kv, k_pe, positions, q_a_norm, w_q_b, kv_a_norm, w_kv_b):
    B, S, _ = c_q.shape
    H = MLA_HEADS
    q = (rms_norm(c_q, q_a_norm) @ w_q_b).reshape(B, S, H, QK_NOPE_DIM + QK_ROPE_DIM)
    q_nope, q_pe = q[..., :QK_NOPE_DIM], q[..., QK_NOPE_DIM:]
    kv = (rms_norm(c_kv, kv_a_norm) @ w_kv_b).reshape(B, S, H, QK_NOPE_DIM + V_HEAD_DIM)
    k_nope, v = kv[..., :QK_NOPE_DIM], kv[..., QK_NOPE_DIM:]
    inv_freq = 1.0 / (ROPE_THETA ** (jnp.arange(0, QK_ROPE_DIM, 2, dtype=jnp.float32) / QK_ROPE_DIM))
    ang = positions.astype(jnp.float32)[..., None] * inv_freq
    cos, sin = jnp.cos(ang), jnp.sin(ang)
    q_pe = rope(q_pe, cos[:, :, None, :], sin[:, :, None, :])
    k_pe = rope(k_pe, cos, sin)
    scale = (QK_NOPE_DIM + QK_ROPE_DIM) ** -0.5
    nb = S // Q_BLOCK

    def to_blocks(t):
        return t.reshape(B, nb, Q_BLOCK, H, t.shape[-1]).transpose(1, 0, 3, 2, 4)

    k_idx = jnp.arange(S)

    def block_attn(args):
        qn, qp, blk = args
        s = (jnp.einsum('bhqd,bkhd->bhqk', qn, k_nope)
             + jnp.einsum('bhqd,bkd->bhqk', qp, k_pe)).astype(jnp.float32) * scale
        q_idx = blk * Q_BLOCK + jnp.arange(Q_BLOCK)
        s = jnp.where(q_idx[:, None] >= k_idx[None, :], s, -jnp.inf)
        p = jax.nn.softmax(s, axis=-1).astype(v.dtype)
        return jnp.einsum('bhqk,bkhd->bhqd', p, v)

    o = lax.map(block_attn, (to_blocks(q_nope), to_blocks(q_pe), jnp.arange(nb)))
    return o.transpose(1, 0, 3, 2, 4).reshape(B, S, H * V_HEAD_DIM)


def _cscan_op(e1, e2):
    a1r, a1i, b1r, b1i = e1
    a2r, a2i, b2r, b2i = e2
    ar = a2r * a1r - a2i * a1i
    ai = a2r * a1i + a2i * a1r
    br = a2r * b1r - a2i * b1i + b2r
    bi = a2r * b1i + a2i * b1r + b2i
    return (ar, ai, br, bi)


def s5_group(u, lam_re, lam_im, log_dt, b_re, b_im, c_re, c_im, d_skip, w_glu, b_glu):
    B, S, _ = u.shape
    uf = u.astype(jnp.float32)
    lr = lam_re.astype(jnp.float32)
    li = lam_im.astype(jnp.float32)
    dt = jnp.exp(log_dt.astype(jnp.float32))[:, None]
    mag = jnp.exp(lr * dt)
    ab_re = mag * jnp.cos(li * dt)
    ab_im = mag * jnp.sin(li * dt)
    nr, ni = ab_re - 1.0, ab_im
    den = lr * lr + li * li
    coef_re = (nr * lr + ni * li) / den
    coef_im = (ni * lr - nr * li) / den
    br = b_re.astype(jnp.float32)
    bim = b_im.astype(jnp.float32)
    bb_re = coef_re[..., None] * br - coef_im[..., None] * bim
    bb_im = coef_re[..., None] * bim + coef_im[..., None] * br
    ug = uf.reshape(B, S, SSM_GROUPS, SSM_GROUP)
    bu_re = jnp.einsum('bsgc,gpc->bsgp', ug, bb_re)
    bu_im = jnp.einsum('bsgc,gpc->bsgp', ug, bb_im)
    a_re = jnp.broadcast_to(ab_re, bu_re.shape)
    a_im = jnp.broadcast_to(ab_im, bu_re.shape)
    _, _, x_re, x_im = lax.associative_scan(_cscan_op, (a_re, a_im, bu_re, bu_im), axis=1)
    y = (jnp.einsum('bsgp,gcp->bsgc', x_re, c_re.astype(jnp.float32))
         - jnp.einsum('bsgp,gcp->bsgc', x_im, c_im.astype(jnp.float32)))
    y = y.reshape(B, S, SSM_WIDTH) + d_skip.astype(jnp.float32) * uf
    y = jax.nn.gelu(y).astype(u.dtype)
    gate = jax.nn.sigmoid((y @ w_glu + b_glu).astype(jnp.float32)).astype(u.dtype)
    return y * gate


def cross_attn(h, mem_n, w_xq, w_xk, w_xv, w_xo):
    B, S, D = h.shape
    M = mem_n.shape[1]
    q = (h @ w_xq).reshape(B, S, XATTN_HEADS, XATTN_HEAD_DIM)
    k = (mem_n @ w_xk).reshape(B, M, XATTN_HEADS, XATTN_HEAD_DIM)
    v = (mem_n @ w_xv).reshape(B, M, XATTN_HEADS, XATTN_HEAD_DIM)
    s = jnp.einsum('bqhd,bkhd->bhqk', q, k).astype(jnp.float32) * XATTN_HEAD_DIM ** -0.5
    p = jax.nn.softmax(s, axis=-1).astype(v.dtype)
    o = jnp.einsum('bhqk,bkhd->bqhd', p, v).reshape(B, S, D)
    return o @ w_xo


def moe(xn, w_router, b_router, w_up, b_up, w_down, b_down):
    B, S, D = xn.shape
    T = B * S
    TK = T * TOP_K
    xt = xn.reshape(T, D)
    logits = (xt @ w_router + b_router).astype(jnp.float32)
    top_val, top_idx = lax.top_k(logits, TOP_K)
    gates = jax.nn.softmax(top_val, axis=-1)
    flat_e = top_idx.reshape(TK)
    flat_g = gates.reshape(TK)
    flat_tok = jnp.arange(TK, dtype=jnp.int32) // TOP_K
    order = jnp.argsort(flat_e)
    sorted_e = flat_e[order]
    counts = jnp.bincount(flat_e, length=N_EXPERTS)
    padded = (counts + EXPERT_BLOCK - 1) // EXPERT_BLOCK * EXPERT_BLOCK
    pad_end = jnp.cumsum(padded)
    pad_start = pad_end - padded
    start = jnp.cumsum(counts) - counts
    dest = pad_start[sorted_e] + jnp.arange(TK, dtype=jnp.int32) - start[sorted_e]
    n_blocks = -(-TK // EXPERT_BLOCK) + N_EXPERTS
    n_slots = n_blocks * EXPERT_BLOCK
    slot_tok = jnp.full((n_slots,), T, jnp.int32).at[dest].set(flat_tok[order])
    slot_gate = jnp.zeros((n_slots,), jnp.float32).at[dest].set(flat_g[order])
    block_e = jnp.minimum(
        jnp.searchsorted(pad_end, jnp.arange(n_blocks) * EXPERT_BLOCK, side='right'),
        N_EXPERTS - 1)
    x_pad = jnp.concatenate([xt, jnp.zeros((1, D), xt.dtype)], axis=0)

    def expert_block(args):
        tok, e = args
        xb = x_pad[tok]
        hu = (xb @ w_up[e] + b_up[e]).astype(jnp.float32)
        glu = jnp.minimum(hu[:, :D_FF], SWIGLU_LIMIT)
        lin = jnp.clip(hu[:, D_FF:], -SWIGLU_LIMIT, SWIGLU_LIMIT)
        act = (glu * jax.nn.sigmoid(SWIGLU_ALPHA * glu) * (lin + 1.0)).astype(xb.dtype)
        return act @ w_down[e] + b_down[e]

    out = lax.map(expert_block, (slot_tok.reshape(n_blocks, EXPERT_BLOCK), block_e))
    weighted = out.reshape(n_slots, D).astype(jnp.float32) * slot_gate[:, None]
    y = jnp.zeros((T + 1, D), jnp.float32).at[slot_tok].add(weighted)
    return y[:T].reshape(B, S, D).astype(xn.dtype)


def setup_inputs(seed: int = 0) -> dict:
    key = jax.random.key(seed)
    ks = jax.random.split(key, 40)
    f32 = jnp.float32
    L, D, G, P, C = DEPTH, D_MODEL, SSM_GROUPS, SSM_STATE, SSM_GROUP

    def w(k, shape, fan_in):
        return jax.random.normal(k, shape, f32) * fan_in ** -0.5

    def gain(k, shape):
        return 1.0 + 0.02 * jax.random.normal(k, shape, f32)

    def small(k, shape):
        return 0.01 * jax.random.normal(k, shape, f32)

    x = jax.random.normal(ks[0], (BATCH, SEQ, D), f32)
    mem = jax.random.normal(ks[1], (BATCH, MEM_LEN, D), f32)
    offsets = jax.random.randint(ks[2], (BATCH, 1), 0, 1024, dtype=jnp.int32)
    positions = (offsets + jnp.arange(SEQ, dtype=jnp.int32)[None, :]).astype(jnp.int32)
    lam_re = -0.5 + 0.01 * jax.random.normal(ks[8], (L, G, P), f32)
    lam_im = math.pi * jnp.arange(P, dtype=f32)[None, None, :] + 0.01 * jax.random.normal(ks[9], (L, G, P), f32)
    log_dt = jax.random.uniform(ks[10], (L, G), f32, math.log(DT_MIN), math.log(DT_MAX))
    return {
        'x': x,
        'mem': mem,
        'positions': positions,
        'attn_norm': gain(ks[3], (L, D)),
        'w_in': w(ks[4], (L, D, IN_COLS), D),
        'q_a_norm': gain(ks[5], (L, Q_LORA_RANK)),
        'w_q_b': w(ks[6], (L, Q_LORA_RANK, MLA_HEADS * (QK_NOPE_DIM + QK_ROPE_DIM)), Q_LORA_RANK),
        'kv_a_norm': gain(ks[7], (L, KV_LORA_RANK)),
        'w_kv_b': w(ks[11], (L, KV_LORA_RANK, MLA_HEADS * (QK_NOPE_DIM + V_HEAD_DIM)), KV_LORA_RANK),
        'ssm_lambda_re': lam_re,
        'ssm_lambda_im': lam_im,
        'ssm_log_dt': log_dt,
        'ssm_b_re': w(ks[12], (L, G, P, C), 2 * C),
        'ssm_b_im': w(ks[13], (L, G, P, C), 2 * C),
        'ssm_c_re': w(ks[14], (L, G, C, P), 2 * P),
        'ssm_c_im': w(ks[15], (L, G, C, P), 2 * P),
        'ssm_d': 0.1 * jax.random.normal(ks[16], (L, SSM_WIDTH), f32),
        'w_glu': w(ks[17], (L, SSM_WIDTH, SSM_WIDTH), SSM_WIDTH),
        'b_glu': small(ks[18], (L, SSM_WIDTH)),
        'mix_norm_attn': gain(ks[19], (L, MLA_HEADS * V_HEAD_DIM)),
        'mix_norm_ssm': gain(ks[20], (L, SSM_WIDTH)),
        'w_out': w(ks[21], (L, MIX_WIDTH, D), MIX_WIDTH),
        'xattn_norm': gain(ks[22], (L, D)),
        'mem_norm': gain(ks[23], (L, D)),
        'w_xq': w(ks[24], (L, D, D), D),
        'w_xk': w(ks[25], (L, D, D), D),
        'w_xv': w(ks[26], (L, D, D), D),
        'w_xo': w(ks[27], (L, D, D), D),
        'ffn_norm': gain(ks[28], (L, D)),
        'w_router': w(ks[29], (L, D, N_EXPERTS), D),
        'b_router': small(ks[30], (L, N_EXPERTS)),
        'w_up': w(ks[31], (L, N_EXPERTS, D, 2 * D_FF), D),
        'b_up': small(ks[32], (L, N_EXPERTS, 2 * D_FF)),
        'w_down': w(ks[33], (L, N_EXPERTS, D_FF, D), D_FF),
        'b_down': small(ks[34], (L, N_EXPERTS, D)),
        'final_norm': gain(ks[35], (D,)),
    }


def reference(x, mem, positions, attn_norm, w_in, q_a_norm, w_q_b, kv_a_norm, w_kv_b,
              ssm_lambda_re, ssm_lambda_im, ssm_log_dt, ssm_b_re, ssm_b_im, ssm_c_re, ssm_c_im,
              ssm_d, w_glu, b_glu, mix_norm_attn, mix_norm_ssm, w_out,
              xattn_norm, mem_norm, w_xq, w_xk, w_xv, w_xo,
              ffn_norm, w_router, b_router, w_up, b_up, w_down, b_down, final_norm):
    for l in range(DEPTH):
        h = rms_norm(x, attn_norm[l])
        proj = h @ w_in[l]
        c_q = proj[..., :COL_Q]
        c_kv = proj[..., COL_Q:COL_KV]
        k_pe = proj[..., COL_KV:COL_KPE]
        u = proj[..., COL_KPE:]
        attn_o = mla_group(c_q, c_kv, k_pe, positions, q_a_norm[l], w_q_b[l], kv_a_norm[l], w_kv_b[l])
        ssm_o = s5_group(u, ssm_lambda_re[l], ssm_lambda_im[l], ssm_log_dt[l], ssm_b_re[l], ssm_b_im[l],
                         ssm_c_re[l], ssm_c_im[l], ssm_d[l], w_glu[l], b_glu[l])
        mixed = jnp.concatenate([rms_norm(attn_o, mix_norm_attn[l]), rms_norm(ssm_o, mix_norm_ssm[l])], axis=-1)
        x = x + mixed @ w_out[l]
        x = x + cross_attn(rms_norm(x, xattn_norm[l]), rms_norm(mem, mem_norm[l]),
                           w_xq[l], w_xk[l], w_xv[l], w_xo[l])
        x = x + moe(rms_norm(x, ffn_norm[l]), w_router[l], b_router[l], w_up[l], b_up[l], w_down[l], b_down[l])
    return rms_norm(x, final_norm)
```

```cpp
#include <hip/hip_runtime.h>
#include <cstdio>
#include <cstdint>

constexpr int D = 2048, BATCH = 4, SEQ = 2048, T = BATCH * SEQ;
constexpr int MEM = 256, TM = BATCH * MEM;
constexpr int H = 8, DN = 128, DR = 64, DV = 128, QL = 384, KVL = 256;
constexpr int SSMW = 1024, G = 64, P = 64, C = 16;
constexpr int XH = 4, XD = 512;
constexpr int E = 32, TOPK = 4, FF = 2048;
constexpr int INC = 1728, INCP = 1792;
constexpr int PJW = 704;
constexpr int LCH = 32, NCH = SEQ / LCH;
constexpr int AGW = 640;
constexpr float EPS = 1e-6f;

__device__ __forceinline__ int lane_id_now() { unsigned z = 0u; asm volatile("" : "+v"(z)); return (int)__builtin_amdgcn_mbcnt_hi(~0u, __builtin_amdgcn_mbcnt_lo(~0u, z)); }
namespace pg8 {
#define PG8_LAS __attribute__((address_space(3)))
typedef unsigned short bf16_t;
typedef short bf16x8 __attribute__((ext_vector_type(8)));
typedef float f32x4 __attribute__((ext_vector_type(4)));
typedef float f32x2 __attribute__((ext_vector_type(2)));
typedef unsigned u32x4 __attribute__((ext_vector_type(4)));
typedef unsigned u32x2 __attribute__((ext_vector_type(2)));
constexpr int BM = 256, BK = 64, HALF = 128, HTB = HALF * BK * 2  , STAGE_BYTES = 8 * HTB, NXCD = 8, WGM = 8;

__host__ __device__ __forceinline__ int lds_byte(int r, int c) { const int st = (r >> 4) * 2 + (c >> 5), rr = r & 15, cc = c & 31, ob = rr * 64 + cc * 2; return st * 1024 + (ob ^ (((ob >> 9) & 1) << 5)); }
__host__ __device__ __forceinline__ void stage_rc(int b, int& R, int& C) { const int st = b / 1024, sb = b % 1024, swz = sb ^ (((sb >> 9) & 1) << 5); R = (st >> 1) * 16 + swz / 64; C = (st & 1) * 32 + (swz % 64) / 2; }
__host__ __device__ __forceinline__ int perm32(int rho) { const int n = rho >> 4, i = rho & 15; return 8 * (i >> 2) + 4 * n + (i & 3); }

struct Unit { int pm, pn, z; };
struct Geo { int lda, ldb; long hstepA, hstepB; int nt; };

struct Sched {
    int nM, nN, nZ, total, G, c, mode, zdiv;
    const char* A; const char* B; long tA, tB, zA, zB, zA2, zB2;
    __device__ __forceinline__ void init(int mode_, int nM_, int nN_, int nZ_, int G_, int c_, const void* A_, long tA_, long zA_, const void* B_, long tB_, long zB_) {
        mode = mode_; nM = nM_; nN = nN_; nZ = nZ_; total = nM_ * nN_ * nZ_; G = G_; c = c_; A = (const char*)A_; B = (const char*)B_; tA = tA_; tB = tB_; zA = zA_; zB = zB_; zdiv = 1 << 30; zA2 = 0; zB2 = 0; }
    __device__ __forceinline__ void split_z(int zdiv_, long zA2_, long zB2_) { zdiv = zdiv_; zA2 = zA2_; zB2 = zB2_; }
    __device__ __forceinline__ bool next(int i, Unit& u) const {
        const long L = (long)i * G + c; if (L >= total) return false;
        if (mode == 0) {
            int wgid = (int)L; { const int q = total / NXCD, r = total % NXCD, xcd = wgid % NXCD, off = wgid / NXCD; wgid = (xcd < r ? xcd * (q + 1) : r * (q + 1) + (xcd - r) * q) + off; }
            const int nig = WGM * nN, gid = wgid / nig, fm = gid * WGM, gsz = (nM - fm) < WGM ? (nM - fm) : WGM;
            u.pm = fm + ((wgid % nig) % gsz); u.pn = (wgid % nig) / gsz; u.z = 0;
        } else { const int l = (int)L; u.pn = l % nN; u.pm = (l / nN) % nM; u.z = l / (nN * nM); }
        return true;
    }
    __device__ __forceinline__ void ptrs(const Unit& u, const char*& a, const char*& b) const { const int z1 = (zdiv == (1 << 30)) ? u.z : u.z / zdiv, z2 = (zdiv == (1 << 30)) ? 0 : u.z % zdiv;
        a = A + (long)z1 * zA + (long)z2 * zA2 + (long)u.pm * tA; b = B + (long)z1 * zB + (long)z2 * zB2 + (long)u.pn * tB; }
    static constexpr bool GATHER = false;
    __device__ __forceinline__ bool half1(const Unit&) const { return true; }
    __device__ __forceinline__ unsigned row_off(int, int) const { return 0u; }
    __device__ __forceinline__ void a_ready(const Unit&) const {}
    __device__ __forceinline__ void done(const Unit&) const {}
};
template <class E, class = void> struct epi_fp8 { static constexpr bool v = false; };
template <class E> struct epi_fp8<E, decltype((void)E::FP8)> { static constexpr bool v = E::FP8; };
typedef int i32x4 __attribute__((ext_vector_type(4)));
typedef int i32x8 __attribute__((ext_vector_type(8)));
__device__ __forceinline__ unsigned cvt_pk_bf16(float lo, float hi) { unsigned r; asm volatile("v_cvt_pk_bf16_f32 %0, %1, %2" : "=v"(r) : "v"(lo), "v"(hi)); return r; }

template <class Epi, class Sched, bool ALIGN_EPI = false, bool SP2 = false>
__device__ __forceinline__ void gemm_phase(PG8_LAS unsigned char* lds, const Geo geo, const Sched& S, const Epi& E, const int wave_) {
    int tid_ = wave_ * 64 + lane_id_now(); asm volatile("" : "+v"(tid_));
    const int tid = tid_, wid = __builtin_amdgcn_readfirstlane(tid >> 6), lane = tid & 63, wr = wid >> 2, wc = wid & 3, fr = lane & 15, fq = lane >> 4;
    const int nt = geo.nt;
    unsigned voffA[2], voffB[2];
#pragma unroll
    for (int i = 0; i < 2; ++i) { int R, C; stage_rc(tid * 16 + i * 8192, R, C); const int Rb = Epi::PERM ? ((R & ~31) + perm32(R & 31)) : R;
        voffA[i] = (unsigned)(R * geo.lda + C * 2); voffB[i] = (unsigned)(Rb * geo.ldb + C * 2); }
    unsigned c0[2], c1[2], n0[2], n1[2];
#pragma unroll
    for (int i = 0; i < 2; ++i) { c0[i] = voffA[i]; c1[i] = voffA[i]; n0[i] = voffA[i]; n1[i] = voffA[i]; }
    const size_t kstep = (size_t)(BK * 2);
    const size_t hstepA = (size_t)geo.hstepA, hstepB = (size_t)geo.hstepB;
    const unsigned ldsw = (unsigned)wid * 1024u;
    const int aoff = lds_byte(wr * 64 + fr, fq * 8), boff = lds_byte(wc * 32 + fr, fq * 8);
#define PG8_SA(b, h) (((b) * 2 + (h)) * HTB)
#define PG8_SB(b, h) ((4 + (b) * 2 + (h)) * HTB)
#define PG8_STAGE(bufoff, gbase, voff) do { _Pragma("unroll") for (int _i = 0; _i < 2; ++_i) \
        __builtin_amdgcn_global_load_lds((const unsigned*)((const char*)(gbase) + (voff)[_i]), (PG8_LAS unsigned*)(lds + (bufoff) + ldsw + _i * 8192), 16, 0, 0); } while (0)
#define PG8_LD16(off) __builtin_bit_cast(i32x4, *(const PG8_LAS bf16x8*)(lds + (off)))
#define PG8_LDA(dst, b, h) do { _Pragma("unroll") for (int m = 0; m < 4; ++m) { if constexpr (epi_fp8<Epi>::v) dst##8[m] = __builtin_shufflevector(PG8_LD16(PG8_SA(b, h) + aoff + m * 2048), PG8_LD16(PG8_SA(b, h) + aoff + m * 2048 + 1024), 0, 1, 2, 3, 4, 5, 6, 7); \
        else { _Pragma("unroll") for (int k = 0; k < 2; ++k) dst[m][k] = *(const PG8_LAS bf16x8*)(lds + PG8_SA(b, h) + aoff + m * 2048 + k * 1024); } } } while (0)
#define PG8_LDB(dst, b, h) do { _Pragma("unroll") for (int n = 0; n < 2; ++n) { if constexpr (epi_fp8<Epi>::v) dst##8[n] = __builtin_shufflevector(PG8_LD16(PG8_SB(b, h) + boff + n * 2048), PG8_LD16(PG8_SB(b, h) + boff + n * 2048 + 1024), 0, 1, 2, 3, 4, 5, 6, 7); \
        else { _Pragma("unroll") for (int k = 0; k < 2; ++k) dst[n][k] = *(const PG8_LAS bf16x8*)(lds + PG8_SB(b, h) + boff + n * 2048 + k * 1024); } } } while (0)
#define PG8_MMA(ai, bj, At, Bt) do { __builtin_amdgcn_s_setprio(1); \
        if constexpr (epi_fp8<Epi>::v) { _Pragma("unroll") for (int m = 0; m < 4; ++m) _Pragma("unroll") for (int n = 0; n < 2; ++n) \
            asm volatile("v_mfma_f32_16x16x128_f8f6f4 %0, %1, %2, %0" : "+v"(acc[ai][bj][m][n]) : "v"(Bt##8[n]), "v"(At##8[m])); }     \
        else { _Pragma("unroll") for (int m = 0; m < 4; ++m) _Pragma("unroll") for (int n = 0; n < 2; ++n) _Pragma("unroll") for (int k = 0; k < 2; ++k) \
            acc[ai][bj][m][n] = __builtin_amdgcn_mfma_f32_16x16x32_bf16(Bt[n][k], At[m][k], acc[ai][bj][m][n], 0, 0, 0); } \
        __builtin_amdgcn_s_setprio(0); } while (0)
#define PG8_WAIT_V(n) asm volatile("s_waitcnt vmcnt(" #n ")" ::: "memory")
#define PG8_WAIT_L(n) asm volatile("s_waitcnt lgkmcnt(" #n ")" ::: "memory")
#define PG8_BAR __builtin_amdgcn_s_barrier()
#define PG8_SCHED __builtin_amdgcn_sched_barrier(0)
    Unit cur, nxt; int ui = 0;
    if (!S.next(0, cur)) return;
    f32x4 acc[2][2][4][2];
#pragma unroll
    for (int a = 0; a < 2; ++a)
#pragma unroll
        for (int b = 0; b < 2; ++b)
#pragma unroll
            for (int m = 0; m < 4; ++m)
#pragma unroll
                for (int n = 0; n < 2; ++n) acc[a][b][m][n] = (f32x4){0.f, 0.f, 0.f, 0.f};
    bf16x8 At[4][2], B0[2][2], B1[2][2];
    i32x8 At8[4], B08[2], B18[2];
    const char* cA; const char* cB; S.ptrs(cur, cA, cB);
    S.a_ready(cur);
    if constexpr (Sched::GATHER) {
#pragma unroll
        for (int i = 0; i < 2; ++i) { int R, C; stage_rc(tid * 16 + i * 8192, R, C); c0[i] = S.row_off(0, R) + (unsigned)(C * 2); c1[i] = S.row_off(0, 128 + R) + (unsigned)(C * 2); n0[i] = c0[i]; n1[i] = c1[i]; } }
    static_assert(SP2, "only the two-super-phase loop is kept in this file");
    PG8_STAGE(PG8_SB(0, 0), cB, voffB); PG8_STAGE(PG8_SB(0, 1), cB + hstepB, voffB); PG8_STAGE(PG8_SA(0, 0), cA, c0); PG8_STAGE(PG8_SA(0, 1), cA + hstepA, c1);
    if (wr == 1) PG8_BAR;
    PG8_WAIT_V(2); PG8_BAR;
    PG8_STAGE(PG8_SB(1, 0), cB + kstep, voffB); PG8_STAGE(PG8_SA(1, 0), cA + kstep, c0); PG8_STAGE(PG8_SB(1, 1), cB + hstepB + kstep, voffB);
    PG8_WAIT_V(6); PG8_BAR;
    for (;;) {
        const bool has_next = S.next(ui + 1, nxt);
        const char* nA = cA; const char* nB = cB; if (has_next) S.ptrs(nxt, nA, nB);
        const bool h1 = S.half1(cur);
        for (int t = 0; t < nt; t += 2) {
            const bool last = (t == nt - 2);
            const char* a1 = cA + (size_t)(t + 1) * kstep;
            const char* a2 = last ? nA : cA + (size_t)(t + 2) * kstep; const char* b2 = last ? nB : cB + (size_t)(t + 2) * kstep;
            const char* a3 = a2 + kstep; const char* b3 = b2 + kstep;
            if (last && has_next) { S.a_ready(nxt);
                if constexpr (Sched::GATHER) {
#pragma unroll
                    for (int i = 0; i < 2; ++i) { int R, C; stage_rc(tid * 16 + i * 8192, R, C); n0[i] = S.row_off(ui + 1, R) + (unsigned)(C * 2); n1[i] = S.row_off(ui + 1, 128 + R) + (unsigned)(C * 2); } } }
            const unsigned s0[2] = {last ? n0[0] : c0[0], last ? n0[1] : c0[1]}, s1[2] = {last ? n1[0] : c1[0], last ? n1[1] : c1[1]};
            PG8_LDB(B0, 0, 0); PG8_LDB(B1, 0, 1); PG8_SCHED; PG8_LDA(At, 0, 0); PG8_STAGE(PG8_SA(1, 1), a1 + hstepA, c1);
            PG8_WAIT_V(8); PG8_WAIT_L(0); PG8_BAR; PG8_MMA(0, 0, At, B0); PG8_MMA(0, 1, At, B1); PG8_BAR; PG8_SCHED;
            PG8_LDA(At, 0, 1); PG8_STAGE(PG8_SB(0, 0), b2, voffB); PG8_STAGE(PG8_SB(0, 1), b2 + hstepB, voffB); PG8_STAGE(PG8_SA(0, 0), a2, s0);
            PG8_WAIT_V(8); PG8_WAIT_L(0); PG8_BAR; if (h1) { PG8_MMA(1, 0, At, B0); PG8_MMA(1, 1, At, B1); } PG8_BAR; PG8_SCHED;
            PG8_LDB(B0, 1, 0); PG8_LDB(B1, 1, 1); PG8_SCHED; PG8_LDA(At, 1, 0); PG8_STAGE(PG8_SA(0, 1), a2 + hstepA, s1);
            PG8_WAIT_V(8); PG8_WAIT_L(0); PG8_BAR; PG8_MMA(0, 0, At, B0); PG8_MMA(0, 1, At, B1); PG8_BAR; PG8_SCHED;
            PG8_LDA(At, 1, 1); PG8_STAGE(PG8_SB(1, 0), b3, voffB); PG8_STAGE(PG8_SB(1, 1), b3 + hstepB, voffB); PG8_STAGE(PG8_SA(1, 0), a3, s0);
            PG8_WAIT_V(8); PG8_WAIT_L(0); PG8_BAR; if (h1) { PG8_MMA(1, 0, At, B0); PG8_MMA(1, 1, At, B1); } PG8_BAR; PG8_SCHED;
        }
        if constexpr (epi_fp8<Epi>::v) { asm volatile("s_nop 7\n\ts_nop 7\n\ts_nop 7" ::: "memory"); }
        if constexpr (ALIGN_EPI) { if (wr == 0) PG8_BAR; }
        if constexpr (!Epi::AFTER_DRAIN) { E(acc, cur, wr, wc, fr, fq); S.done(cur); }
        if (!has_next) break;
#pragma unroll
        for (int a = 0; a < 2; ++a)
#pragma unroll
            for (int b = 0; b < 2; ++b)
#pragma unroll
                for (int m = 0; m < 4; ++m)
#pragma unroll
                    for (int n = 0; n < 2; ++n) acc[a][b][m][n] = (f32x4){0.f, 0.f, 0.f, 0.f};
        cur = nxt; cA = nA; cB = nB; ++ui;
#pragma unroll
        for (int i = 0; i < 2; ++i) { c0[i] = n0[i]; c1[i] = n1[i]; }
        if constexpr (ALIGN_EPI) { if (wr == 1) PG8_BAR; }
    }
    PG8_WAIT_V(0);
    if constexpr (!ALIGN_EPI) { if (wr == 0) PG8_BAR; }
    PG8_BAR;
    if constexpr (Epi::AFTER_DRAIN) { E.fused(acc, cur, wr, wc, fr, fq, lds, wid, lane); S.done(cur); }
#undef PG8_SA
#undef PG8_SB
#undef PG8_STAGE
#undef PG8_LDA
#undef PG8_LD16
#undef PG8_LDB
#undef PG8_MMA
#undef PG8_WAIT_V
#undef PG8_WAIT_L
#undef PG8_BAR
#undef PG8_SCHED
}
}

constexpr size_t MiB = 1u << 20;
constexpr size_t al256(size_t x) { return (x + 255) & ~(size_t)255; }
constexpr size_t WS_CTL = 0, CTL_ZERO_BYTES = 1 * MiB;
constexpr int CW_BAR = 4096;
constexpr int CW_CNT = 49152, CNT_STRIDE = 64;
constexpr int CW_CVQ = 16384;
constexpr int CW_SSQ2 = 32768;
constexpr size_t WS_WIN = 1 * MiB;
constexpr size_t WS_WQB = WS_WIN + al256((size_t)INCP * D * 2);
constexpr size_t WS_WKVB = WS_WQB + al256((size_t)1536 * QL * 2);
constexpr size_t WS_WGLU = WS_WKVB + al256((size_t)2048 * KVL * 2);
constexpr size_t WS_WOUT = WS_WGLU + al256((size_t)SSMW * SSMW * 2);
constexpr size_t WS_WXQ = WS_WOUT + al256((size_t)D * D * 2);
constexpr size_t WS_WXK = WS_WXQ + al256((size_t)D * D * 2);
constexpr size_t WS_WXV = WS_WXK + al256((size_t)D * D * 2);
constexpr size_t WS_WXO = WS_WXV + al256((size_t)D * D * 2);
constexpr size_t WS_BTY = WS_WXO + al256((size_t)D * D * 2);
constexpr size_t WS_BTS = WS_BTY + al256((size_t)G * 512 * AGW * 2);
constexpr size_t WS_AP32 = WS_BTS + al256((size_t)G * 128 * 512 * 2);
constexpr size_t WS_HB = WS_AP32 + al256((size_t)G * P * 2 * 4);
constexpr size_t WS_MEMN = WS_HB + al256((size_t)T * D * 2);
constexpr size_t WS_PROJB = WS_MEMN + al256((size_t)TM * D * 2);
constexpr size_t WS_AG = WS_PROJB + al256((size_t)T * PJW * 2);
constexpr size_t WS_SC = WS_AG + al256((size_t)G * 256 * AGW * 2);
constexpr size_t WS_CQN = WS_SC + al256((size_t)G * 256 * 128 * 4);
constexpr size_t WS_CKVN = WS_CQN + al256((size_t)T * QL * 2);
constexpr size_t WS_KPE = WS_CKVN + al256((size_t)T * KVL * 2);
constexpr size_t WS_ROPE = WS_KPE + al256((size_t)T * DR * 2);
constexpr size_t WS_Q = WS_ROPE + al256((size_t)T * 64 * 4);
constexpr size_t WS_KV = WS_Q + al256((size_t)T * 1536 * 2);
constexpr size_t WS_XK = WS_KV + al256((size_t)T * 2048 * 2);
constexpr size_t WS_XVT = WS_XK + al256((size_t)TM * D * 2);
constexpr size_t WS_Y = WS_XVT + al256((size_t)D * TM * 2);
constexpr size_t WS_ATTO = WS_Y + al256((size_t)T * SSMW * 2);
constexpr size_t WS_SSMO = WS_ATTO + al256((size_t)T * 1024 * 2);
constexpr size_t WS_X1 = WS_SSMO + al256((size_t)T * 1024 * 2);
constexpr size_t WS_X1B = WS_X1 + al256((size_t)T * D * 4);
constexpr size_t WS_XQ = WS_X1B + al256((size_t)T * D * 2);
constexpr size_t WS_PX = WS_XQ + al256((size_t)T * D * 2);
constexpr size_t WS_XO = WS_PX + al256((size_t)BATCH * XH * SEQ * MEM * 2);
constexpr size_t WS_X2 = WS_XO + al256((size_t)T * D * 2);
constexpr size_t WS_X2B = WS_X2 + al256((size_t)T * D * 4);
constexpr size_t WS_WRH = WS_X2B + al256((size_t)T * D * 2);
constexpr size_t WS_WRL = WS_WRH + al256((size_t)E * D * 2);
constexpr size_t WS_SELE = WS_WRL + al256((size_t)E * D * 2);
constexpr size_t WS_SELP = WS_SELE + al256((size_t)T * TOPK * 4);
constexpr size_t WS_SELG = WS_SELP + al256((size_t)T * TOPK * 4);
constexpr size_t WS_LIST = WS_SELG + al256((size_t)T * TOPK * 4);
constexpr int NSLOT = (T * TOPK / 256 + E) * 256;
constexpr size_t WS_ACT = WS_LIST + al256((size_t)E * T * 4);
constexpr size_t WS_YK = WS_ACT + al256((size_t)NSLOT * FF * 2);
constexpr size_t WS_WUP = WS_YK + al256((size_t)NSLOT * D * 2);
constexpr size_t WS_WDN = WS_WUP + al256((size_t)E * 2 * FF * D * 2);
constexpr size_t WS_X2F8 = WS_WDN + al256((size_t)E * D * FF * 2);
constexpr size_t WS_X1F8 = WS_X2F8 + al256((size_t)T * D);
constexpr size_t WS_XO8 = WS_X1F8 + al256((size_t)T * D);
constexpr size_t WS_WXQ8 = WS_XO8 + al256((size_t)T * D);
constexpr size_t WS_WXO8 = WS_WXQ8 + al256((size_t)D * D);
constexpr size_t WS_MIXED = WS_WXO8 + al256((size_t)D * D);
constexpr size_t WS_SSQP1 = WS_MIXED + al256((size_t)T * D * 2);
constexpr size_t WS_SSQP2 = WS_SSQP1 + al256((size_t)T * 32 * 4);
constexpr size_t WS_RSTD2 = WS_SSQP2 + al256((size_t)T * 32 * 4);
constexpr size_t WS_END1 = WS_RSTD2 + al256((size_t)T * 4);

constexpr int NWAVES = 8, NTHR = 512;
constexpr int RING_OFF = 0, RING_BYTES = 131072;
constexpr int LDSCTL_OFF = RING_BYTES, MISC_OFF = LDSCTL_OFF + 320;
constexpr int TOK_OFF = LDSCTL_OFF + 1024, MAXU = 10;
constexpr int BLK_OFF = TOK_OFF + MAXU * 1024;
constexpr int LDS_BYTES = 147456;
static_assert(BLK_OFF + 480 * 4 <= LDS_BYTES, "LDS map");

#define GAS __attribute__((address_space(1)))
#define LAS __attribute__((address_space(3)))
typedef unsigned short bf16;
typedef unsigned v4u __attribute__((ext_vector_type(4)));
typedef unsigned v2u __attribute__((ext_vector_type(2)));
typedef float v2f __attribute__((ext_vector_type(2)));
typedef float f32x4 __attribute__((ext_vector_type(4)));
typedef short bf16x8 __attribute__((ext_vector_type(8)));
#define LDS_WAIT() asm volatile("s_waitcnt lgkmcnt(0)" ::: "memory")
#define VM_WAIT() asm volatile("s_waitcnt vmcnt(0)" ::: "memory")
__device__ __forceinline__ unsigned f2bf(float f) { unsigned u = __builtin_bit_cast(unsigned, f); return (u + 0x7fffu + ((u >> 16) & 1u)) >> 16; }
__device__ __forceinline__ unsigned pk2(float lo, float hi) { return f2bf(lo) | (f2bf(hi) << 16); }
__device__ __forceinline__ float bf2f(unsigned short h) { return __builtin_bit_cast(float, (unsigned)h << 16); }
__device__ __forceinline__ float bflo(unsigned w) { return __builtin_bit_cast(float, w << 16); }
__device__ __forceinline__ float bfhi(unsigned w) { return __builtin_bit_cast(float, w & 0xffff0000u); }

__device__ __forceinline__ float clamp448(float v) { return fminf(fmaxf(v, -448.0f), 448.0f); }
__device__ __forceinline__ float clamp448m(float v) { return __builtin_amdgcn_fmed3f(v, -448.0f, 448.0f); }
__device__ __forceinline__ unsigned pk4_fp8w(float a, float b, float c, float d) {
    int p = __builtin_amdgcn_cvt_pk_fp8_f32(clamp448m(a), clamp448m(b), 0, false); p = __builtin_amdgcn_cvt_pk_fp8_f32(clamp448m(c), clamp448m(d), p, true); return (unsigned)p; }
__device__ __forceinline__ unsigned pk4_fp8(float a, float b, float c, float d) {
    int p = __builtin_amdgcn_cvt_pk_fp8_f32(clamp448(a), clamp448(b), 0, false); p = __builtin_amdgcn_cvt_pk_fp8_f32(clamp448(c), clamp448(d), p, true); return (unsigned)p; }
constexpr float W8_SCALE = 256.0f, W8_INV = 1.0f / 256.0f;

#define XB_TMO      128
#define XB_XCNT(j)  (256  + 64 * (j))
#define XB_XSUB(j)  (1280 + 64 * (j))
#define XB_XGEN(j)  (2304 + 64 * (j))
#define XB_TOP      3328
#define XB_TOPGEN   3392
#define XB_FLAG(j)  (3456 + (j))
#define XCD_BAR_WORDS 3520
#define XB_SPIN_CAP (1u << 18)

__device__ __forceinline__ unsigned xb_ld(unsigned* p)              { return __hip_atomic_load(p, __ATOMIC_RELAXED, __HIP_MEMORY_SCOPE_AGENT); }
__device__ __forceinline__ unsigned xb_add(unsigned* p, unsigned v) { return __hip_atomic_fetch_add(p, v, __ATOMIC_RELAXED, __HIP_MEMORY_SCOPE_AGENT); }
__device__ __forceinline__ unsigned xb_xcc_id() { return (unsigned)__builtin_amdgcn_s_getreg((3 << 11) | 20) & 0xFu; }
#define XB_SPIN(cond, bar) do { unsigned _sp = 0; while (cond) { __builtin_amdgcn_s_sleep(1); \
    if ((++_sp & 255u) == 0u) { if (xb_ld(&(bar)[XB_TMO])) break; if (_sp > XB_SPIN_CAP) { atomicAdd(&(bar)[XB_TMO], 1u); break; } } } } while (0)

struct XcdBarrier {
    unsigned* bar; unsigned x; int wave;
    volatile LAS unsigned* st;
};
__device__ __forceinline__ bool xb_thread0(int wave) { return wave == 0 && lane_id_now() == 0; }
__device__ __forceinline__ XcdBarrier xcd_barrier_post(unsigned* bar, volatile LAS unsigned* st, int wave) {
    XcdBarrier b; b.bar = bar; b.x = xb_xcc_id(); b.st = st; b.wave = wave;
    if (xb_thread0(wave)) (void)xb_add(&bar[XB_XCNT(b.x)], 1u);
    return b;
}
__device__ __forceinline__ void xcd_barrier_complete(unsigned* bar, unsigned x, unsigned& nloc, unsigned& nx, unsigned& mask) {
    const unsigned G_ = gridDim.x * gridDim.y * gridDim.z;
    unsigned sum, cnt, mine, msk, sp = 0u;
    for (;;) {
        sum = 0u; cnt = 0u; mine = 0u; msk = 0u;
#pragma unroll
        for (unsigned j = 0; j < 16; ++j) { const unsigned c = xb_ld(&bar[XB_XCNT(j)]); sum += c; cnt += (c > 0u) ? 1u : 0u; msk |= (c > 0u) ? (1u << j) : 0u; mine = (j == x) ? c : mine; }
        if (sum == G_) break;
        __builtin_amdgcn_s_sleep(1);
        if ((++sp & 255u) == 0u) { if (xb_ld(&bar[XB_TMO])) break; if (sp > XB_SPIN_CAP) { atomicAdd(&bar[XB_TMO], 1u); break; } }
    }
    nloc = mine > 0u ? mine : 1u; nx = cnt > 0u ? cnt : 1u; mask = msk;
}
__device__ __forceinline__ void xb_wave0(const XcdBarrier& b, volatile LAS unsigned* stopw = nullptr, unsigned stopv = 0u) {
    unsigned* bar = b.bar;
    const int lane = lane_id_now();
    __builtin_amdgcn_s_waitcnt(0);
    unsigned gen = 0u;
    if (lane == 0) {
        unsigned nloc = b.st[0], nx = b.st[1], mask = b.st[2];
        if (nloc == 0u) { xcd_barrier_complete(bar, b.x, nloc, nx, mask); b.st[0] = nloc; b.st[1] = nx; b.st[2] = mask; }
        const unsigned old = xb_add(&bar[XB_XSUB(b.x)], 1u);
        gen = old / nloc;
        if (old + 1u == (gen + 1u) * nloc) {
            __builtin_amdgcn_fence(__ATOMIC_RELEASE, "agent");
            asm volatile("s_waitcnt vmcnt(0)" ::: "memory");
            xb_add(&bar[XB_FLAG(b.x)], 1u);
        }
    }
    gen = (unsigned)__builtin_amdgcn_readfirstlane((int)gen);
    asm volatile("s_waitcnt lgkmcnt(0)" ::: "memory");
    const unsigned mask = b.st[2];
    unsigned sp = 0u;
    for (;;) {
        unsigned f = 0u; if (lane < 16) f = xb_ld(&bar[XB_FLAG(lane)]);
        const bool waiting = (lane < 16) && ((mask >> lane) & 1u) && ((int)(f - gen) <= 0);
        const unsigned long long wm = __builtin_amdgcn_ballot_w64(waiting);
        if (wm == 0ull) break;
        if (stopw && 2 * __builtin_popcountll(wm) <= __builtin_popcount(mask)) { *stopw = stopv; stopw = nullptr; }
        __builtin_amdgcn_s_sleep(1);
        if ((++sp & 255u) == 0u) { if (xb_ld(&bar[XB_TMO])) break; if (sp > XB_SPIN_CAP) { if (lane == 0) atomicAdd(&bar[XB_TMO], 1u); break; } }
    }
    __builtin_amdgcn_fence(__ATOMIC_ACQUIRE, "agent");
    asm volatile("s_waitcnt vmcnt(0)" ::: "memory");
}
__device__ __forceinline__ void xcd_barrier(const XcdBarrier& b) {
    asm volatile("s_waitcnt vmcnt(0)" ::: "memory");
    __syncthreads();
    if (b.wave == 0) xb_wave0(b);
    __syncthreads();
}

__device__ __forceinline__ float wave_sum(float v) {
#pragma unroll
    for (int o = 1; o < 64; o <<= 1) v += __shfl_xor(v, o);
    return v;
}
__device__ __forceinline__ void transpose_item(const float* W, int N, bf16* WT, int ldk, const float* gain, LAS float* scr, int item, int nblk, int lane) {
    const int kb = item / nblk, nb = item % nblk, k0 = 64 * kb, n0 = 32 * nb;
#pragma unroll 8
    for (int i = 0; i < 32; ++i) { const int kk = 2 * i + (lane >> 5); const float g = gain ? gain[k0 + kk] : 1.0f;
        scr[kk * 33 + (lane & 31)] = W[(size_t)(k0 + kk) * N + n0 + (lane & 31)] * g; }
    LDS_WAIT(); asm volatile("" ::: "memory");
    const int c = lane & 7;
#pragma unroll
    for (int j = 0; j < 4; ++j) { const int n = (lane >> 3) + 8 * j; const LAS float* s = scr + (8 * c) * 33 + n;
        v4u o; o.x = pk2(s[0 * 33], s[1 * 33]); o.y = pk2(s[2 * 33], s[3 * 33]); o.z = pk2(s[4 * 33], s[5 * 33]); o.w = pk2(s[6 * 33], s[7 * 33]);
        *(GAS v4u*)(WT + (size_t)(n0 + n) * ldk + k0 + 8 * c) = o; }
    LDS_WAIT(); asm volatile("" ::: "memory");
}
__device__ __forceinline__ void rms_row_to_bf16(const float* xrow, const float* g, bf16* orow, int lane) {
    const GAS f32x4* xr = (const GAS f32x4*)xrow + lane;
    f32x4 v[8], gv[8]; float s = 0.f;
#pragma unroll
    for (int j = 0; j < 8; ++j) { v[j] = xr[64 * j]; gv[j] = ((const GAS f32x4*)g)[lane + 64 * j]; }
#pragma unroll
    for (int j = 0; j < 8; ++j) s += (v[j].x * v[j].x + v[j].y * v[j].y) + (v[j].z * v[j].z + v[j].w * v[j].w);
    const float r = rsqrtf(wave_sum(s) * (1.f / D) + EPS);
    GAS v2u* o8 = (GAS v2u*)orow + lane;
#pragma unroll
    for (int j = 0; j < 8; ++j) { const f32x4 gg = gv[j];
        v2u o; o.x = pk2(v[j].x * r * gg.x, v[j].y * r * gg.y); o.y = pk2(v[j].z * r * gg.z, v[j].w * r * gg.w); o8[64 * j] = o; }
}

__device__ __forceinline__ void s5_setup(int g, LAS unsigned char* lds, const float* lam_re, const float* lam_im, const float* log_dt, const float* b_re, const float* b_im,
                                         const float* c_re, const float* c_im, bf16* BTY, bf16* BTS, float* AP32, int tid) {
    LAS float* apr = (LAS float*)lds;
    LAS float* api = apr + 33 * 64;
    LAS float* bbr = api + 33 * 64;
    LAS float* bbi = bbr + 1024;
    LAS float* ccr = bbi + 1024;
    LAS float* cci = ccr + 1024;
    LAS float* Kd = cci + 1024;
    const float dt = expf(log_dt[g]);
    for (int idx = tid; idx < 33 * 64; idx += NTHR) { const int d = idx >> 6, p = idx & 63; const float lr = lam_re[g * 64 + p], li = lam_im[g * 64 + p];
        const float mag = expf((float)d * (lr * dt)), ang = (float)d * (li * dt); apr[idx] = mag * cosf(ang); api[idx] = mag * sinf(ang); }
    for (int idx = tid; idx < 1024; idx += NTHR) { ccr[idx] = c_re[g * 1024 + idx]; cci[idx] = c_im[g * 1024 + idx]; }
    __syncthreads();
    for (int idx = tid; idx < 1024; idx += NTHR) { const int p = idx >> 4; const float lr = lam_re[g * 64 + p], li = lam_im[g * 64 + p];
        const float nr = apr[64 + p] - 1.0f, ni = api[64 + p], den = lr * lr + li * li; const float cre = (nr * lr + ni * li) / den, cim = (ni * lr - nr * li) / den;
        const float br = b_re[g * 1024 + idx], bi = b_im[g * 1024 + idx]; bbr[idx] = cre * br - cim * bi; bbi[idx] = cre * bi + cim * br; }
    __syncthreads();
    for (int idx = tid; idx < 32 * 256; idx += NTHR) { const int d = idx >> 8, co = (idx >> 4) & 15, ci = idx & 15; float a = 0.f;
        for (int p = 0; p < 64; ++p) { const float cr = ccr[co * 64 + p], cm = cci[co * 64 + p], ar = apr[d * 64 + p], ai = api[d * 64 + p];
            const float car = cr * ar - cm * ai, cai = cr * ai + cm * ar; a += car * bbr[p * 16 + ci] - cai * bbi[p * 16 + ci]; }
        Kd[idx] = a; }
    __syncthreads();
    for (int idx = tid; idx < 512 * 80; idx += NTHR) { const int row = idx / 80, q = idx % 80, i = row >> 4, co = row & 15; float v[8];
        if (q < 64) { const int j = q >> 1, ci0 = (q & 1) * 8;
#pragma unroll
            for (int e = 0; e < 8; ++e) v[e] = (j <= i) ? Kd[(i - j) * 256 + co * 16 + ci0 + e] : 0.f; }
        else if (q < 72) { const int p0 = (q - 64) * 8;
#pragma unroll
            for (int e = 0; e < 8; ++e) { const int p = p0 + e; v[e] = ccr[co * 64 + p] * apr[(i + 1) * 64 + p] - cci[co * 64 + p] * api[(i + 1) * 64 + p]; } }
        else { const int p0 = (q - 72) * 8;
#pragma unroll
            for (int e = 0; e < 8; ++e) { const int p = p0 + e; v[e] = -(ccr[co * 64 + p] * api[(i + 1) * 64 + p] + cci[co * 64 + p] * apr[(i + 1) * 64 + p]); } }
        v4u o; o.x = pk2(v[0], v[1]); o.y = pk2(v[2], v[3]); o.z = pk2(v[4], v[5]); o.w = pk2(v[6], v[7]);
        *(GAS v4u*)(BTY + ((size_t)g * 512 + row) * AGW + q * 8) = o; }
    for (int idx = tid; idx < 128 * 64; idx += NTHR) { const int row = idx >> 6, q = idx & 63, p = row & 63, part = row >> 6, j = q >> 1, ci0 = (q & 1) * 8; float v[8];
        const float ar = apr[(31 - j) * 64 + p], ai = api[(31 - j) * 64 + p];
#pragma unroll
        for (int e = 0; e < 8; ++e) { const float br = bbr[p * 16 + ci0 + e], bi = bbi[p * 16 + ci0 + e]; v[e] = part ? (ar * bi + ai * br) : (ar * br - ai * bi); }
        v4u o; o.x = pk2(v[0], v[1]); o.y = pk2(v[2], v[3]); o.z = pk2(v[4], v[5]); o.w = pk2(v[6], v[7]);
        *(GAS v4u*)(BTS + ((size_t)g * 128 + row) * 512 + q * 8) = o; }
    if (tid < 64) { AP32[(g * 64 + tid) * 2] = apr[32 * 64 + tid]; AP32[(g * 64 + tid) * 2 + 1] = api[32 * 64 + tid]; }
    __syncthreads();
}

using pg8::Unit;
template <bool RS, bool F8 = false, bool O8 = false> struct EpiPlain {
    static constexpr bool PERM = true, AFTER_DRAIN = false, FP8 = F8;
    bf16* O; int ldc; int zdiv; long zC1, zC2; const LAS float* rstd;
    __device__ __forceinline__ void operator()(const f32x4 (&acc)[2][2][4][2], const Unit& u, int wr, int wc, int fr, int fq) const {
        const long zoff = (long)(u.z / zdiv) * zC1 + (long)(u.z % zdiv) * zC2;
        const int row0 = u.pm * 256 + wr * 64 + fr, col0 = u.pn * 256 + wc * 32 + 8 * fq;
#pragma unroll
        for (int ai = 0; ai < 2; ++ai)
#pragma unroll
            for (int m = 0; m < 4; ++m) { const int row = row0 + ai * 128 + m * 16; const size_t eo = (size_t)zoff + (size_t)row * ldc + col0;
                float sc = F8 ? W8_INV : 1.f; if (RS) sc *= rstd[row - u.pm * 256];
#pragma unroll
                for (int bj = 0; bj < 2; ++bj) { const f32x4 v0 = acc[ai][bj][m][0] * sc, v1 = acc[ai][bj][m][1] * sc;
                    if constexpr (O8) { v2u w; w.x = pk4_fp8(v0[0], v0[1], v0[2], v0[3]); w.y = pk4_fp8(v1[0], v1[1], v1[2], v1[3]); *(v2u*)((unsigned char*)O + eo + bj * 128) = w; }
                    else { v4u w; w.x = pg8::cvt_pk_bf16(v0[0], v0[1]); w.y = pg8::cvt_pk_bf16(v0[2], v0[3]); w.z = pg8::cvt_pk_bf16(v1[0], v1[1]); w.w = pg8::cvt_pk_bf16(v1[2], v1[3]);
                        *(v4u*)(O + eo + bj * 128) = w; } } }
    }
};
struct EpiProj {
    static constexpr bool PERM = true, AFTER_DRAIN = false;
    bf16* projb; bf16* Ag;
    __device__ __forceinline__ void operator()(const f32x4 (&acc)[2][2][4][2], const Unit& u, int wr, int wc, int fr, int fq) const {
        const int row0 = u.pm * 256 + wr * 64 + fr;
#pragma unroll
        for (int bj = 0; bj < 2; ++bj) { const int colg = u.pn * 256 + bj * 128 + wc * 32, c0 = colg + 8 * fq;
            if (colg >= INC) continue;
#pragma unroll
            for (int ai = 0; ai < 2; ++ai)
#pragma unroll
                for (int m = 0; m < 4; ++m) { const int row = row0 + ai * 128 + m * 16; const f32x4 v0 = acc[ai][bj][m][0], v1 = acc[ai][bj][m][1]; v4u w;
                    w.x = pg8::cvt_pk_bf16(v0[0], v0[1]); w.y = pg8::cvt_pk_bf16(v0[2], v0[3]); w.z = pg8::cvt_pk_bf16(v1[0], v1[1]); w.w = pg8::cvt_pk_bf16(v1[2], v1[3]);
                    if (colg < PJW) *(v4u*)(projb + (size_t)row * PJW + c0) = w;
                    else { const int ch = c0 - PJW, g = ch >> 4, c = ch & 15; *(v4u*)(Ag + ((size_t)g * 256 + (row >> 5)) * AGW + (row & 31) * 16 + c) = w; } } }
    }
};
struct EpiS5State {
    static constexpr bool PERM = false, AFTER_DRAIN = false;
    float* Sc;
    __device__ __forceinline__ void operator()(const f32x4 (&acc)[2][2][4][2], const Unit& u, int wr, int wc, int fr, int fq) const {
        const int row0 = wr * 64 + fr, col0 = wc * 32 + 4 * fq;
#pragma unroll
        for (int ai = 0; ai < 2; ++ai)
#pragma unroll
            for (int m = 0; m < 4; ++m) { float* rowp = Sc + ((size_t)u.z * 256 + row0 + ai * 128 + m * 16) * 128 + col0;
#pragma unroll
                for (int n = 0; n < 2; ++n) *(f32x4*)(rowp + n * 16) = acc[ai][0][m][n]; }
    }
};
__device__ __forceinline__ float gelu_tanh(float v) {
    const float t = v * (0.7978845608028654f + 0.7978845608028654f * 0.044715f * v * v);
    return v * __builtin_amdgcn_rcpf(1.0f + __builtin_amdgcn_exp2f(-2.885390081777927f * t));
}
struct EpiS5Y {
    static constexpr bool PERM = true, AFTER_DRAIN = false;
    const bf16* Ag; const float* dsk; bf16* Y;
    __device__ __forceinline__ void operator()(const f32x4 (&acc)[2][2][4][2], const Unit& u, int wr, int wc, int fr, int fq) const {
        const int g = u.z, row0 = wr * 64 + fr;
        v4u ub2[2][8]; f32x4 dd[2][2];
#pragma unroll
        for (int bj = 0; bj < 2; ++bj) { const int c0 = u.pn * 256 + bj * 128 + wc * 32 + 8 * fq, co = c0 & 15;
            dd[bj][0] = *(const f32x4*)(dsk + g * 16 + co); dd[bj][1] = *(const f32x4*)(dsk + g * 16 + co + 4);
#pragma unroll
            for (int q = 0; q < 8; ++q) ub2[bj][q] = *(const v4u*)(Ag + ((size_t)g * 256 + row0 + (q >> 2) * 128 + (q & 3) * 16) * AGW + c0); }
#pragma unroll
        for (int bj = 0; bj < 2; ++bj) { const int c0 = u.pn * 256 + bj * 128 + wc * 32 + 8 * fq, i = c0 >> 4, co = c0 & 15;
            const f32x4 d0 = dd[bj][0], d1 = dd[bj][1];
#pragma unroll
            for (int ai = 0; ai < 2; ++ai)
#pragma unroll
                for (int m = 0; m < 4; ++m) { const int r = row0 + ai * 128 + m * 16;
                    const v4u uu = ub2[bj][ai * 4 + m];
                    f32x4 v0 = acc[ai][bj][m][0], v1 = acc[ai][bj][m][1];
                    v0[0] += d0[0] * bflo(uu.x); v0[1] += d0[1] * bfhi(uu.x); v0[2] += d0[2] * bflo(uu.y); v0[3] += d0[3] * bfhi(uu.y);
                    v1[0] += d1[0] * bflo(uu.z); v1[1] += d1[1] * bfhi(uu.z); v1[2] += d1[2] * bflo(uu.w); v1[3] += d1[3] * bfhi(uu.w);
                    v4u w; w.x = pg8::cvt_pk_bf16(gelu_tanh(v0[0]), gelu_tanh(v0[1])); w.y = pg8::cvt_pk_bf16(gelu_tanh(v0[2]), gelu_tanh(v0[3]));
                    w.z = pg8::cvt_pk_bf16(gelu_tanh(v1[0]), gelu_tanh(v1[1])); w.w = pg8::cvt_pk_bf16(gelu_tanh(v1[2]), gelu_tanh(v1[3]));
                    *(v4u*)(Y + ((size_t)(r * 32 + i)) * SSMW + g * 16 + co) = w; } }
    }
};

struct EpiGlu {
    static constexpr bool PERM = true, AFTER_DRAIN = false;
    const bf16* Y; const float* bias; bf16* O;
    __device__ __forceinline__ void operator()(const f32x4 (&acc)[2][2][4][2], const Unit& u, int wr, int wc, int fr, int fq) const {
        const int row0 = u.pm * 256 + wr * 64 + fr;
        v4u yb2[2][8]; f32x4 bb[2][2];
#pragma unroll
        for (int bj = 0; bj < 2; ++bj) { const int c0 = u.pn * 256 + bj * 128 + wc * 32 + 8 * fq;
            bb[bj][0] = *(const f32x4*)(bias + c0); bb[bj][1] = *(const f32x4*)(bias + c0 + 4);
#pragma unroll
            for (int q = 0; q < 8; ++q) yb2[bj][q] = *(const v4u*)(Y + (size_t)(row0 + (q >> 2) * 128 + (q & 3) * 16) * SSMW + c0); }
#pragma unroll
        for (int bj = 0; bj < 2; ++bj) { const int c0 = u.pn * 256 + bj * 128 + wc * 32 + 8 * fq;
            const f32x4 b0 = bb[bj][0], b1 = bb[bj][1];
#pragma unroll
            for (int ai = 0; ai < 2; ++ai)
#pragma unroll
                for (int m = 0; m < 4; ++m) { const size_t off = (size_t)(row0 + ai * 128 + m * 16) * SSMW + c0;
                    const v4u yy = yb2[bj][ai * 4 + m]; const f32x4 z0 = acc[ai][bj][m][0] + b0, z1 = acc[ai][bj][m][1] + b1;
#define SG(z) __builtin_amdgcn_rcpf(1.0f + __builtin_amdgcn_exp2f(-1.4426950408889634f * (z)))
                    v4u w; w.x = pg8::cvt_pk_bf16(bflo(yy.x) * SG(z0[0]), bfhi(yy.x) * SG(z0[1])); w.y = pg8::cvt_pk_bf16(bflo(yy.y) * SG(z0[2]), bfhi(yy.y) * SG(z0[3]));
                    w.z = pg8::cvt_pk_bf16(bflo(yy.z) * SG(z1[0]), bfhi(yy.z) * SG(z1[1])); w.w = pg8::cvt_pk_bf16(bflo(yy.w) * SG(z1[2]), bfhi(yy.w) * SG(z1[3]));
#undef SG
                    *(v4u*)(O + off) = w; } }
    }
};
template <bool F8 = false> struct EpiResid {
    static constexpr bool PERM = false, AFTER_DRAIN = false, FP8 = F8;
    const float* res; float* Xo; bf16* Xb; float* ssq; unsigned char* X8;
    __device__ __forceinline__ void operator()(const f32x4 (&acc)[2][2][4][2], const Unit& u, int wr, int wc, int fr, int fq) const {
        const int row0 = u.pm * 256 + wr * 64 + fr, col0 = u.pn * 256 + wc * 32 + 4 * fq;
        constexpr int RB = 4;
        f32x4 rb[RB][4];
#define ER_LOAD(idx) do { const size_t off_ = (size_t)(row0 + ((idx) >> 2) * 128 + ((idx) & 3) * 16) * D + col0; _Pragma("unroll") for (int q = 0; q < 4; ++q) rb[(idx) % RB][q] = *(const f32x4*)(res + off_ + (q >> 1) * 128 + (q & 1) * 16); } while (0)
#pragma unroll
        for (int i = 0; i < RB - 1; ++i) ER_LOAD(i);
#pragma unroll
        for (int idx = 0; idx < 8; ++idx) { const int ai = idx >> 2, m = idx & 3, row = row0 + ai * 128 + m * 16; const size_t off = (size_t)row * D + col0; float s = 0.f;
            if (idx + RB - 1 < 8) ER_LOAD(idx + RB - 1);
#pragma unroll
            for (int bj = 0; bj < 2; ++bj)
#pragma unroll
                for (int n = 0; n < 2; ++n) { const size_t o2 = off + bj * 128 + n * 16; const f32x4 v = rb[idx % RB][bj * 2 + n] + acc[ai][bj][m][n] * (F8 ? W8_INV : 1.0f);
                    *(f32x4*)(Xo + o2) = v; if (Xb) { v2u w; w.x = pg8::cvt_pk_bf16(v[0], v[1]); w.y = pg8::cvt_pk_bf16(v[2], v[3]); *(v2u*)(Xb + o2) = w; }
                    if (X8) *(unsigned*)(X8 + o2) = pk4_fp8(v[0], v[1], v[2], v[3]);
                    s += (v[0] * v[0] + v[1] * v[1]) + (v[2] * v[2] + v[3] * v[3]); }
            s += __shfl_xor(s, 16); s += __shfl_xor(s, 32);
            if (fq == 0) ssq[(size_t)row * 32 + u.pn * 4 + wc] = s; }
#undef ER_LOAD
    }
};

struct EpiSoftmax {
    static constexpr bool PERM = true, AFTER_DRAIN = true;
    bf16* Pm;
    __device__ __forceinline__ void fused(f32x4 (&acc)[2][2][4][2], const Unit& u, int wr, int wc, int fr, int fq, PG8_LAS unsigned char* lds, int wid, int lane) const {
        PG8_LAS float* Rm = (PG8_LAS float*)lds;
        PG8_LAS float* Rs = Rm + 1024;
        constexpr float CS = 1.4426950408889634f * 0.04419417382415922f;
        float mx[2][4];
#pragma unroll
        for (int ai = 0; ai < 2; ++ai)
#pragma unroll
            for (int m = 0; m < 4; ++m) { float v = -3.0e38f;
#pragma unroll
                for (int bj = 0; bj < 2; ++bj)
#pragma unroll
                    for (int n = 0; n < 2; ++n) { const f32x4 a = acc[ai][bj][m][n]; v = fmaxf(v, fmaxf(fmaxf(a[0], a[1]), fmaxf(a[2], a[3]))); }
                v = fmaxf(v, __shfl_xor(v, 16)); v = fmaxf(v, __shfl_xor(v, 32));
                if (fq == 0) Rm[(ai * 128 + wr * 64 + m * 16 + fr) * 4 + wc] = v; }
        asm volatile("s_waitcnt lgkmcnt(0)" ::: "memory"); __builtin_amdgcn_s_barrier(); asm volatile("" ::: "memory");
#pragma unroll
        for (int ai = 0; ai < 2; ++ai)
#pragma unroll
            for (int m = 0; m < 4; ++m) { const int r = ai * 128 + wr * 64 + m * 16 + fr; const f32x4 q = *(const PG8_LAS f32x4*)(Rm + r * 4);
                const float rm = fmaxf(fmaxf(q[0], q[1]), fmaxf(q[2], q[3])) * CS; mx[ai][m] = rm; float s = 0.f;
#pragma unroll
                for (int bj = 0; bj < 2; ++bj)
#pragma unroll
                    for (int n = 0; n < 2; ++n) { f32x4 a = acc[ai][bj][m][n];
#pragma unroll
                        for (int e = 0; e < 4; ++e) { a[e] = __builtin_amdgcn_exp2f(fmaf(a[e], CS, -rm)); s += a[e]; }
                        acc[ai][bj][m][n] = a; }
                s += __shfl_xor(s, 16); s += __shfl_xor(s, 32);
                if (fq == 0) Rs[r * 4 + wc] = s; }
        asm volatile("s_waitcnt lgkmcnt(0)" ::: "memory"); __builtin_amdgcn_s_barrier(); asm volatile("" ::: "memory");
        bf16* base = Pm + (size_t)u.z * SEQ * MEM;
#pragma unroll
        for (int ai = 0; ai < 2; ++ai)
#pragma unroll
            for (int m = 0; m < 4; ++m) { const int r = ai * 128 + wr * 64 + m * 16 + fr; const f32x4 q = *(const PG8_LAS f32x4*)(Rs + r * 4);
                const float inv = __builtin_amdgcn_rcpf((q[0] + q[1]) + (q[2] + q[3]));
                bf16* rowp = base + (size_t)(u.pm * 256 + r) * MEM + wc * 32 + 8 * fq;
#pragma unroll
                for (int bj = 0; bj < 2; ++bj) { const f32x4 v0 = acc[ai][bj][m][0] * inv, v1 = acc[ai][bj][m][1] * inv; v4u w;
                    w.x = pg8::cvt_pk_bf16(v0[0], v0[1]); w.y = pg8::cvt_pk_bf16(v0[2], v0[3]); w.z = pg8::cvt_pk_bf16(v1[0], v1[1]); w.w = pg8::cvt_pk_bf16(v1[2], v1[3]);
                    *(v4u*)(rowp + bj * 128) = w; } }
        (void)mx;
    }
};

template <bool GATHER_> struct MoeSched {
    static constexpr bool GATHER = GATHER_;
    int NB, nN, G, c, lda; const char* A; const char* B; long tA, eB, tB;
    const LAS int* blkE; const LAS int* tokTab;
    __device__ __forceinline__ bool next(int i, Unit& u) const { const int L = i * G + c; if (L >= NB * nN) return false; u.z = L / nN; u.pn = L % nN; u.pm = i; return true; }
    __device__ __forceinline__ void ptrs(const Unit& u, const char*& a, const char*& b_) const { const int e = blkE[u.z]; a = GATHER_ ? A : A + (long)u.z * tA; b_ = B + (long)e * eB + (long)u.pn * tB; }
    __device__ __forceinline__ unsigned row_off(int ui, int row) const { return (unsigned)tokTab[ui * 256 + row] * (unsigned)lda; }
    __device__ __forceinline__ bool half1(const Unit& u) const { return blkE[320 + u.z] > 128; }
    __device__ __forceinline__ void a_ready(const Unit&) const {}
    __device__ __forceinline__ void done(const Unit&) const {}
};
struct EpiMoeUp {
    static constexpr bool PERM = true, AFTER_DRAIN = false, FP8 = true;
    const LAS int* blkE; const LAS int* tokTab; const float* ssq; const float* bup; unsigned char* ACT;
    __device__ __forceinline__ void operator()(const f32x4 (&acc)[2][2][4][2], const Unit& u, int wr, int wc, int fr, int fq) const {
        asm volatile("" : "+v"(fr), "+v"(fq));
        const int e = blkE[u.z], c0 = u.pn * 128 + wc * 32 + 8 * fq, row0 = wr * 64 + fr;
        const float* bg = bup + (size_t)e * 2 * FF + c0; const f32x4 g0 = *(const f32x4*)bg, g1 = *(const f32x4*)(bg + 4), l0 = *(const f32x4*)(bg + FF), l1 = *(const f32x4*)(bg + FF + 4);
        float rsb[8];
#pragma unroll
        for (int q = 0; q < 8; ++q) rsb[q] = ssq[tokTab[u.pm * 256 + row0 + (q >> 2) * 128 + (q & 3) * 16]] * W8_INV;
#pragma unroll
        for (int ai = 0; ai < 2; ++ai)
#pragma unroll
            for (int m = 0; m < 4; ++m) { const int r = row0 + ai * 128 + m * 16; const float rs = rsb[ai * 4 + m];
                float a[8];
#pragma unroll
                for (int j = 0; j < 8; ++j) { const float gb = j < 4 ? g0[j & 3] : g1[j & 3], lb = j < 4 ? l0[j & 3] : l1[j & 3];
                    const float gl = fminf(acc[ai][0][m][j >> 2][j & 3] * rs + gb, 7.0f), ln = fminf(fmaxf(acc[ai][1][m][j >> 2][j & 3] * rs + lb, -7.0f), 7.0f);
                    a[j] = gl * __builtin_amdgcn_rcpf(1.0f + __builtin_amdgcn_exp2f(-1.702f * 1.4426950408889634f * gl)) * (ln + 1.0f); }
                v2u w; w.x = pk4_fp8(a[0], a[1], a[2], a[3]); w.y = pk4_fp8(a[4], a[5], a[6], a[7]);
                *(v2u*)(ACT + ((size_t)u.z * 256 + r) * FF + c0) = w; }
    }
};
constexpr float Y8_SCALE = 32.0f, Y8_INV = 1.0f / 32.0f;
struct EpiMoeDown {
    static constexpr bool PERM = true, AFTER_DRAIN = false, FP8 = true;
    const LAS int* blkE; const float* bdn; unsigned char* YK;
    __device__ __forceinline__ void operator()(const f32x4 (&acc)[2][2][4][2], const Unit& u, int wr, int wc, int fr, int fq) const {
        const int e = blkE[u.z], row0 = wr * 64 + fr;
        f32x4 bq[2][2];
#pragma unroll
        for (int bj = 0; bj < 2; ++bj) { const int c0 = u.pn * 256 + bj * 128 + wc * 32 + 8 * fq; bq[bj][0] = *(const f32x4*)(bdn + (size_t)e * D + c0); bq[bj][1] = *(const f32x4*)(bdn + (size_t)e * D + c0 + 4); }
#pragma unroll
        for (int bj = 0; bj < 2; ++bj) { const int c0 = u.pn * 256 + bj * 128 + wc * 32 + 8 * fq; const f32x4 b0 = bq[bj][0] * Y8_SCALE, b1 = bq[bj][1] * Y8_SCALE;
#pragma unroll
            for (int ai = 0; ai < 2; ++ai)
#pragma unroll
                for (int m = 0; m < 4; ++m) { const int r = row0 + ai * 128 + m * 16; const f32x4 v0 = acc[ai][bj][m][0] * (W8_INV * Y8_SCALE) + b0, v1 = acc[ai][bj][m][1] * (W8_INV * Y8_SCALE) + b1; v2u w;
                    w.x = pk4_fp8(v0[0], v0[1], v0[2], v0[3]); w.y = pk4_fp8(v1[0], v1[1], v1[2], v1[3]);
                    *(v2u*)(YK + ((size_t)u.z * 256 + r) * D + c0) = w; } }
    }
};
__device__ __forceinline__ int moe_block_table(const unsigned* counts, LAS int* blkE, int tid) {
    if (tid < 64) {
        const int cnt = tid < E ? (int)counts[tid * CNT_STRIDE] : 0, nb = (cnt + 255) >> 8;
        int inc = nb;
#pragma unroll
        for (int o = 1; o < 64; o <<= 1) { const int v = __shfl_up(inc, o); if (tid >= o) inc += v; }
        const int base = inc - nb;
        for (int j = 0; j < nb; ++j) { blkE[base + j] = tid; blkE[160 + base + j] = j; const int left = cnt - j * 256; blkE[320 + base + j] = left < 256 ? left : 256; }
        if (tid == 63) blkE[480] = inc;
    }
    __syncthreads();
    return blkE[480];
}

struct TItem { const float* src; bf16* dst; const float* gain; int N, ldk; };
template <bool GAIN> __device__ __forceinline__ void titem_load(const TItem& d, int lane, f32x4 (&r)[16], f32x4 (&g)[4]) {
    const int q = lane & 15, kg = lane >> 4; const float* p = d.src + (size_t)(8 * kg) * d.N + 4 * q;
#pragma unroll
    for (int j = 0; j < 16; ++j) r[j] = *(const GAS f32x4*)(p + (size_t)(32 * (j >> 3) + (j & 7)) * d.N);
    if constexpr (GAIN) {
#pragma unroll
        for (int j4 = 0; j4 < 4; ++j4) g[j4] = *(const GAS f32x4*)(d.gain + 32 * (j4 >> 1) + 8 * kg + 4 * (j4 & 1)); }
    asm volatile("" ::: "memory"); __builtin_amdgcn_sched_barrier(0);
}
template <bool GAIN> __device__ __forceinline__ void titem_store(const TItem& d, int lane, const f32x4 (&r)[16], const f32x4 (&g)[4]) {
    const int q = lane & 15, kg = lane >> 4;
    bf16* o = d.dst + (size_t)(4 * q) * d.ldk + 8 * kg;
#define TG(j) (GAIN ? g[(j) >> 2][(j) & 3] : 1.0f)
#pragma unroll
    for (int i = 0; i < 4; ++i)
#pragma unroll
        for (int h = 0; h < 2; ++h) { v4u w;
            w.x = pg8::cvt_pk_bf16(r[8 * h + 0][i] * TG(8 * h + 0), r[8 * h + 1][i] * TG(8 * h + 1)); w.y = pg8::cvt_pk_bf16(r[8 * h + 2][i] * TG(8 * h + 2), r[8 * h + 3][i] * TG(8 * h + 3));
            w.z = pg8::cvt_pk_bf16(r[8 * h + 4][i] * TG(8 * h + 4), r[8 * h + 5][i] * TG(8 * h + 5)); w.w = pg8::cvt_pk_bf16(r[8 * h + 6][i] * TG(8 * h + 6), r[8 * h + 7][i] * TG(8 * h + 7));
            *(GAS v4u*)(o + (size_t)i * d.ldk + 32 * h) = w; }
#undef TG
}
template <bool GAIN, bool NT = false> __device__ __forceinline__ void titem8_load(const TItem& d, int lane, f32x4 (&r)[16], f32x4 (&g)[4]) {
    const int q = lane & 7, kg = lane >> 3; const unsigned lo = (unsigned)((16 * kg) * d.N + 4 * q) * 4u;
    const GAS char* base = (const GAS char*)d.src;
#pragma unroll
    for (int j = 0; j < 16; ++j) { const GAS f32x4* p = (const GAS f32x4*)(base + (size_t)j * (size_t)d.N * 4 + lo); r[j] = NT ? __builtin_nontemporal_load(p) : *p; }
    if constexpr (GAIN) { const GAS char* gb = (const GAS char*)d.gain; const unsigned go = (unsigned)(16 * kg) * 4u;
#pragma unroll
        for (int j4 = 0; j4 < 4; ++j4) g[j4] = *(const GAS f32x4*)(gb + 16 * j4 + go); }
    asm volatile("" ::: "memory"); __builtin_amdgcn_sched_barrier(0);
}
template <bool GAIN, bool NT = false> __device__ __forceinline__ void titem8_store(const TItem& d, int lane, const f32x4 (&r)[16], const f32x4 (&g)[4]) {
    const int q = lane & 7, kg = lane >> 3; const unsigned lo = (unsigned)((4 * q) * d.ldk + 16 * kg);
    GAS char* base = (GAS char*)d.dst;
    f32x4 s[16];
#pragma unroll
    for (int j = 0; j < 16; ++j) s[j] = r[j] * ((GAIN ? g[j >> 2][j & 3] : 1.0f) * W8_SCALE);
#pragma unroll
    for (int i = 0; i < 4; ++i) { v4u w;
        w.x = pk4_fp8w(s[0][i], s[1][i], s[2][i], s[3][i]); w.y = pk4_fp8w(s[4][i], s[5][i], s[6][i], s[7][i]);
        w.z = pk4_fp8w(s[8][i], s[9][i], s[10][i], s[11][i]); w.w = pk4_fp8w(s[12][i], s[13][i], s[14][i], s[15][i]);
        GAS v4u* p = (GAS v4u*)(base + (size_t)i * (size_t)d.ldk + lo);
        if (NT) __builtin_nontemporal_store(w, p); else *p = w; }
}
#define TSTREAM(n_, DEC, LOAD, STORE) do { f32x4 ra[16], rb[16], ga[4], gb[4]; int it0 = gw; \
        if (it0 < (n_)) { TItem d0 = DEC(it0); LOAD(d0, lane, ra, ga); \
            for (;;) { const int it1 = it0 + NGW; \
                if (!(it1 < (n_))) { STORE(d0, lane, ra, ga); break; } \
                TItem d1 = DEC(it1); LOAD(d1, lane, rb, gb); STORE(d0, lane, ra, ga);            \
                it0 = it1 + NGW; \
                if (!(it0 < (n_))) { STORE(d1, lane, rb, gb); break; } \
                d0 = DEC(it0); LOAD(d0, lane, ra, ga); STORE(d1, lane, rb, gb); } } } while (0)

#define TI8S_NT titem8_store<false, true>
#define TI8L_NT titem8_load<false, true>
struct MoeSchedUpCv : MoeSched<true> {
    const float* wdn; unsigned char* wdn8; int wave;
    __device__ __forceinline__ TItem dec_dn(int it) const { constexpr int I_DN = (FF / 128) * (D / 32); TItem d; int r = it; const int e = r / I_DN; r -= e * I_DN;
        const int nb_ = D / 32, kb = r / nb_, nbi = r % nb_; d.src = wdn + (size_t)e * FF * D + (size_t)(128 * kb) * D + 32 * nbi; d.dst = (bf16*)(wdn8 + (size_t)e * D * FF + (size_t)(32 * nbi) * FF + 128 * kb);
        d.gain = wdn; d.N = D; d.ldk = FF; return d; }
    __device__ __forceinline__ void convert_share() const {
        const int lane = lane_id_now(), gw = c * NWAVES + wave, NGW = G * NWAVES;
        constexpr int NIT = E * (FF / 128) * (D / 32);
        TSTREAM(NIT, dec_dn, TI8L_NT, TI8S_NT);
    }
    __device__ __forceinline__ void done(const Unit& u) const { if (u.pm == (c & 7)) convert_share(); }
};

constexpr int CV_I_UP = (D / 128) * (2 * FF / 32), CV_ITEMS = E * CV_I_UP;
constexpr int CV_BATCH = 4;
struct CvWork { const float* wup; const float* gain; unsigned char* wup8; volatile LAS int* cur; volatile LAS unsigned* rel; unsigned* q; int wave; };
__device__ __forceinline__ bool cv_one(const CvWork& w) {
    if (w.wave == 0) return false;
    int it = __builtin_amdgcn_readfirstlane(w.cur[2 * w.wave]); const int end = __builtin_amdgcn_readfirstlane(w.cur[2 * w.wave + 1]);
    if (it >= end) {
        if (it > CV_ITEMS) return false;
        unsigned base = 0u; if (lane_id_now() == 0) base = __hip_atomic_fetch_add(w.q, (unsigned)CV_BATCH, __ATOMIC_RELAXED, __HIP_MEMORY_SCOPE_AGENT);
        base = __builtin_amdgcn_readfirstlane(base);
        if (base >= (unsigned)CV_ITEMS) { w.cur[2 * w.wave] = CV_ITEMS + 1; w.cur[2 * w.wave + 1] = 0; return false; }
        it = (int)base; w.cur[2 * w.wave + 1] = (int)base + CV_BATCH;
    }
    TItem d; { int r = it; const int e = r / CV_I_UP; r -= e * CV_I_UP; const int nb_ = 2 * FF / 32, kb = r / nb_, nbi = r % nb_;
        d.src = w.wup + (size_t)e * D * 2 * FF + (size_t)(128 * kb) * (2 * FF) + 32 * nbi; d.dst = (bf16*)(w.wup8 + (size_t)e * 2 * FF * D + (size_t)(32 * nbi) * D + 128 * kb);
        d.gain = w.gain + 128 * kb; d.N = 2 * FF; d.ldk = D; }
    const int lane = lane_id_now();
    f32x4 r[16], g[4]; titem8_load<true, true>(d, lane, r, g); titem8_store<true, true>(d, lane, r, g);
    w.cur[2 * w.wave] = it + 1;
    return true;
}
__device__ __forceinline__ void cv_flush(const CvWork& w) { while (cv_one(w)) {} }
__device__ __forceinline__ void xcd_barrier_cv(const XcdBarrier& b, const CvWork& w) {
    asm volatile("s_waitcnt vmcnt(0)" ::: "memory");
    const unsigned g0 = w.rel[0];
    __syncthreads();
    if (b.wave == 0) {
        xb_wave0(b, w.rel + 1, g0 + 1u);
        w.rel[0] = g0 + 1u;
    } else if (b.wave != 0) {
        unsigned guard = 0;
        while (w.rel[0] == g0) { if (w.rel[1] == g0 + 1u) { __builtin_amdgcn_s_sleep(1); continue; }
            if (!cv_one(w)) __builtin_amdgcn_s_sleep(4); if (++guard > (1u << 22)) break; }
    }
    asm volatile("s_waitcnt lgkmcnt(0)" ::: "memory"); __builtin_amdgcn_s_barrier(); asm volatile("" ::: "memory");
}

namespace mla {
typedef short s16x4 __attribute__((ext_vector_type(4)));
typedef float f32x16 __attribute__((ext_vector_type(16)));
constexpr int KVBLK = 64, QB = 256;
constexpr int SHM_V = KVBLK * 128 * 2, SHM_K = KVBLK * 128 * 2, SHM_P = KVBLK * 64 * 2;
constexpr int BUFB = SHM_V + SHM_K + SHM_P, V_OFF = 0, K_OFF = SHM_V, P_OFF = SHM_V + SHM_K, NBUF = 3, W_OFF = NBUF * BUFB;
constexpr float C2 = 1.4426950408889634f * 0.07216878364870322f;
#define KSWZ(row, colB) ((row) * 256 + ((colB) ^ (((row) & 7) << 4)))
#define KPSWZ(row, colB) ((row) * 128 + ((colB) ^ ((((row) >> 1) & 7) << 4)))
#define SBAR() __builtin_amdgcn_sched_barrier(0)
__device__ __forceinline__ int v_st(int k, int c) { const int kk = (k & ~0xC) | ((k & 4) << 1) | ((k & 8) >> 1); return ((kk >> 3) * 4 + (c >> 5)) * 512 + ((kk & 7) * 32 + (c & 31)) * 2; }
__device__ __forceinline__ int v_rd_base(int lane) { return ((lane & 3) << 3) | (((lane >> 2) & 3) << 6) | (((lane >> 4) & 1) << 5) | (((lane >> 5) & 1) << 8); }
constexpr int v_rd_off(int d0, int ks, int half) { return d0 * 512 + ks * 4096 + half * 2048; }
__device__ __forceinline__ int crow(int r, int hi) { return (r & 3) + 8 * (r >> 2) + 4 * hi; }
__device__ __forceinline__ unsigned cvtpk(float lo, float hi) { unsigned r; asm volatile("v_cvt_pk_bf16_f32 %0, %1, %2" : "=v"(r) : "v"(lo), "v"(hi)); return r; }

__device__ __forceinline__ void mask_tile(f32x16& p0, f32x16& p1, int dq) {
    const float NEG = -__builtin_inff();
#pragma unroll
    for (int r = 0; r < 16; ++r) { const int c = (r & 3) + 8 * (r >> 2);
        if (dq - c < 0) p0[r] = NEG;
        if (dq - c - 32 < 0) p1[r] = NEG; }
}
__device__ __forceinline__ void partialSM(f32x16& p0, f32x16& p1, float& m_reg, float& mn, float& alpha) {
    float pmax = p0[0];
#pragma unroll
    for (int r = 1; r < 16; ++r) pmax = fmaxf(pmax, p0[r]);
#pragma unroll
    for (int r = 0; r < 16; ++r) pmax = fmaxf(pmax, p1[r]);
    { auto rr = __builtin_amdgcn_permlane32_swap(__float_as_uint(pmax), __float_as_uint(pmax), false, false);
      pmax = fmaxf(__uint_as_float(rr[0]), __uint_as_float(rr[1])); }
    mn = fmaxf(m_reg, pmax); alpha = __builtin_amdgcn_exp2f((m_reg - mn) * C2); m_reg = mn;
    const float mnL = -mn * C2;
#pragma unroll
    for (int r = 0; r < 16; ++r) p0[r] = __builtin_amdgcn_exp2f(fmaf(p0[r], C2, mnL));
#pragma unroll
    for (int r = 0; r < 16; ++r) p1[r] = __builtin_amdgcn_exp2f(fmaf(p1[r], C2, mnL));
}
__device__ __forceinline__ void finishSM(f32x16& p0, f32x16& p1, float alpha, float& l_reg, bf16x8& pa0, bf16x8& pa1, bf16x8& pa2, bf16x8& pa3) {
    float ps = 0;
#pragma unroll
    for (int r = 0; r < 16; ++r) ps += p0[r];
#pragma unroll
    for (int r = 0; r < 16; ++r) ps += p1[r];
    { auto rr = __builtin_amdgcn_permlane32_swap(__float_as_uint(ps), __float_as_uint(ps), false, false);
      ps = __uint_as_float(rr[0]) + __uint_as_float(rr[1]); }
    l_reg = l_reg * alpha + ps;
#define PK4(P, B_, OUT) do { unsigned a0 = cvtpk(P[B_+0], P[B_+1]), a1 = cvtpk(P[B_+2], P[B_+3]);                          \
        unsigned b0 = cvtpk(P[B_+4], P[B_+5]), b1 = cvtpk(P[B_+6], P[B_+7]);                                             \
        auto r0 = __builtin_amdgcn_permlane32_swap(a0, b0, false, false); auto r1 = __builtin_amdgcn_permlane32_swap(a1, b1, false, false); \
        v4u w = {r0[0], r1[0], r0[1], r1[1]}; OUT = *reinterpret_cast<bf16x8*>(&w); } while (0)
    PK4(p0, 0, pa0); PK4(p0, 8, pa1); PK4(p1, 0, pa2); PK4(p1, 8, pa3);
#undef PK4
}
__device__ __forceinline__ void qkt(f32x16& p0, f32x16& p1, LAS unsigned char* lds  , int r32, int hi, const bf16x8* qr) {
    p0 = f32x16{}; p1 = f32x16{};
    const LAS unsigned char* kb[4];
#pragma unroll
    for (int dd = 0; dd < 4; ++dd) kb[dd] = lds + K_OFF + KSWZ(r32, (dd * 16 + hi * 8) * 2);
#pragma unroll
    for (int d0 = 0; d0 < 8; ++d0) { const LAS unsigned char* a = kb[d0 & 3] + (d0 >> 2) * 128;
        const bf16x8 b0 = *(const LAS bf16x8*)(a);
        const bf16x8 b1 = *(const LAS bf16x8*)(a + 32 * 256);
        p0 = __builtin_amdgcn_mfma_f32_32x32x16_bf16(b0, qr[d0], p0, 0, 0, 0);
        p1 = __builtin_amdgcn_mfma_f32_32x32x16_bf16(b1, qr[d0], p1, 0, 0, 0); }
#pragma unroll
    for (int e = 0; e < 4; ++e) { const LAS unsigned char* a = lds + P_OFF + KPSWZ(r32, (e * 2 + hi) * 16);
        const bf16x8 b0 = *(const LAS bf16x8*)(a);
        const bf16x8 b1 = *(const LAS bf16x8*)(a + 32 * 128);
        p0 = __builtin_amdgcn_mfma_f32_32x32x16_bf16(b0, qr[8 + e], p0, 0, 0, 0);
        p1 = __builtin_amdgcn_mfma_f32_32x32x16_bf16(b1, qr[8 + e], p1, 0, 0, 0); }
}
__device__ __forceinline__ void pv_tile(f32x16* o, int vb0  , bf16x8 pa0, bf16x8 pa1, bf16x8 pa2, bf16x8 pa3) {
#define TRRD(dst, off) asm volatile("ds_read_b64_tr_b16 %0, %1 offset:%2" : "=&v"(dst) : "v"(vb0), "i"(off) : "memory")
#define PV_D0(d0) do { s16x4 l0, l1, l2, l3, h0, h1, h2, h3; constexpr int b_ = V_OFF + v_rd_off(d0, 0, 0); \
        TRRD(l0, b_); TRRD(h0, b_ + 2048); TRRD(l1, b_ + 4096); TRRD(h1, b_ + 6144); TRRD(l2, b_ + 8192); TRRD(h2, b_ + 10240); TRRD(l3, b_ + 12288); TRRD(h3, b_ + 14336); \
        asm volatile("s_waitcnt lgkmcnt(0)" ::: "memory"); SBAR();   \
        o[d0] = __builtin_amdgcn_mfma_f32_32x32x16_bf16(pa0, (bf16x8){l0[0], l0[1], l0[2], l0[3], h0[0], h0[1], h0[2], h0[3]}, o[d0], 0, 0, 0);   \
        o[d0] = __builtin_amdgcn_mfma_f32_32x32x16_bf16(pa1, (bf16x8){l1[0], l1[1], l1[2], l1[3], h1[0], h1[1], h1[2], h1[3]}, o[d0], 0, 0, 0);   \
        o[d0] = __builtin_amdgcn_mfma_f32_32x32x16_bf16(pa2, (bf16x8){l2[0], l2[1], l2[2], l2[3], h2[0], h2[1], h2[2], h2[3]}, o[d0], 0, 0, 0);   \
        o[d0] = __builtin_amdgcn_mfma_f32_32x32x16_bf16(pa3, (bf16x8){l3[0], l3[1], l3[2], l3[3], h3[0], h3[1], h3[2], h3[3]}, o[d0], 0, 0, 0); } while (0)
    PV_D0(0); PV_D0(1); PV_D0(2); PV_D0(3);
#undef PV_D0
#undef TRRD
}

__device__ __forceinline__ void attn_unit(LAS unsigned char* lds, int b, int h, int qb, const bf16* Q  , const bf16* KV  , const bf16* KPE  ,
                                          const float* ROPE  , bf16* O  , const int wave_) {
    int tid_ = wave_ * 64 + lane_id_now(); asm volatile("" : "+v"(tid_));
    const int tid = tid_, wid = __builtin_amdgcn_readfirstlane(tid >> 6), lane = tid & 63, r32 = lane & 31, hi = lane >> 5;
    const int NT = ((15 - qb) * 128 + 128) / KVBLK;
    const int qlo = (wid < 4 ? qb * 128 + wid * 32 : (15 - qb) * 128 + (wid - 4) * 32), qm = qlo + r32 - 4 * hi;
    const size_t tok0 = (size_t)b * SEQ;
    bf16x8 qr[12];
    { const size_t t = tok0 + qlo + r32; const bf16* qp = Q + t * 1536 + h * 192 + hi * 8;
#pragma unroll
      for (int d0 = 0; d0 < 12; ++d0) qr[d0] = *(const bf16x8*)(qp + d0 * 16);
      const float* rp = ROPE + t * 64 + hi * 8;
#pragma unroll
      for (int e = 0; e < 2; ++e) {
          const f32x4 c0 = *(const f32x4*)(rp + 16 * e), c1 = *(const f32x4*)(rp + 16 * e + 4), s0 = *(const f32x4*)(rp + 32 + 16 * e), s1 = *(const f32x4*)(rp + 32 + 16 * e + 4);
          const v4u xa = *reinterpret_cast<v4u*>(&qr[8 + e]), xb = *reinterpret_cast<v4u*>(&qr[10 + e]); v4u ya, yb;
#define ROPE2(W, CL, CH, SL, SH) { const float a0 = bflo(xa.W), a1 = bfhi(xa.W), b0 = bflo(xb.W), b1 = bfhi(xb.W); \
          ya.W = cvtpk(a0 * CL - b0 * SL, a1 * CH - b1 * SH); yb.W = cvtpk(b0 * CL + a0 * SL, b1 * CH + a1 * SH); }
          ROPE2(x, c0[0], c0[1], s0[0], s0[1]); ROPE2(y, c0[2], c0[3], s0[2], s0[3]); ROPE2(z, c1[0], c1[1], s1[0], s1[1]); ROPE2(w, c1[2], c1[3], s1[2], s1[3]);
#undef ROPE2
          qr[8 + e] = *reinterpret_cast<bf16x8*>(&ya); qr[10 + e] = *reinterpret_cast<bf16x8*>(&yb); } }
    const int vb0 = (int)(uintptr_t)(lds) + v_rd_base(lane);
    LAS float* wsf = (LAS float*)(lds + W_OFF) + wid * 64; LAS float* li_l = wsf; LAS float* al_l = wsf + 32;
    unsigned so[5];
#pragma unroll
    for (int p = 0; p < 2; ++p) { const int s = p * 512 + tid;
        { const int sub = s >> 5, within = s & 31, kk = (sub >> 2) * 8 + (within >> 2), k = (kk & ~0xC) | ((kk & 4) << 1) | ((kk & 8) >> 1), c = (sub & 3) * 32 + (within & 3) * 8;
          so[p] = (unsigned)(k * 2048 + h * 256 + 128 + c); }
        { const int row = s >> 4, chunk = (s & 15) ^ (row & 7); so[2 + p] = (unsigned)(row * 2048 + h * 256 + chunk * 8); } }
    { const int row = tid >> 3, chunk = (tid & 7) ^ ((row >> 1) & 7); so[4] = (unsigned)(row * 64 + chunk * 8); }
    const bf16* KVt = KV + tok0 * 2048; const bf16* KPt = KPE + tok0 * 64;
#define AISSUE(tile, bufoff) do { const bf16* kv_ = KVt + (size_t)(tile) * (KVBLK * 2048); const bf16* kp_ = KPt + (size_t)(tile) * (KVBLK * 64); \
        __builtin_amdgcn_global_load_lds((const unsigned*)(kv_ + so[0]), (LAS unsigned*)(lds + (bufoff) + V_OFF + wid * 1024), 16, 0, 0); \
        __builtin_amdgcn_global_load_lds((const unsigned*)(kv_ + so[1]), (LAS unsigned*)(lds + (bufoff) + V_OFF + 8192 + wid * 1024), 16, 0, 0); \
        __builtin_amdgcn_global_load_lds((const unsigned*)(kv_ + so[2]), (LAS unsigned*)(lds + (bufoff) + K_OFF + wid * 1024), 16, 0, 0); \
        __builtin_amdgcn_global_load_lds((const unsigned*)(kv_ + so[3]), (LAS unsigned*)(lds + (bufoff) + K_OFF + 8192 + wid * 1024), 16, 0, 0); \
        __builtin_amdgcn_global_load_lds((const unsigned*)(kp_ + so[4]), (LAS unsigned*)(lds + (bufoff) + P_OFF + wid * 1024), 16, 0, 0); } while (0)
    float m_reg = -1e30f, l_reg = 0.f; f32x16 o[4] = {};
    f32x16 p0, p1; float mn, alpha; bf16x8 pa0, pa1, pa2, pa3;
    asm volatile("s_waitcnt vmcnt(0)" ::: "memory");
    AISSUE(0, 0); AISSUE(1, BUFB);
    int bc = 0, bl = 2 * BUFB;
    for (int t = 0; t < NT; ++t) {
        asm volatile("s_waitcnt vmcnt(5)" ::: "memory"); __builtin_amdgcn_s_barrier();
        { const int tn = (t + 2 < NT) ? t + 2 : NT - 1; AISSUE(tn, bl); }
        const int kb_ = t * KVBLK;
        if (kb_ <= qlo + 31) {
            SBAR(); qkt(p0, p1, lds + bc, r32, hi, qr);
            if (kb_ + KVBLK - 1 > qlo) mask_tile(p0, p1, qm - kb_);
            partialSM(p0, p1, m_reg, mn, alpha);
            if (__any(alpha < 1.f)) { if (hi == 0) al_l[r32] = alpha; LDS_WAIT();
#pragma unroll
                for (int d_ = 0; d_ < 4; ++d_)
#pragma unroll
                    for (int r = 0; r < 16; ++r) o[d_][r] *= al_l[crow(r, hi)]; }
            finishSM(p0, p1, alpha, l_reg, pa0, pa1, pa2, pa3); SBAR();
            pv_tile(o, vb0 + bc, pa0, pa1, pa2, pa3); }
        bc = (bc == 2 * BUFB) ? 0 : bc + BUFB; bl = (bl == 2 * BUFB) ? 0 : bl + BUFB;
    }
#undef AISSUE
    asm volatile("s_waitcnt vmcnt(0)" ::: "memory");
    if (hi == 0) li_l[r32] = l_reg; LDS_WAIT();
    bf16* Ow = O + (tok0 + qlo) * 1024 + h * 128;
#pragma unroll
    for (int r = 0; r < 16; ++r) { const int orow = crow(r, hi); const float rl = __builtin_amdgcn_rcpf(li_l[orow]);
#pragma unroll
        for (int d0 = 0; d0 < 4; ++d0) { const float v = o[d0][r] * rl; const float vn = __shfl_xor(v, 1);
            if ((r32 & 1) == 0) *(unsigned*)(Ow + (size_t)orow * 1024 + d0 * 32 + r32) = cvtpk(v, vn); } }
    __syncthreads();
}
#undef KSWZ
#undef KPSWZ
#undef SBAR
}

struct Args { const void* in[36]; float* out; unsigned char* ws; int ph_lo, ph_hi, li, pad; };
constexpr int N_PHASES = 15;

__device__ __forceinline__ void mla_thin_token(int t, int lane, const bf16* projb, const float* qg, const float* kvg, const int* pos, bf16* cqn, bf16* ckvn, bf16* kpe, float* rope) {
    const unsigned* pr = (const unsigned*)(projb + (size_t)t * PJW);
    unsigned wq[3], wk[2]; float sq = 0.f, sk = 0.f;
    v2f gq[3], gk[2];
#pragma unroll
    for (int j = 0; j < 3; ++j) { wq[j] = pr[lane + 64 * j]; gq[j] = *(const v2f*)(qg + 2 * (lane + 64 * j)); }
#pragma unroll
    for (int j = 0; j < 2; ++j) { wk[j] = pr[192 + lane + 64 * j]; gk[j] = *(const v2f*)(kvg + 2 * (lane + 64 * j)); }
    const int pos_t = pos[t]; const bf16* kp = projb + (size_t)t * PJW + 640; const float x1 = bf2f(kp[lane & 31]), x2 = bf2f(kp[(lane & 31) + 32]);
#pragma unroll
    for (int j = 0; j < 3; ++j) { const float a = bflo(wq[j]), b = bfhi(wq[j]); sq += a * a + b * b; }
#pragma unroll
    for (int j = 0; j < 2; ++j) { const float a = bflo(wk[j]), b = bfhi(wk[j]); sk += a * a + b * b; }
    const float rq = rsqrtf(wave_sum(sq) * (1.f / QL) + EPS), rk = rsqrtf(wave_sum(sk) * (1.f / KVL) + EPS);
#pragma unroll
    for (int j = 0; j < 3; ++j) ((unsigned*)(cqn + (size_t)t * QL))[lane + 64 * j] = pk2(bflo(wq[j]) * rq * gq[j][0], bfhi(wq[j]) * rq * gq[j][1]);
#pragma unroll
    for (int j = 0; j < 2; ++j) ((unsigned*)(ckvn + (size_t)t * KVL))[lane + 64 * j] = pk2(bflo(wk[j]) * rk * gk[j][0], bfhi(wk[j]) * rk * gk[j][1]);
    if (lane < 32) {
        const float inv = 1.0f / powf(10000.0f, (float)(2 * lane) / 64.0f), ang = (float)pos_t * inv, c = cosf(ang), s = sinf(ang);
        rope[(size_t)t * 64 + lane] = c; rope[(size_t)t * 64 + 32 + lane] = s;
        kpe[(size_t)t * 64 + lane] = (bf16)f2bf(x1 * c - x2 * s); kpe[(size_t)t * 64 + 32 + lane] = (bf16)f2bf(x2 * c + x1 * s);
    }
}
__device__ __forceinline__ void s5_scan_group(int g, LAS unsigned char* lds, const float* Sc, const float* AP32, bf16* Ag, int tid) {
    LAS f32x4* S4 = (LAS f32x4*)lds;
    const GAS f32x4* src = (const GAS f32x4*)(Sc + (size_t)g * 256 * 128);
#pragma unroll 16
    for (int i = tid; i < 256 * 32; i += NTHR) S4[i] = src[i];
    __syncthreads();
    if (tid < 256) { const int b = tid >> 6, p = tid & 63; const float ar = AP32[(g * 64 + p) * 2], ai = AP32[(g * 64 + p) * 2 + 1]; float xr = 0.f, xi = 0.f;
        const LAS float* S = (const LAS float*)lds;
        for (int ch = 0; ch < NCH; ++ch) { const int row = b * NCH + ch; bf16* o = Ag + ((size_t)g * 256 + row) * AGW + 512;
            o[p] = (bf16)f2bf(xr); o[64 + p] = (bf16)f2bf(xi);
            const float sr = S[row * 128 + p], si = S[row * 128 + 64 + p];
            const float nr = ar * xr - ai * xi + sr, ni = ar * xi + ai * xr + si; xr = nr; xi = ni; } }
    VM_WAIT(); __syncthreads();
}

__device__ __forceinline__ void route_tile(int tile, LAS unsigned char* lds, const float* X2, const float* ssq2, float* rstd2, const bf16* WRH, const bf16* WRL, const float* brt,
                                           unsigned* counts, int* SELE, int* SELP, float* SELG, int* LIST, int tid) {
    typedef float f32x16 __attribute__((ext_vector_type(16)));
    const int wid = tid >> 6, lane = tid & 63, r32 = lane & 31, hi = lane >> 5, t0 = tile * 32;
    f32x16 acc = {};
    const float* xp = X2 + (size_t)(t0 + r32) * D + wid * 256 + hi * 8;
    const bf16* wh = WRH + (size_t)r32 * D + wid * 256 + hi * 8; const bf16* wl = WRL + (size_t)r32 * D + wid * 256 + hi * 8;
#pragma unroll 4
    for (int s = 0; s < 16; ++s) {
        const f32x4 a = *(const f32x4*)(xp + 16 * s), b = *(const f32x4*)(xp + 16 * s + 4);
        float xv[8] = {a[0], a[1], a[2], a[3], b[0], b[1], b[2], b[3]}; unsigned hh[8], ll[8];
#pragma unroll
        for (int j = 0; j < 8; ++j) { hh[j] = f2bf(xv[j]); ll[j] = f2bf(xv[j] - __builtin_bit_cast(float, hh[j] << 16)); }
        v4u ph = {hh[0] | (hh[1] << 16), hh[2] | (hh[3] << 16), hh[4] | (hh[5] << 16), hh[6] | (hh[7] << 16)}, pl = {ll[0] | (ll[1] << 16), ll[2] | (ll[3] << 16), ll[4] | (ll[5] << 16), ll[6] | (ll[7] << 16)};
        const bf16x8 xh = *reinterpret_cast<bf16x8*>(&ph), xl = *reinterpret_cast<bf16x8*>(&pl);
        const bf16x8 bh = *(const bf16x8*)(wh + 16 * s), bl = *(const bf16x8*)(wl + 16 * s);
        acc = __builtin_amdgcn_mfma_f32_32x32x16_bf16(xh, bh, acc, 0, 0, 0);
        acc = __builtin_amdgcn_mfma_f32_32x32x16_bf16(xl, bh, acc, 0, 0, 0);
        acc = __builtin_amdgcn_mfma_f32_32x32x16_bf16(xh, bl, acc, 0, 0, 0);
    }
    LAS float* red = (LAS float*)lds;
    LAS float* lg = red + 8 * 32 * 33;
#pragma unroll
    for (int r = 0; r < 16; ++r) red[(wid * 32 + ((r & 3) + 8 * (r >> 2) + 4 * hi)) * 33 + r32] = acc[r];
    __syncthreads();
    for (int idx = tid; idx < 1024; idx += NTHR) { const int tk = idx >> 5, e = idx & 31; float s = 0.f;
#pragma unroll
        for (int w = 0; w < 8; ++w) s += red[(w * 32 + tk) * 33 + e];
        lg[tk * 33 + e] = s; }
    __syncthreads();
    if (tid < 32) { const int t = t0 + tid; float sq = 0.f;
#pragma unroll
        for (int k = 0; k < 8; ++k) { const f32x4 v = *(const f32x4*)(ssq2 + (size_t)t * 32 + 4 * k); sq += v[0]; sq += v[1]; sq += v[2]; sq += v[3]; }
        const float rs = rsqrtf(sq * (1.f / D) + EPS); rstd2[t] = rs;
        float l[E];
#pragma unroll
        for (int e = 0; e < E; ++e) l[e] = lg[tid * 33 + e] * rs + brt[e];
        float tv[TOPK]; int ti[TOPK];
#pragma unroll
        for (int k = 0; k < TOPK; ++k) { float best = -INFINITY; int bi = 0;
#pragma unroll
            for (int e = 0; e < E; ++e) if (l[e] > best) { best = l[e]; bi = e; }
            tv[k] = best; ti[k] = bi;
#pragma unroll
            for (int e = 0; e < E; ++e) if (e == bi) l[e] = -INFINITY; }
        float sum = 0.f, ex[TOPK];
#pragma unroll
        for (int k = 0; k < TOPK; ++k) { ex[k] = expf(tv[k] - tv[0]); sum += ex[k]; }
        LAS unsigned* lcnt = (LAS unsigned*)(lg + 32 * 33); LAS unsigned* lbase = lcnt + 32;
        lcnt[tid] = 0u; LDS_WAIT();
        int lp[TOPK];
#pragma unroll
        for (int k = 0; k < TOPK; ++k) lp[k] = (int)__hip_atomic_fetch_add(&lcnt[ti[k]], 1u, __ATOMIC_RELAXED, __HIP_MEMORY_SCOPE_WORKGROUP);
        LDS_WAIT();
        { const unsigned n = lcnt[tid]; lbase[tid] = n ? atomicAdd(&counts[tid * CNT_STRIDE], n) : 0u; }
        LDS_WAIT();
#pragma unroll
        for (int k = 0; k < TOPK; ++k) { const int pos = (int)lbase[ti[k]] + lp[k];
            SELE[t * TOPK + k] = ti[k]; SELP[t * TOPK + k] = pos; SELG[t * TOPK + k] = ex[k] / sum; LIST[(size_t)ti[k] * T + pos] = t; } }
    __syncthreads();
}

__global__ void __launch_bounds__(NTHR, 2) fwd(Args args) {
    extern __shared__ __attribute__((aligned(16))) unsigned char lds_raw[];
    LAS unsigned char* lds = (LAS unsigned char*)lds_raw;
    volatile LAS unsigned* MISC = (volatile LAS unsigned*)(lds + MISC_OFF);
    int wave_ = __builtin_amdgcn_readfirstlane((int)threadIdx.x >> 6); asm volatile("" : "+s"(wave_));
    const int wave = wave_;
#define LANE_NOW() ({ int l_ = lane_id_now(); asm volatile("" : "+v"(l_)); l_; })
    const int NG = gridDim.x, bx = blockIdx.x;
    unsigned char* ws = args.ws;
    unsigned* ctl = (unsigned*)(ws + WS_CTL);
    { const int tid = wave * 64 + LANE_NOW();
      for (int u = tid; u < (LDS_BYTES - LDSCTL_OFF) / 4; u += NTHR) ((LAS unsigned*)(lds + LDSCTL_OFF))[u] = 0u; }
    __syncthreads();
    const int lo = args.ph_lo, hi = args.ph_hi;
    const bool multi = (hi - lo) > 1;
    XcdBarrier bar; bar.bar = ctl + CW_BAR + args.li * XCD_BAR_WORDS; bar.x = 0; bar.st = nullptr; bar.wave = wave;
    if (multi) bar = xcd_barrier_post(ctl + CW_BAR + args.li * XCD_BAR_WORDS, MISC + 8, wave);
#define IN(k) (lo <= (k) && (k) < hi)
#define BOTH(k) (IN(k) && IN((k) + 1))
#define GRID_BAR() xcd_barrier(bar)
#define GRID_BAR_CV() xcd_barrier_cv(bar, cvw)
#if defined(PROBE_PHASE) || defined(PROBE_RANGE)
#define PRB(p, T_) ((args.li == 1) ? (T_)(ws + WS_END1 + (8u << 20)) : (T_)(p))
#else
#define PRB(p, T_) ((T_)(p))
#endif
#define INP(i) ((const float*)args.in[i])
#define WSP(T_, off) ((T_*)(ws + (off)))
    const CvWork cvw{INP(31), INP(28), WSP(unsigned char, WS_WUP), (volatile LAS int*)(MISC + 16), MISC + 12, ctl + CW_CVQ, wave};
    if (IN(0)) {
        const int lane = LANE_NOW(), tid = wave * 64 + lane; (void)tid; (void)lane;
        const int gw = bx * NWAVES + wave, NGW = NG * NWAVES;
        constexpr int I_IN = (D / 64) * (INC / 64), I_QB = (QL / 64) * (1536 / 64), I_KVB = (KVL / 64) * (2048 / 64), I_GLU = (SSMW / 64) * (SSMW / 64), I_SQ = (D / 64) * (D / 64);
        constexpr int I_UP = (D / 64) * (2 * FF / 64), I_DN = (FF / 64) * (D / 64);
#define TI_MAT(W_, K_, N_, WT_, G_) { const int nb_ = (N_) / 64, kb = r / nb_, nbi = r % nb_; d.src = (W_) + (size_t)(64 * kb) * (N_) + 64 * nbi; d.dst = (WT_) + (size_t)(64 * nbi) * (K_) + 64 * kb; \
            d.gain = (G_) + 64 * kb; d.N = (N_); d.ldk = (K_); }
#define TI_MAT8(W_, K_, N_, WT_, G_) { const int nb_ = (N_) / 32, kb = r / nb_, nbi = r % nb_; d.src = (W_) + (size_t)(128 * kb) * (N_) + 32 * nbi; d.dst = (bf16*)((unsigned char*)(WT_) + (size_t)(32 * nbi) * (K_) + 128 * kb); \
            d.gain = (G_) + 128 * kb; d.N = (N_); d.ldk = (K_); }
        auto dec_up = [&](int it) { TItem d; int r = it; const int e = r / I_UP; r -= e * I_UP; TI_MAT8(INP(31) + (size_t)e * D * 2 * FF, D, 2 * FF, WSP(unsigned char, WS_WUP) + (size_t)e * 2 * FF * D, INP(28)); return d; };
        auto dec_dn = [&](int it) { TItem d; int r = it; const int e = r / I_DN; r -= e * I_DN; TI_MAT8(INP(33) + (size_t)e * FF * D, FF, D, WSP(unsigned char, WS_WDN) + (size_t)e * D * FF, INP(28)); return d; };
        auto dec_xq = [&](int it) { TItem d; int r = it; TI_MAT8(INP(24), D, D, WSP(unsigned char, WS_WXQ8), INP(22)); return d; };
        auto dec_xo = [&](int it) { TItem d; int r = it; TI_MAT8(INP(27), D, D, WSP(unsigned char, WS_WXO8), INP(22)); return d; };
        auto dec_16 = [&](int it) { TItem d; int r = it;
            if (r < I_IN) { TI_MAT(INP(4), D, INC, WSP(bf16, WS_WIN), INP(22)); return d; } r -= I_IN;
            if (r < I_QB) { TI_MAT(INP(6), QL, 1536, WSP(bf16, WS_WQB), INP(22)); return d; } r -= I_QB;
            if (r < I_KVB) { TI_MAT(INP(8), KVL, 2048, WSP(bf16, WS_WKVB), INP(22)); return d; } r -= I_KVB;
            if (r < I_GLU) { TI_MAT(INP(17), SSMW, SSMW, WSP(bf16, WS_WGLU), INP(22)); return d; } r -= I_GLU;
            if (r < I_SQ) { TI_MAT(INP(25), D, D, WSP(bf16, WS_WXK), INP(22)); return d; } r -= I_SQ;
            if (r < I_SQ) { TI_MAT(INP(26), D, D, WSP(bf16, WS_WXV), INP(22)); return d; } r -= I_SQ;
            TI_MAT(INP(21), D, D, WSP(bf16, WS_WOUT), INP(22)); return d; };
#undef TI_MAT
#undef TI_MAT8
        if (bx < G) { s5_setup(bx, lds, INP(9), INP(10), INP(11), INP(12), INP(13), INP(14), INP(15), WSP(bf16, WS_BTY), WSP(bf16, WS_BTS), WSP(float, WS_AP32), tid); }
        else {
            const int gw = (bx - G) * NWAVES + wave, NGW = (NG - G) * NWAVES, gt = (bx - G) * NTHR + tid, NGT = (NG - G) * NTHR;
            TSTREAM(I_SQ, dec_xq, titem8_load<true>, titem8_store<true>);
            TSTREAM(I_SQ, dec_xo, titem8_load<false>, titem8_store<false>);
            TSTREAM(I_IN + I_QB + I_KVB + I_GLU + 3 * I_SQ, dec_16, titem_load<false>, titem_store<false>);
            for (int i = gt; i < E * D; i += NGT) { const int e = i / D, k = i % D; const float w = INP(29)[(size_t)k * E + e] * INP(28)[k]; const unsigned h = f2bf(w);
                WSP(bf16, WS_WRH)[i] = (bf16)h; WSP(bf16, WS_WRL)[i] = (bf16)f2bf(w - __builtin_bit_cast(float, h << 16)); }
            for (int i = gt; i < (INCP - INC) * D / 8; i += NGT) ((GAS v4u*)(WSP(bf16, WS_WIN) + (size_t)INC * D))[i] = (v4u){0u, 0u, 0u, 0u};
            for (int m = gw; m < T; m += NGW) rms_row_to_bf16(INP(0) + (size_t)m * D, INP(3), WSP(bf16, WS_HB) + (size_t)m * D, lane);
            for (int m = gw; m < TM; m += NGW) rms_row_to_bf16(INP(1) + (size_t)m * D, INP(23), WSP(bf16, WS_MEMN) + (size_t)m * D, lane);
        }
        if (BOTH(0)) GRID_BAR_CV();
    }
    if (IN(1)) {
        const int lane = LANE_NOW(), tid = wave * 64 + lane; (void)tid; (void)lane;
        { pg8::Geo geo{D * 2, D * 2, 128L * D * 2, 128L * D * 2, D / 64};
          pg8::Sched S; S.init(0, T / 256, INCP / 256, 1, NG, bx, WSP(bf16, WS_HB), 256L * D * 2, 0, WSP(bf16, WS_WIN), 256L * D * 2, 0);
          EpiProj Ep{WSP(bf16, WS_PROJB), WSP(bf16, WS_AG)};
          pg8::gemm_phase<EpiProj, pg8::Sched, true, true>(lds + RING_OFF, geo, S, Ep, wave); }
        { pg8::Geo geo{D * 2, D * 2, 128L * D * 2, 128L * D * 2, D / 64};
          const int c = (bx >= 224) ? bx - 224 : (1 << 30);
          pg8::Sched S; S.init(1, TM / 256, D / 256, 1, 32, c, WSP(bf16, WS_MEMN), 256L * D * 2, 0, WSP(bf16, WS_WXK), 256L * D * 2, 0);
          EpiPlain<false> Ep{WSP(bf16, WS_XK), D, 1, 0, 0, nullptr};
          pg8::gemm_phase<EpiPlain<false>, pg8::Sched, true, true>(lds + RING_OFF, geo, S, Ep, wave); }
        if (BOTH(1)) GRID_BAR_CV();
    }
    if (IN(2)) {
        const int lane = LANE_NOW(), tid = wave * 64 + lane; (void)tid; (void)lane;
        { const int gw = bx * NWAVES + wave, NGW = NG * NWAVES;
          for (int t = gw; t < T; t += NGW) mla_thin_token(t, lane, WSP(bf16, WS_PROJB), INP(5), INP(7), ((const int*)args.in[2]), WSP(bf16, WS_CQN), WSP(bf16, WS_CKVN), WSP(bf16, WS_KPE), WSP(float, WS_ROPE)); }
        __syncthreads();
        { pg8::Geo geo{AGW * 2, 512 * 2, 128L * AGW * 2, 0, 512 / 64};
          pg8::Sched S; S.init(1, 1, 1, G, NG, bx, WSP(bf16, WS_AG), 0, 256L * AGW * 2, WSP(bf16, WS_BTS), 0, 128L * 512 * 2);
          EpiS5State Ep{WSP(float, WS_SC)};
          pg8::gemm_phase<EpiS5State, pg8::Sched, true, true>(lds + RING_OFF, geo, S, Ep, wave); }
        { pg8::Geo geo{D * 2, D * 2, 128L * D * 2, 128L * D * 2, D / 64};
          const int c = (bx >= 64 && bx < 96) ? bx - 64 : (1 << 30);
          pg8::Sched S; S.init(1, D / 256, TM / 256, 1, 32, c, WSP(bf16, WS_WXV), 256L * D * 2, 0, WSP(bf16, WS_MEMN), 256L * D * 2, 0);
          EpiPlain<false> Ep{WSP(bf16, WS_XVT), TM, 1, 0, 0, nullptr};
          pg8::gemm_phase<EpiPlain<false>, pg8::Sched, true, true>(lds + RING_OFF, geo, S, Ep, wave); }
        if (BOTH(2)) GRID_BAR_CV();
    }
    if (IN(3)) {
        const int lane = LANE_NOW(), tid = wave * 64 + lane; (void)tid; (void)lane;
        if (bx < 128) {
            s5_scan_group(bx >> 1, lds, WSP(float, WS_SC), WSP(float, WS_AP32), WSP(bf16, WS_AG), tid);
            pg8::Geo geo{AGW * 2, AGW * 2, 128L * AGW * 2, 128L * AGW * 2, AGW / 64};
            pg8::Sched S; S.init(1, 1, 2, G, 128, bx, WSP(bf16, WS_AG), 0, 256L * AGW * 2, WSP(bf16, WS_BTY), 256L * AGW * 2, 512L * AGW * 2);
            EpiS5Y Ep{WSP(bf16, WS_AG), INP(16), WSP(bf16, WS_Y)};
            pg8::gemm_phase<EpiS5Y, pg8::Sched, true, true>(lds + RING_OFF, geo, S, Ep, wave);
        }
        { pg8::Geo geo{KVL * 2, KVL * 2, 128L * KVL * 2, 128L * KVL * 2, KVL / 64};
          pg8::Sched S; S.init(0, T / 256, 2048 / 256, 1, NG, bx, WSP(bf16, WS_CKVN), 256L * KVL * 2, 0, WSP(bf16, WS_WKVB), 256L * KVL * 2, 0);
          EpiPlain<false> Ep{WSP(bf16, WS_KV), 2048, 1, 0, 0, nullptr};
          pg8::gemm_phase<EpiPlain<false>, pg8::Sched, true, true>(lds + RING_OFF, geo, S, Ep, wave); }
        { pg8::Geo geo{QL * 2, QL * 2, 128L * QL * 2, 128L * QL * 2, QL / 64};
          const int c = (bx >= 128) ? bx - 128 : (1 << 30);
          pg8::Sched S; S.init(0, T / 256, 1536 / 256, 1, 128, c, WSP(bf16, WS_CQN), 256L * QL * 2, 0, WSP(bf16, WS_WQB), 256L * QL * 2, 0);
          EpiPlain<false> Ep{WSP(bf16, WS_Q), 1536, 1, 0, 0, nullptr};
          pg8::gemm_phase<EpiPlain<false>, pg8::Sched, true, true>(lds + RING_OFF, geo, S, Ep, wave); }
        if (BOTH(3)) GRID_BAR_CV();
    }
    if (IN(4)) {
        const int lane = LANE_NOW(), tid = wave * 64 + lane; (void)tid; (void)lane;
        const int vcu = (NG % 8 == 0) ? (bx % 8) * (NG / 8) + bx / 8 : bx;
        if (vcu < BATCH * H * 8) { const int L = vcu, bh = L >> 3, qb = L & 7;
            mla::attn_unit(lds + RING_OFF, bh >> 3, bh & 7, qb, WSP(bf16, WS_Q), WSP(bf16, WS_KV), WSP(bf16, WS_KPE), WSP(float, WS_ROPE), WSP(bf16, WS_ATTO), wave); }
        { const int qb = vcu & 7, c = (vcu < 256 && qb >= 4) ? (vcu >> 3) * 4 + (qb - 4) : (1 << 30);
          pg8::Geo geo{SSMW * 2, SSMW * 2, 128L * SSMW * 2, 128L * SSMW * 2, SSMW / 64};
          pg8::Sched S; S.init(1, T / 256, SSMW / 256, 1, 128, c, WSP(bf16, WS_Y), 256L * SSMW * 2, 0, WSP(bf16, WS_WGLU), 256L * SSMW * 2, 0);
          EpiGlu Ep{WSP(bf16, WS_Y), INP(18), WSP(bf16, WS_SSMO)};
          pg8::gemm_phase<EpiGlu, pg8::Sched, true, true>(lds + RING_OFF, geo, S, Ep, wave); }
        if (BOTH(4)) GRID_BAR_CV();
    }
    if (IN(5)) {
        const int lane = LANE_NOW(), tid = wave * 64 + lane; (void)tid; (void)lane;
        const int gw = bx * NWAVES + wave, NGW = NG * NWAVES;
        for (int t = gw; t < T; t += NGW) {
#pragma unroll
            for (int half = 0; half < 2; ++half) { const bf16* src = (half ? WSP(bf16, WS_SSMO) : WSP(bf16, WS_ATTO)) + (size_t)t * 1024; const float* gn = half ? INP(20) : INP(19);
                const v4u a = ((const v4u*)src)[lane], b = ((const v4u*)src)[64 + lane];
                f32x4 gpre[4];
#pragma unroll
                for (int jj = 0; jj < 2; ++jj) { const int k0 = (jj * 64 + lane) * 8; gpre[2 * jj] = *(const f32x4*)(gn + k0); gpre[2 * jj + 1] = *(const f32x4*)(gn + k0 + 4); }
                float v[16] = {bflo(a.x), bfhi(a.x), bflo(a.y), bfhi(a.y), bflo(a.z), bfhi(a.z), bflo(a.w), bfhi(a.w), bflo(b.x), bfhi(b.x), bflo(b.y), bfhi(b.y), bflo(b.z), bfhi(b.z), bflo(b.w), bfhi(b.w)};
                float s = 0.f;
#pragma unroll
                for (int e = 0; e < 16; ++e) s += v[e] * v[e];
                const float r = rsqrtf(wave_sum(s) * (1.f / 1024) + EPS);
#pragma unroll
                for (int jj = 0; jj < 2; ++jj) { const int k0 = (jj * 64 + lane) * 8; const f32x4 g0 = gpre[2 * jj], g1 = gpre[2 * jj + 1]; v4u w;
                    w.x = pk2(v[8 * jj + 0] * r * g0[0], v[8 * jj + 1] * r * g0[1]); w.y = pk2(v[8 * jj + 2] * r * g0[2], v[8 * jj + 3] * r * g0[3]);
                    w.z = pk2(v[8 * jj + 4] * r * g1[0], v[8 * jj + 5] * r * g1[1]); w.w = pk2(v[8 * jj + 6] * r * g1[2], v[8 * jj + 7] * r * g1[3]);
                    *(v4u*)(WSP(bf16, WS_MIXED) + (size_t)t * D + half * 1024 + k0) = w; } } }
        if (BOTH(5)) GRID_BAR_CV();
#if defined(PROBE_BAR)
        if (BOTH(5)) { for (int i_ = 0; i_ < 10; ++i_) GRID_BAR(); }
#endif
    }
    if (IN(6)) {
        const int lane = LANE_NOW(), tid = wave * 64 + lane; (void)tid; (void)lane;
        pg8::Geo geo{D * 2, D * 2, 128L * D * 2, 128L * D * 2, D / 64};
        pg8::Sched S; S.init(0, T / 256, D / 256, 1, NG, bx, WSP(bf16, WS_MIXED), 256L * D * 2, 0, WSP(bf16, WS_WOUT), 256L * D * 2, 0);
        EpiResid<> Ep{INP(0), WSP(float, WS_X1), nullptr, WSP(float, WS_SSQP1), WSP(unsigned char, WS_X1F8)};
        pg8::gemm_phase<EpiResid<>, pg8::Sched, true, true>(lds + RING_OFF, geo, S, Ep, wave);
        if (BOTH(6)) GRID_BAR_CV();
    }
    if (IN(7)) {
        const int lane = LANE_NOW(), tid = wave * 64 + lane; (void)tid; (void)lane;
        pg8::Geo geo{D, D, 128L * D, 128L * D, D / 128};
        pg8::Sched S; S.init(0, T / 256, D / 256, 1, NG, bx, WSP(unsigned char, WS_X1F8), 256L * D, 0, WSP(unsigned char, WS_WXQ8), 256L * D, 0);
        LAS float* rt = (LAS float*)(lds + TOK_OFF);
        { pg8::Unit u0; if (S.next(0, u0) && tid < 256) { const float* pp = WSP(float, WS_SSQP1) + (size_t)(u0.pm * 256 + tid) * 32; float sq = 0.f;
#pragma unroll
                for (int k = 0; k < 8; ++k) { const f32x4 v = *(const f32x4*)(pp + 4 * k); sq += v[0]; sq += v[1]; sq += v[2]; sq += v[3]; }
                rt[tid] = rsqrtf(sq * (1.f / D) + EPS); }
            __syncthreads(); }
        EpiPlain<true, true> Ep{WSP(bf16, WS_XQ), D, 1, 0, 0, rt};
        pg8::gemm_phase<EpiPlain<true, true>, pg8::Sched, true, true>(lds + RING_OFF, geo, S, Ep, wave);
        if (BOTH(7)) GRID_BAR_CV();
    }
    if (IN(8)) {
        const int lane = LANE_NOW(), tid = wave * 64 + lane; (void)tid; (void)lane;
        pg8::Geo geo{D * 2, D * 2, 128L * D * 2, 128L * D * 2, XD / 64};
        pg8::Sched S; S.init(1, SEQ / 256, 1, BATCH * XH, NG, bx, WSP(bf16, WS_XQ), 256L * D * 2, (long)SEQ * D * 2, WSP(bf16, WS_XK), 0, (long)MEM * D * 2);
        S.split_z(XH, XD * 2, XD * 2);
        EpiSoftmax Ep{WSP(bf16, WS_PX)};
        pg8::gemm_phase<EpiSoftmax, pg8::Sched, false, true>(lds + RING_OFF, geo, S, Ep, wave);
        if (BOTH(8)) GRID_BAR_CV();
    }
    if (IN(9)) {
        const int lane = LANE_NOW(), tid = wave * 64 + lane; (void)tid; (void)lane;
        pg8::Geo geo{MEM * 2, TM * 2, 128L * MEM * 2, 128L * TM * 2, MEM / 64};
        pg8::Sched S; S.init(1, SEQ / 256, XD / 256, BATCH * XH, NG, bx, WSP(bf16, WS_PX), 256L * MEM * 2, (long)XH * SEQ * MEM * 2, WSP(bf16, WS_XVT), 256L * TM * 2, (long)MEM * 2);
        S.split_z(XH, (long)SEQ * MEM * 2, (long)XD * TM * 2);
        EpiPlain<false, false, true> Ep{(bf16*)WSP(unsigned char, WS_XO8), D, XH, (long)SEQ * D, XD, nullptr};
        pg8::gemm_phase<EpiPlain<false, false, true>, pg8::Sched, true, true>(lds + RING_OFF, geo, S, Ep, wave);
        if (BOTH(9)) GRID_BAR_CV();
    }
    if (IN(10)) {
        const int lane = LANE_NOW(), tid = wave * 64 + lane; (void)tid; (void)lane;
        pg8::Geo geo{D, D, 128L * D, 128L * D, D / 128};
        pg8::Sched S; S.init(0, T / 256, D / 256, 1, NG, bx, WSP(unsigned char, WS_XO8), 256L * D, 0, WSP(unsigned char, WS_WXO8), 256L * D, 0);
        EpiResid<true> Ep{WSP(float, WS_X1), WSP(float, WS_X2), nullptr, WSP(float, WS_SSQP2), WSP(unsigned char, WS_X2F8)};
        pg8::gemm_phase<EpiResid<true>, pg8::Sched, true, true>(lds + RING_OFF, geo, S, Ep, wave);
        if (BOTH(10)) GRID_BAR_CV();
    }
    if (IN(11)) {
        const int lane = LANE_NOW(), tid = wave * 64 + lane; (void)tid; (void)lane;
        for (int tile = bx; tile < T / 32; tile += NG)
            route_tile(tile, lds, WSP(float, WS_X2), WSP(float, WS_SSQP2), WSP(float, WS_RSTD2), WSP(bf16, WS_WRH), WSP(bf16, WS_WRL), INP(30), PRB(ctl + CW_CNT, unsigned*), PRB(WSP(int, WS_SELE), int*), PRB(WSP(int, WS_SELP), int*), PRB(WSP(float, WS_SELG), float*), PRB(WSP(int, WS_LIST), int*) + (args.li == 1 ? (1 << 20) : 0), tid);
        cv_flush(cvw);
        if (BOTH(11)) GRID_BAR();
    }
    if (IN(12)) {
        const int lane = LANE_NOW(), tid = wave * 64 + lane; (void)tid; (void)lane;
        LAS int* blkE = (LAS int*)(lds + BLK_OFF); LAS int* tokTab = (LAS int*)(lds + TOK_OFF);
        const unsigned* counts = ctl + CW_CNT;
        const int NBt = moe_block_table(counts, blkE, tid);
        { int tokv[MAXU / 2];
#pragma unroll
          for (int k = 0; k < MAXU / 2; ++k) { const int i = 2 * k + (tid >> 8), L = i * NG + bx, r = tid & 255; int v = 0;
              if (L < NBt * 16) { const int blk = L >> 4, e = blkE[blk], j = blkE[160 + blk]; if (r < blkE[320 + blk]) v = WSP(int, WS_LIST)[(size_t)e * T + j * 256 + r]; }
              tokv[k] = v; }
#pragma unroll
          for (int k = 0; k < MAXU / 2; ++k) tokTab[(2 * k + (tid >> 8)) * 256 + (tid & 255)] = tokv[k]; }
        __syncthreads();
        pg8::Geo geo{D, D, 0, (long)FF * D, D / 128};
        MoeSchedUpCv S{{NBt, 16, NG, bx, D, (const char*)WSP(unsigned char, WS_X2F8), (const char*)WSP(unsigned char, WS_WUP), 0, (long)2 * FF * D, 128L * D, blkE, tokTab}, INP(33), WSP(unsigned char, WS_WDN), wave};
        EpiMoeUp Ep{blkE, tokTab, WSP(float, WS_RSTD2), INP(32), WSP(unsigned char, WS_ACT)};
        pg8::gemm_phase<EpiMoeUp, MoeSchedUpCv, true, true>(lds + RING_OFF, geo, S, Ep, wave);
        if (BOTH(12)) GRID_BAR();
    }
    if (IN(13)) {
        const int lane = LANE_NOW(), tid = wave * 64 + lane; (void)tid; (void)lane;
        LAS int* blkE = (LAS int*)(lds + BLK_OFF);
        __syncthreads();
        const int NBt = moe_block_table(ctl + CW_CNT, blkE, tid);
        pg8::Geo geo{FF, FF, 128L * FF, 128L * FF, FF / 128};
        MoeSched<false> S{NBt, 8, NG, bx, FF, (const char*)WSP(unsigned char, WS_ACT), (const char*)WSP(unsigned char, WS_WDN), 256L * FF, (long)D * FF, 256L * FF, blkE, nullptr};
        EpiMoeDown Ep{blkE, INP(34), WSP(unsigned char, WS_YK)};
        pg8::gemm_phase<EpiMoeDown, MoeSched<false>, true, true>(lds + RING_OFF, geo, S, Ep, wave);
        if (BOTH(13)) GRID_BAR();
    }
    if (IN(14)) {
        const int lane = LANE_NOW(), tid = wave * 64 + lane; (void)tid; (void)lane;
        const int gw = bx * NWAVES + wave, NGW = NG * NWAVES;
        const unsigned* counts = ctl + CW_CNT;
        int pb = 0;
        { const int nb = (lane < E) ? (((int)counts[(lane & 31) * CNT_STRIDE] + 255) >> 8) : 0; int inc = nb;
#pragma unroll
          for (int o = 1; o < 32; o <<= 1) { const int v = __shfl_up(inc, o); if ((lane & 31) >= o) inc += v; }
          pb = inc - nb; }
        const float* X2 = WSP(float, WS_X2); const unsigned char* YK = WSP(unsigned char, WS_YK); const float* fn = INP(35); float* out = args.out;
        f32x4 fg[8];
#pragma unroll
        for (int j = 0; j < 8; ++j) fg[j] = *(const f32x4*)(fn + (j * 64 + lane) * 4);
        for (int t = gw; t < T; t += NGW) {
            size_t so[TOPK]; float gk[TOPK];
#pragma unroll
            for (int k = 0; k < TOPK; ++k) { const int e = WSP(int, WS_SELE)[t * TOPK + k], p = WSP(int, WS_SELP)[t * TOPK + k]; gk[k] = WSP(float, WS_SELG)[t * TOPK + k] * Y8_INV;
                so[k] = ((size_t)__shfl(pb, e) * 256 + p) * D; }
            f32x4 v[8]; float s = 0.f;
#pragma unroll
            for (int j = 0; j < 8; ++j) { const int cidx = (j * 64 + lane) * 4; f32x4 a = *(const f32x4*)(X2 + (size_t)t * D + cidx);
#pragma unroll
                for (int k = 0; k < TOPK; ++k) { const unsigned y = *(const unsigned*)(YK + so[k] + cidx); const v2f lo = __builtin_amdgcn_cvt_pk_f32_fp8(y, false), hi = __builtin_amdgcn_cvt_pk_f32_fp8(y, true);
                    a[0] += gk[k] * lo[0]; a[1] += gk[k] * lo[1]; a[2] += gk[k] * hi[0]; a[3] += gk[k] * hi[1]; }
                v[j] = a; s += (a[0] * a[0] + a[1] * a[1]) + (a[2] * a[2] + a[3] * a[3]); }
            const float r = rsqrtf(wave_sum(s) * (1.f / D) + EPS);
#pragma unroll
            for (int j = 0; j < 8; ++j) { const int cidx = (j * 64 + lane) * 4; *(f32x4*)(out + (size_t)t * D + cidx) = v[j] * r * fg[j]; }
        }
    }
#if defined(PROBE_READ)
    if (IN(15)) {
        const int lane = LANE_NOW(), tid = wave * 64 + lane; (void)tid; (void)lane;
        const int gw = bx * NWAVES + wave, NGW = NG * NWAVES;
        constexpr int I_UP = (D / 64) * (2 * FF / 64), I_DN = (FF / 64) * (D / 64);
        f32x4 sum = {0.f, 0.f, 0.f, 0.f};
#define TI_MAT8(W_, K_, N_, WT_, G_) { const int nb_ = (N_) / 64, kb = r / nb_, nbi = r % nb_; d.src = (W_) + (size_t)(64 * kb) * (N_) + 64 * nbi; d.dst = (bf16*)((unsigned char*)(WT_) + (size_t)(64 * nbi) * (K_) + 64 * kb); \
            d.gain = (G_) + 64 * kb; d.N = (N_); d.ldk = (K_); }
        auto dec_up = [&](int it) { TItem d; int r = it; const int e = r / I_UP; r -= e * I_UP; TI_MAT8(INP(31) + (size_t)e * D * 2 * FF, D, 2 * FF, WSP(unsigned char, WS_WUP) + (size_t)e * 2 * FF * D, INP(28)); return d; };
        auto dec_dn = [&](int it) { TItem d; int r = it; const int e = r / I_DN; r -= e * I_DN; TI_MAT8(INP(33) + (size_t)e * FF * D, FF, D, WSP(unsigned char, WS_WDN) + (size_t)e * D * FF, INP(28)); return d; };
#undef TI_MAT8
#define PR_STORE(d_, lane_, r_, g_) do { _Pragma("unroll") for (int j_ = 0; j_ < 16; ++j_) sum += r_[j_]; } while (0)
        TSTREAM(E * I_UP, dec_up, titem8_load<false>, PR_STORE);
        TSTREAM(E * I_DN, dec_dn, titem8_load<false>, PR_STORE);
#undef PR_STORE
        *(f32x4*)(ws + WS_END1 + (16u << 20) + ((size_t)gw * 64 + lane) * 16) = sum;
    }
#endif
#undef IN
#undef BOTH
#undef GRID_BAR
}

extern "C" void kernel_launch(void* const* d_in, const int* in_sizes, int n_in, void* d_out, int out_size, void* d_ws, size_t ws_size, hipStream_t stream) {
    static int grid = 0;
    if (grid == 0) {
        if (n_in != 36 || out_size != T * D || ws_size < WS_END1) { fprintf(stderr, "kernel_launch: built for 36 inputs, %d outputs, >= %zu bytes of workspace; got %d, %d, %zu; nothing launched\n", T * D, (size_t)WS_END1, n_in, out_size, ws_size); grid = -1; return; }
        int dev = 0, cus = 0, per_cu = 0;
        if (hipGetDevice(&dev) != hipSuccess || hipDeviceGetAttribute(&cus, hipDeviceAttributeMultiprocessorCount, dev) != hipSuccess) { fprintf(stderr, "kernel_launch: device query failed\n"); grid = -1; return; }
        if (hipFuncSetAttribute((const void*)fwd, hipFuncAttributeMaxDynamicSharedMemorySize, LDS_BYTES) != hipSuccess) { fprintf(stderr, "kernel_launch: hipFuncSetAttribute failed\n"); grid = -1; return; }
        if (hipOccupancyMaxActiveBlocksPerMultiprocessor(&per_cu, (const void*)fwd, NTHR, LDS_BYTES) != hipSuccess || per_cu < 1) fprintf(stderr, "kernel_launch: occupancy query reports %d\n", per_cu);
        (void)hipGetLastError();
        grid = 256;
        if (cus < 256) { fprintf(stderr, "kernel_launch: %d CUs < 256: the grid would not be resident; nothing launched\n", cus); grid = -1; return; }
    }
    if (grid < 0) return;
    (void)hipMemsetAsync((char*)d_ws + WS_CTL, 0, CTL_ZERO_BYTES, stream);
    Args a{};
    for (int i = 0; i < 36; ++i) a.in[i] = d_in[i];
    a.out = (float*)d_out; a.ws = (unsigned char*)d_ws;
#if defined(PROBE_RANGE)
    a.ph_lo = 0; a.ph_hi = PROBE_RANGE_HI; a.li = 0; hipLaunchKernelGGL(fwd, dim3(grid), dim3(NTHR), LDS_BYTES, stream, a);
    a.ph_lo = PROBE_RANGE_LO; a.ph_hi = PROBE_RANGE_HI; a.li = 1; hipLaunchKernelGGL(fwd, dim3(grid), dim3(NTHR), LDS_BYTES, stream, a);
    a.ph_lo = PROBE_RANGE_HI; a.ph_hi = N_PHASES; a.li = 2; hipLaunchKernelGGL(fwd, dim3(grid), dim3(NTHR), LDS_BYTES, stream, a);
#elif defined(PROBE_READ)
    a.ph_lo = 0; a.ph_hi = N_PHASES; a.li = 0; hipLaunchKernelGGL(fwd, dim3(grid), dim3(NTHR), LDS_BYTES, stream, a);
    a.ph_lo = 15; a.ph_hi = 16; a.li = 1; hipLaunchKernelGGL(fwd, dim3(grid), dim3(NTHR), LDS_BYTES, stream, a);
#elif defined(PROBE_PHASE)
    a.ph_lo = 0; a.ph_hi = PROBE_PHASE + 1; a.li = 0; hipLaunchKernelGGL(fwd, dim3(grid), dim3(NTHR), LDS_BYTES, stream, a);
    a.ph_lo = PROBE_PHASE; a.ph_hi = PROBE_PHASE + 1; a.li = 1; hipLaunchKernelGGL(fwd, dim3(grid), dim3(NTHR), LDS_BYTES, stream, a);
    if (PROBE_PHASE + 1 < N_PHASES) { a.ph_lo = PROBE_PHASE + 1; a.ph_hi = N_PHASES; a.li = 2; hipLaunchKernelGGL(fwd, dim3(grid), dim3(NTHR), LDS_BYTES, stream, a); }
#else
    a.ph_lo = 0; a.ph_hi = N_PHASES;
    hipLaunchKernelGGL(fwd, dim3(grid), dim3(NTHR), LDS_BYTES, stream, a);
#endif
}
```

```cpp
#include <hip/hip_runtime.h>
#include <cstdio>
#include <cstdint>

constexpr int D = 2048, BATCH = 4, SEQ = 2048, T = BATCH * SEQ;
constexpr int MEM = 256, TM = BATCH * MEM;
constexpr int H = 8, DN = 128, DR = 64, DV = 128, QL = 384, KVL = 256;
constexpr int SSMW = 1024, G = 64, P = 64, C = 16;
constexpr int XH = 4, XD = 512;
constexpr int E = 32, TOPK = 4, FF = 2048;
constexpr int INC = 1728, INCP = 1792;
constexpr int PJW = 704;
constexpr int LCH = 32, NCH = SEQ / LCH;
constexpr int AGW = 640;
constexpr float EPS = 1e-6f;

__device__ __forceinline__ int lane_id_now() { unsigned z = 0u; asm volatile("" : "+v"(z)); return (int)__builtin_amdgcn_mbcnt_hi(~0u, __builtin_amdgcn_mbcnt_lo(~0u, z)); }
namespace pg8 {
#define PG8_LAS __attribute__((address_space(3)))
typedef unsigned short bf16_t;
typedef short bf16x8 __attribute__((ext_vector_type(8)));
typedef float f32x4 __attribute__((ext_vector_type(4)));
typedef float f32x2 __attribute__((ext_vector_type(2)));
typedef unsigned u32x4 __attribute__((ext_vector_type(4)));
typedef unsigned u32x2 __attribute__((ext_vector_type(2)));
constexpr int BM = 256, BK = 64, HALF = 128, HTB = HALF * BK * 2  , STAGE_BYTES = 8 * HTB, NXCD = 8, WGM = 8;

__host__ __device__ __forceinline__ int lds_byte(int r, int c) { const int st = (r >> 4) * 2 + (c >> 5), rr = r & 15, cc = c & 31, ob = rr * 64 + cc * 2; return st * 1024 + (ob ^ (((ob >> 9) & 1) << 5)); }
__host__ __device__ __forceinline__ void stage_rc(int b, int& R, int& C) { const int st = b / 1024, sb = b % 1024, swz = sb ^ (((sb >> 9) & 1) << 5); R = (st >> 1) * 16 + swz / 64; C = (st & 1) * 32 + (swz % 64) / 2; }
__host__ __device__ __forceinline__ int perm32(int rho) { const int n = rho >> 4, i = rho & 15; return 8 * (i >> 2) + 4 * n + (i & 3); }

struct Unit { int pm, pn, z; };
struct Geo { int lda, ldb; long hstepA, hstepB; int nt; };

struct Sched {
    int nM, nN, nZ, total, G, c, mode, zdiv;
    const char* A; const char* B; long tA, tB, zA, zB, zA2, zB2;
    __device__ __forceinline__ void init(int mode_, int nM_, int nN_, int nZ_, int G_, int c_, const void* A_, long tA_, long zA_, const void* B_, long tB_, long zB_) {
        mode = mode_; nM = nM_; nN = nN_; nZ = nZ_; total = nM_ * nN_ * nZ_; G = G_; c = c_; A = (const char*)A_; B = (const char*)B_; tA = tA_; tB = tB_; zA = zA_; zB = zB_; zdiv = 1 << 30; zA2 = 0; zB2 = 0; }
    __device__ __forceinline__ void split_z(int zdiv_, long zA2_, long zB2_) { zdiv = zdiv_; zA2 = zA2_; zB2 = zB2_; }
    __device__ __forceinline__ bool next(int i, Unit& u) const {
        const long L = (long)i * G + c; if (L >= total) return false;
        if (mode == 0) {
            int wgid = (int)L; { const int q = total / NXCD, r = total % NXCD, xcd = wgid % NXCD, off = wgid / NXCD; wgid = (xcd < r ? xcd * (q + 1) : r * (q + 1) + (xcd - r) * q) + off; }
            const int nig = WGM * nN, gid = wgid / nig, fm = gid * WGM, gsz = (nM - fm) < WGM ? (nM - fm) : WGM;
            u.pm = fm + ((wgid % nig) % gsz); u.pn = (wgid % nig) / gsz; u.z = 0;
        } else { const int l = (int)L; u.pn = l % nN; u.pm = (l / nN) % nM; u.z = l / (nN * nM); }
        return true;
    }
    __device__ __forceinline__ void ptrs(const Unit& u, const char*& a, const char*& b) const { const int z1 = (zdiv == (1 << 30)) ? u.z : u.z / zdiv, z2 = (zdiv == (1 << 30)) ? 0 : u.z % zdiv;
        a = A + (long)z1 * zA + (long)z2 * zA2 + (long)u.pm * tA; b = B + (long)z1 * zB + (long)z2 * zB2 + (long)u.pn * tB; }
    static constexpr bool GATHER = false;
    __device__ __forceinline__ bool half1(const Unit&) const { return true; }
    __device__ __forceinline__ unsigned row_off(int, int) const { return 0u; }
    __device__ __forceinline__ void a_ready(const Unit&) const {}
    __device__ __forceinline__ void done(const Unit&) const {}
};
template <class E, class = void> struct epi_fp8 { static constexpr bool v = false; };
template <class E> struct epi_fp8<E, decltype((void)E::FP8)> { static constexpr bool v = E::FP8; };
typedef int i32x4 __attribute__((ext_vector_type(4)));
typedef int i32x8 __attribute__((ext_vector_type(8)));
__device__ __forceinline__ unsigned cvt_pk_bf16(float lo, float hi) { unsigned r; asm volatile("v_cvt_pk_bf16_f32 %0, %1, %2" : "=v"(r) : "v"(lo), "v"(hi)); return r; }

template <class Epi, class Sched, bool ALIGN_EPI = false, bool SP2 = false>
__device__ __forceinline__ void gemm_phase(PG8_LAS unsigned char* lds, const Geo geo, const Sched& S, const Epi& E, const int wave_) {
    int tid_ = wave_ * 64 + lane_id_now(); asm volatile("" : "+v"(tid_));
    const int tid = tid_, wid = __builtin_amdgcn_readfirstlane(tid >> 6), lane = tid & 63, wr = wid >> 2, wc = wid & 3, fr = lane & 15, fq = lane >> 4;
    const int nt = geo.nt;
    unsigned voffA[2], voffB[2];
#pragma unroll
    for (int i = 0; i < 2; ++i) { int R, C; stage_rc(tid * 16 + i * 8192, R, C); const int Rb = Epi::PERM ? ((R & ~31) + perm32(R & 31)) : R;
        voffA[i] = (unsigned)(R * geo.lda + C * 2); voffB[i] = (unsigned)(Rb * geo.ldb + C * 2); }
    unsigned c0[2], c1[2], n0[2], n1[2];
#pragma unroll
    for (int i = 0; i < 2; ++i) { c0[i] = voffA[i]; c1[i] = voffA[i]; n0[i] = voffA[i]; n1[i] = voffA[i]; }
    const size_t kstep = (size_t)(BK * 2);
    const size_t hstepA = (size_t)geo.hstepA, hstepB = (size_t)geo.hstepB;
    const unsigned ldsw = (unsigned)wid * 1024u;
    const int aoff = lds_byte(wr * 64 + fr, fq * 8), boff = lds_byte(wc * 32 + fr, fq * 8);
#define PG8_SA(b, h) (((b) * 2 + (h)) * HTB)
#define PG8_SB(b, h) ((4 + (b) * 2 + (h)) * HTB)
#define PG8_STAGE(bufoff, gbase, voff) do { _Pragma("unroll") for (int _i = 0; _i < 2; ++_i) \
        __builtin_amdgcn_global_load_lds((const unsigned*)((const char*)(gbase) + (voff)[_i]), (PG8_LAS unsigned*)(lds + (bufoff) + ldsw + _i * 8192), 16, 0, 0); } while (0)
#define PG8_LD16(off) __builtin_bit_cast(i32x4, *(const PG8_LAS bf16x8*)(lds + (off)))
#define PG8_LDA(dst, b, h) do { _Pragma("unroll") for (int m = 0; m < 4; ++m) { if constexpr (epi_fp8<Epi>::v) dst##8[m] = __builtin_shufflevector(PG8_LD16(PG8_SA(b, h) + aoff + m * 2048), PG8_LD16(PG8_SA(b, h) + aoff + m * 2048 + 1024), 0, 1, 2, 3, 4, 5, 6, 7); \
        else { _Pragma("unroll") for (int k = 0; k < 2; ++k) dst[m][k] = *(const PG8_LAS bf16x8*)(lds + PG8_SA(b, h) + aoff + m * 2048 + k * 1024); } } } while (0)
#define PG8_LDB(dst, b, h) do { _Pragma("unroll") for (int n = 0; n < 2; ++n) { if constexpr (epi_fp8<Epi>::v) dst##8[n] = __builtin_shufflevector(PG8_LD16(PG8_SB(b, h) + boff + n * 2048), PG8_LD16(PG8_SB(b, h) + boff + n * 2048 + 1024), 0, 1, 2, 3, 4, 5, 6, 7); \
        else { _Pragma("unroll") for (int k = 0; k < 2; ++k) dst[n][k] = *(const PG8_LAS bf16x8*)(lds + PG8_SB(b, h) + boff + n * 2048 + k * 1024); } } } while (0)
#define PG8_MMA(ai, bj, At, Bt) do { __builtin_amdgcn_s_setprio(1); \
        if constexpr (epi_fp8<Epi>::v) { _Pragma("unroll") for (int m = 0; m < 4; ++m) _Pragma("unroll") for (int n = 0; n < 2; ++n) \
            asm volatile("v_mfma_f32_16x16x128_f8f6f4 %0, %1, %2, %0" : "+v"(acc[ai][bj][m][n]) : "v"(Bt##8[n]), "v"(At##8[m])); }     \
        else { _Pragma("unroll") for (int m = 0; m < 4; ++m) _Pragma("unroll") for (int n = 0; n < 2; ++n) _Pragma("unroll") for (int k = 0; k < 2; ++k) \
            acc[ai][bj][m][n] = __builtin_amdgcn_mfma_f32_16x16x32_bf16(Bt[n][k], At[m][k], acc[ai][bj][m][n], 0, 0, 0); } \
        __builtin_amdgcn_s_setprio(0); } while (0)
#define PG8_WAIT_V(n) asm volatile("s_waitcnt vmcnt(" #n ")" ::: "memory")
#define PG8_WAIT_L(n) asm volatile("s_waitcnt lgkmcnt(" #n ")" ::: "memory")
#define PG8_BAR __builtin_amdgcn_s_barrier()
#define PG8_SCHED __builtin_amdgcn_sched_barrier(0)
    Unit cur, nxt; int ui = 0;
    if (!S.next(0, cur)) return;
    f32x4 acc[2][2][4][2];
#pragma unroll
    for (int a = 0; a < 2; ++a)
#pragma unroll
        for (int b = 0; b < 2; ++b)
#pragma unroll
            for (int m = 0; m < 4; ++m)
#pragma unroll
                for (int n = 0; n < 2; ++n) acc[a][b][m][n] = (f32x4){0.f, 0.f, 0.f, 0.f};
    bf16x8 At[4][2], B0[2][2], B1[2][2];
    i32x8 At8[4], B08[2], B18[2];
    const char* cA; const char* cB; S.ptrs(cur, cA, cB);
    S.a_ready(cur);
    if constexpr (Sched::GATHER) {
#pragma unroll
        for (int i = 0; i < 2; ++i) { int R, C; stage_rc(tid * 16 + i * 8192, R, C); c0[i] = S.row_off(0, R) + (unsigned)(C * 2); c1[i] = S.row_off(0, 128 + R) + (unsigned)(C * 2); n0[i] = c0[i]; n1[i] = c1[i]; } }
    static_assert(SP2, "only the two-super-phase loop is kept in this file");
    PG8_STAGE(PG8_SB(0, 0), cB, voffB); PG8_STAGE(PG8_SB(0, 1), cB + hstepB, voffB); PG8_STAGE(PG8_SA(0, 0), cA, c0); PG8_STAGE(PG8_SA(0, 1), cA + hstepA, c1);
    if (wr == 1) PG8_BAR;
    PG8_WAIT_V(2); PG8_BAR;
    PG8_STAGE(PG8_SB(1, 0), cB + kstep, voffB); PG8_STAGE(PG8_SA(1, 0), cA + kstep, c0); PG8_STAGE(PG8_SB(1, 1), cB + hstepB + kstep, voffB);
    PG8_WAIT_V(6); PG8_BAR;
    for (;;) {
        const bool has_next = S.next(ui + 1, nxt);
        const char* nA = cA; const char* nB = cB; if (has_next) S.ptrs(nxt, nA, nB);
        const bool h1 = S.half1(cur);
        for (int t = 0; t < nt; t += 2) {
            const bool last = (t == nt - 2);
            const char* a1 = cA + (size_t)(t + 1) * kstep;
            const char* a2 = last ? nA : cA + (size_t)(t + 2) * kstep; const char* b2 = last ? nB : cB + (size_t)(t + 2) * kstep;
            const char* a3 = a2 + kstep; const char* b3 = b2 + kstep;
            if (last && has_next) { S.a_ready(nxt);
                if constexpr (Sched::GATHER) {
#pragma unroll
                    for (int i = 0; i < 2; ++i) { int R, C; stage_rc(tid * 16 + i * 8192, R, C); n0[i] = S.row_off(ui + 1, R) + (unsigned)(C * 2); n1[i] = S.row_off(ui + 1, 128 + R) + (unsigned)(C * 2); } } }
            const unsigned s0[2] = {last ? n0[0] : c0[0], last ? n0[1] : c0[1]}, s1[2] = {last ? n1[0] : c1[0], last ? n1[1] : c1[1]};
            PG8_LDB(B0, 0, 0); PG8_LDB(B1, 0, 1); PG8_SCHED; PG8_LDA(At, 0, 0); PG8_STAGE(PG8_SA(1, 1), a1 + hstepA, c1);
            PG8_WAIT_V(8); PG8_WAIT_L(0); PG8_BAR; PG8_MMA(0, 0, At, B0); PG8_MMA(0, 1, At, B1); PG8_BAR; PG8_SCHED;
            PG8_LDA(At, 0, 1); PG8_STAGE(PG8_SB(0, 0), b2, voffB); PG8_STAGE(PG8_SB(0, 1), b2 + hstepB, voffB); PG8_STAGE(PG8_SA(0, 0), a2, s0);
            PG8_WAIT_V(8); PG8_WAIT_L(0); PG8_BAR; if (h1) { PG8_MMA(1, 0, At, B0); PG8_MMA(1, 1, At, B1); } PG8_BAR; PG8_SCHED;
            PG8_LDB(B0, 1, 0); PG8_LDB(B1, 1, 1); PG8_SCHED; PG8_LDA(At, 1, 0); PG8_STAGE(PG8_SA(0, 1), a2 + hstepA, s1);
            PG8_WAIT_V(8); PG8_WAIT_L(0); PG8_BAR; PG8_MMA(0, 0, At, B0); PG8_MMA(0, 1, At, B1); PG8_BAR; PG8_SCHED;
            PG8_LDA(At, 1, 1); PG8_STAGE(PG8_SB(1, 0), b3, voffB); PG8_STAGE(PG8_SB(1, 1), b3 + hstepB, voffB); PG8_STAGE(PG8_SA(1, 0), a3, s0);
            PG8_WAIT_V(8); PG8_WAIT_L(0); PG8_BAR; if (h1) { PG8_MMA(1, 0, At, B0); PG8_MMA(1, 1, At, B1); } PG8_BAR; PG8_SCHED;
        }
        if constexpr (epi_fp8<Epi>::v) { asm volatile("s_nop 7\n\ts_nop 7\n\ts_nop 7" ::: "memory"); }
        if constexpr (ALIGN_EPI) { if (wr == 0) PG8_BAR; }
        if constexpr (!Epi::AFTER_DRAIN) { E(acc, cur, wr, wc, fr, fq); S.done(cur); }
        if (!has_next) break;
#pragma unroll
        for (int a = 0; a < 2; ++a)
#pragma unroll
            for (int b = 0; b < 2; ++b)
#pragma unroll
                for (int m = 0; m < 4; ++m)
#pragma unroll
                    for (int n = 0; n < 2; ++n) acc[a][b][m][n] = (f32x4){0.f, 0.f, 0.f, 0.f};
        cur = nxt; cA = nA; cB = nB; ++ui;
#pragma unroll
        for (int i = 0; i < 2; ++i) { c0[i] = n0[i]; c1[i] = n1[i]; }
        if constexpr (ALIGN_EPI) { if (wr == 1) PG8_BAR; }
    }
    PG8_WAIT_V(0);
    if constexpr (!ALIGN_EPI) { if (wr == 0) PG8_BAR; }
    PG8_BAR;
    if constexpr (Epi::AFTER_DRAIN) { E.fused(acc, cur, wr, wc, fr, fq, lds, wid, lane); S.done(cur); }
#undef PG8_SA
#undef PG8_SB
#undef PG8_STAGE
#undef PG8_LDA
#undef PG8_LD16
#undef PG8_LDB
#undef PG8_MMA
#undef PG8_WAIT_V
#undef PG8_WAIT_L
#undef PG8_BAR
#undef PG8_SCHED
}
}

constexpr size_t MiB = 1u << 20;
constexpr size_t al256(size_t x) { return (x + 255) & ~(size_t)255; }
constexpr size_t WS_CTL = 0, CTL_ZERO_BYTES = 1 * MiB;
constexpr int CW_BAR = 4096;
constexpr int CW_CNT = 49152, CNT_STRIDE = 64;
constexpr int CW_CVQ = 16384;
constexpr int CW_SSQ2 = 32768;
constexpr size_t WS_WIN = 1 * MiB;
constexpr size_t WS_WQB = WS_WIN + al256((size_t)INCP * D * 2);
constexpr size_t WS_WKVB = WS_WQB + al256((size_t)1536 * QL * 2);
constexpr size_t WS_WGLU = WS_WKVB + al256((size_t)2048 * KVL * 2);
constexpr size_t WS_WOUT = WS_WGLU + al256((size_t)SSMW * SSMW * 2);
constexpr size_t WS_WXQ = WS_WOUT + al256((size_t)D * D * 2);
constexpr size_t WS_WXK = WS_WXQ + al256((size_t)D * D * 2);
constexpr size_t WS_WXV = WS_WXK + al256((size_t)D * D * 2);
constexpr size_t WS_WXO = WS_WXV + al256((size_t)D * D * 2);
constexpr size_t WS_BTY = WS_WXO + al256((size_t)D * D * 2);
constexpr size_t WS_BTS = WS_BTY + al256((size_t)G * 512 * AGW * 2);
constexpr size_t WS_AP32 = WS_BTS + al256((size_t)G * 128 * 512 * 2);
constexpr size_t WS_HB = WS_AP32 + al256((size_t)G * P * 2 * 4);
constexpr size_t WS_MEMN = WS_HB + al256((size_t)T * D * 2);
constexpr size_t WS_PROJB = WS_MEMN + al256((size_t)TM * D * 2);
constexpr size_t WS_AG = WS_PROJB + al256((size_t)T * PJW * 2);
constexpr size_t WS_SC = WS_AG + al256((size_t)G * 256 * AGW * 2);
constexpr size_t WS_CQN = WS_SC + al256((size_t)G * 256 * 128 * 4);
constexpr size_t WS_CKVN = WS_CQN + al256((size_t)T * QL * 2);
constexpr size_t WS_KPE = WS_CKVN + al256((size_t)T * KVL * 2);
constexpr size_t WS_ROPE = WS_KPE + al256((size_t)T * DR * 2);
constexpr size_t WS_Q = WS_ROPE + al256((size_t)T * 64 * 4);
constexpr size_t WS_KV = WS_Q + al256((size_t)T * 1536 * 2);
constexpr size_t WS_XK = WS_KV + al256((size_t)T * 2048 * 2);
constexpr size_t WS_XVT = WS_XK + al256((size_t)TM * D * 2);
constexpr size_t WS_Y = WS_XVT + al256((size_t)D * TM * 2);
constexpr size_t WS_ATTO = WS_Y + al256((size_t)T * SSMW * 2);
constexpr size_t WS_SSMO = WS_ATTO + al256((size_t)T * 1024 * 2);
constexpr size_t WS_X1 = WS_SSMO + al256((size_t)T * 1024 * 2);
constexpr size_t WS_X1B = WS_X1 + al256((size_t)T * D * 4);
constexpr size_t WS_XQ = WS_X1B + al256((size_t)T * D * 2);
constexpr size_t WS_PX = WS_XQ + al256((size_t)T * D * 2);
constexpr size_t WS_WXQN = WS_XQ;
constexpr size_t WS_WKT8 = WS_XQ + (size_t)D * D * 2;
constexpr size_t WS_XO = WS_PX + al256((size_t)BATCH * XH * SEQ * MEM * 2);
constexpr size_t WS_X2 = WS_XO + al256((size_t)T * D * 2);
constexpr size_t WS_X2B = WS_X2 + al256((size_t)T * D * 4);
constexpr size_t WS_WRH = WS_X2B + al256((size_t)T * D * 2);
constexpr size_t WS_WRL = WS_WRH + al256((size_t)E * D * 2);
constexpr size_t WS_SELE = WS_WRL + al256((size_t)E * D * 2);
constexpr size_t WS_SELP = WS_SELE + al256((size_t)T * TOPK * 4);
constexpr size_t WS_SELG = WS_SELP + al256((size_t)T * TOPK * 4);
constexpr size_t WS_LIST = WS_SELG + al256((size_t)T * TOPK * 4);
constexpr int NSLOT = (T * TOPK / 256 + E) * 256;
constexpr size_t WS_ACT = WS_LIST + al256((size_t)E * T * 4);
constexpr size_t WS_YK = WS_ACT + al256((size_t)NSLOT * FF * 2);
constexpr size_t WS_WUP = WS_YK + al256((size_t)NSLOT * D * 2);
constexpr size_t WS_WDN = WS_WUP + al256((size_t)E * 2 * FF * D * 2);
constexpr size_t WS_X2F8 = WS_WDN + al256((size_t)E * D * FF * 2);
constexpr size_t WS_X1F8 = WS_X2F8 + al256((size_t)T * D);
constexpr size_t WS_XO8 = WS_X1F8 + al256((size_t)T * D);
constexpr size_t WS_WXQ8 = WS_XO8 + al256((size_t)T * D);
constexpr size_t WS_WXO8 = WS_WXQ8 + al256((size_t)D * D);
constexpr size_t WS_MIXED = WS_WXO8 + al256((size_t)D * D);
constexpr size_t WS_SSQP1 = WS_MIXED + al256((size_t)T * D * 2);
constexpr size_t WS_SSQP2 = WS_SSQP1 + al256((size_t)T * 32 * 4);
constexpr size_t WS_RSTD2 = WS_SSQP2 + al256((size_t)T * 32 * 4);
constexpr size_t WS_END1 = WS_RSTD2 + al256((size_t)T * 4);

constexpr int NWAVES = 8, NTHR = 512;
constexpr int RING_OFF = 0, RING_BYTES = 131072;
constexpr int LDSCTL_OFF = RING_BYTES, MISC_OFF = LDSCTL_OFF + 320;
constexpr int TOK_OFF = LDSCTL_OFF + 1024, MAXU = 10;
constexpr int BLK_OFF = TOK_OFF + MAXU * 1024;
constexpr int LDS_BYTES = 147456;
static_assert(BLK_OFF + 480 * 4 <= LDS_BYTES, "LDS map");

#define GAS __attribute__((address_space(1)))
#define LAS __attribute__((address_space(3)))
typedef unsigned short bf16;
typedef unsigned v4u __attribute__((ext_vector_type(4)));
typedef unsigned v2u __attribute__((ext_vector_type(2)));
typedef float v2f __attribute__((ext_vector_type(2)));
typedef float f32x4 __attribute__((ext_vector_type(4)));
typedef short bf16x8 __attribute__((ext_vector_type(8)));
#define LDS_WAIT() asm volatile("s_waitcnt lgkmcnt(0)" ::: "memory")
#define VM_WAIT() asm volatile("s_waitcnt vmcnt(0)" ::: "memory")
__device__ __forceinline__ unsigned f2bf(float f) { unsigned u = __builtin_bit_cast(unsigned, f); return (u + 0x7fffu + ((u >> 16) & 1u)) >> 16; }
__device__ __forceinline__ unsigned pk2(float lo, float hi) { return f2bf(lo) | (f2bf(hi) << 16); }
__device__ __forceinline__ float bf2f(unsigned short h) { return __builtin_bit_cast(float, (unsigned)h << 16); }
__device__ __forceinline__ float bflo(unsigned w) { return __builtin_bit_cast(float, w << 16); }
__device__ __forceinline__ float bfhi(unsigned w) { return __builtin_bit_cast(float, w & 0xffff0000u); }

__device__ __forceinline__ float clamp448(float v) { return fminf(fmaxf(v, -448.0f), 448.0f); }
__device__ __forceinline__ float clamp448m(float v) { return __builtin_amdgcn_fmed3f(v, -448.0f, 448.0f); }
__device__ __forceinline__ unsigned pk4_fp8w(float a, float b, float c, float d) {
    int p = __builtin_amdgcn_cvt_pk_fp8_f32(clamp448m(a), clamp448m(b), 0, false); p = __builtin_amdgcn_cvt_pk_fp8_f32(clamp448m(c), clamp448m(d), p, true); return (unsigned)p; }
__device__ __forceinline__ unsigned pk4_fp8(float a, float b, float c, float d) {
    int p = __builtin_amdgcn_cvt_pk_fp8_f32(clamp448(a), clamp448(b), 0, false); p = __builtin_amdgcn_cvt_pk_fp8_f32(clamp448(c), clamp448(d), p, true); return (unsigned)p; }
constexpr float W8_SCALE = 256.0f, W8_INV = 1.0f / 256.0f;

#define XB_TMO      128
#define XB_XCNT(j)  (256  + 64 * (j))
#define XB_XSUB(j)  (1280 + 64 * (j))
#define XB_XGEN(j)  (2304 + 64 * (j))
#define XB_TOP      3328
#define XB_TOPGEN   3392
#define XB_FLAG(j)  (3456 + (j))
#define XCD_BAR_WORDS 3520
#define XB_SPIN_CAP (1u << 18)

__device__ __forceinline__ unsigned xb_ld(unsigned* p)              { return __hip_atomic_load(p, __ATOMIC_RELAXED, __HIP_MEMORY_SCOPE_AGENT); }
__device__ __forceinline__ unsigned xb_add(unsigned* p, unsigned v) { return __hip_atomic_fetch_add(p, v, __ATOMIC_RELAXED, __HIP_MEMORY_SCOPE_AGENT); }
__device__ __forceinline__ unsigned xb_xcc_id() { return (unsigned)__builtin_amdgcn_s_getreg((3 << 11) | 20) & 0xFu; }
#define XB_SPIN(cond, bar) do { unsigned _sp = 0; while (cond) { __builtin_amdgcn_s_sleep(1); \
    if ((++_sp & 255u) == 0u) { if (xb_ld(&(bar)[XB_TMO])) break; if (_sp > XB_SPIN_CAP) { atomicAdd(&(bar)[XB_TMO], 1u); break; } } } } while (0)

struct XcdBarrier {
    unsigned* bar; unsigned x; int wave;
    volatile LAS unsigned* st;
};
__device__ __forceinline__ bool xb_thread0(int wave) { return wave == 0 && lane_id_now() == 0; }
__device__ __forceinline__ XcdBarrier xcd_barrier_post(unsigned* bar, volatile LAS unsigned* st, int wave) {
    XcdBarrier b; b.bar = bar; b.x = xb_xcc_id(); b.st = st; b.wave = wave;
    if (xb_thread0(wave)) (void)xb_add(&bar[XB_XCNT(b.x)], 1u);
    return b;
}
__device__ __forceinline__ void xcd_barrier_complete(unsigned* bar, unsigned x, unsigned& nloc, unsigned& nx, unsigned& mask) {
    const unsigned G_ = gridDim.x * gridDim.y * gridDim.z;
    unsigned sum, cnt, mine, msk, sp = 0u;
    for (;;) {
        sum = 0u; cnt = 0u; mine = 0u; msk = 0u;
#pragma unroll
        for (unsigned j = 0; j < 16; ++j) { const unsigned c = xb_ld(&bar[XB_XCNT(j)]); sum += c; cnt += (c > 0u) ? 1u : 0u; msk |= (c > 0u) ? (1u << j) : 0u; mine = (j == x) ? c : mine; }
        if (sum == G_) break;
        __builtin_amdgcn_s_sleep(1);
        if ((++sp & 255u) == 0u) { if (xb_ld(&bar[XB_TMO])) break; if (sp > XB_SPIN_CAP) { atomicAdd(&bar[XB_TMO], 1u); break; } }
    }
    nloc = mine > 0u ? mine : 1u; nx = cnt > 0u ? cnt : 1u; mask = msk;
}
__device__ __forceinline__ void xb_wave0(const XcdBarrier& b, volatile LAS unsigned* stopw = nullptr, unsigned stopv = 0u) {
    unsigned* bar = b.bar;
    const int lane = lane_id_now();
    __builtin_amdgcn_s_waitcnt(0);
    unsigned gen = 0u;
    if (lane == 0) {
        unsigned nloc = b.st[0], nx = b.st[1], mask = b.st[2];
        if (nloc == 0u) { xcd_barrier_complete(bar, b.x, nloc, nx, mask); b.st[0] = nloc; b.st[1] = nx; b.st[2] = mask; }
        const unsigned old = xb_add(&bar[XB_XSUB(b.x)], 1u);
        gen = old / nloc;
        if (old + 1u == (gen + 1u) * nloc) {
            __builtin_amdgcn_fence(__ATOMIC_RELEASE, "agent");
            asm volatile("s_waitcnt vmcnt(0)" ::: "memory");
            xb_add(&bar[XB_FLAG(b.x)], 1u);
        }
    }
    gen = (unsigned)__builtin_amdgcn_readfirstlane((int)gen);
    asm volatile("s_waitcnt lgkmcnt(0)" ::: "memory");
    const unsigned mask = b.st[2];
    unsigned sp = 0u;
    for (;;) {
        unsigned f = 0u; if (lane < 16) f = xb_ld(&bar[XB_FLAG(lane)]);
        const bool waiting = (lane < 16) && ((mask >> lane) & 1u) && ((int)(f - gen) <= 0);
        const unsigned long long wm = __builtin_amdgcn_ballot_w64(waiting);
        if (wm == 0ull) break;
        if (stopw && 2 * __builtin_popcountll(wm) <= __builtin_popcount(mask)) { *stopw = stopv; stopw = nullptr; }
        __builtin_amdgcn_s_sleep(1);
        if ((++sp & 255u) == 0u) { if (xb_ld(&bar[XB_TMO])) break; if (sp > XB_SPIN_CAP) { if (lane == 0) atomicAdd(&bar[XB_TMO], 1u); break; } }
    }
    __builtin_amdgcn_fence(__ATOMIC_ACQUIRE, "agent");
    asm volatile("s_waitcnt vmcnt(0)" ::: "memory");
}
__device__ __forceinline__ void xcd_barrier(const XcdBarrier& b) {
    asm volatile("s_waitcnt vmcnt(0)" ::: "memory");
    __syncthreads();
    if (b.wave == 0) xb_wave0(b);
    __syncthreads();
}

__device__ __forceinline__ float wave_sum(float v) {
#pragma unroll
    for (int o = 1; o < 64; o <<= 1) v += __shfl_xor(v, o);
    return v;
}
__device__ __forceinline__ void transpose_item(const float* W, int N, bf16* WT, int ldk, const float* gain, LAS float* scr, int item, int nblk, int lane) {
    const int kb = item / nblk, nb = item % nblk, k0 = 64 * kb, n0 = 32 * nb;
#pragma unroll 8
    for (int i = 0; i < 32; ++i) { const int kk = 2 * i + (lane >> 5); const float g = gain ? gain[k0 + kk] : 1.0f;
        scr[kk * 33 + (lane & 31)] = W[(size_t)(k0 + kk) * N + n0 + (lane & 31)] * g; }
    LDS_WAIT(); asm volatile("" ::: "memory");
    const int c = lane & 7;
#pragma unroll
    for (int j = 0; j < 4; ++j) { const int n = (lane >> 3) + 8 * j; const LAS float* s = scr + (8 * c) * 33 + n;
        v4u o; o.x = pk2(s[0 * 33], s[1 * 33]); o.y = pk2(s[2 * 33], s[3 * 33]); o.z = pk2(s[4 * 33], s[5 * 33]); o.w = pk2(s[6 * 33], s[7 * 33]);
        *(GAS v4u*)(WT + (size_t)(n0 + n) * ldk + k0 + 8 * c) = o; }
    LDS_WAIT(); asm volatile("" ::: "memory");
}
__device__ __forceinline__ void rms_row_to_bf16(const float* xrow, const float* g, bf16* orow, int lane) {
    const GAS f32x4* xr = (const GAS f32x4*)xrow + lane;
    f32x4 v[8], gv[8]; float s = 0.f;
#pragma unroll
    for (int j = 0; j < 8; ++j) { v[j] = xr[64 * j]; gv[j] = ((const GAS f32x4*)g)[lane + 64 * j]; }
#pragma unroll
    for (int j = 0; j < 8; ++j) s += (v[j].x * v[j].x + v[j].y * v[j].y) + (v[j].z * v[j].z + v[j].w * v[j].w);
    const float r = rsqrtf(wave_sum(s) * (1.f / D) + EPS);
    GAS v2u* o8 = (GAS v2u*)orow + lane;
#pragma unroll
    for (int j = 0; j < 8; ++j) { const f32x4 gg = gv[j];
        v2u o; o.x = pk2(v[j].x * r * gg.x, v[j].y * r * gg.y); o.y = pk2(v[j].z * r * gg.z, v[j].w * r * gg.w); o8[64 * j] = o; }
}

__device__ __forceinline__ void s5_setup(int g, LAS unsigned char* lds, const float* lam_re, const float* lam_im, const float* log_dt, const float* b_re, const float* b_im,
                                         const float* c_re, const float* c_im, bf16* BTY, bf16* BTS, float* AP32, int tid) {
    LAS float* apr = (LAS float*)lds;
    LAS float* api = apr + 33 * 64;
    LAS float* bbr = api + 33 * 64;
    LAS float* bbi = bbr + 1024;
    LAS float* ccr = bbi + 1024;
    LAS float* cci = ccr + 1024;
    LAS float* Kd = cci + 1024;
    const float dt = expf(log_dt[g]);
    for (int idx = tid; idx < 33 * 64; idx += NTHR) { const int d = idx >> 6, p = idx & 63; const float lr = lam_re[g * 64 + p], li = lam_im[g * 64 + p];
        const float mag = expf((float)d * (lr * dt)), ang = (float)d * (li * dt); apr[idx] = mag * cosf(ang); api[idx] = mag * sinf(ang); }
    for (int idx = tid; idx < 1024; idx += NTHR) { ccr[idx] = c_re[g * 1024 + idx]; cci[idx] = c_im[g * 1024 + idx]; }
    __syncthreads();
    for (int idx = tid; idx < 1024; idx += NTHR) { const int p = idx >> 4; const float lr = lam_re[g * 64 + p], li = lam_im[g * 64 + p];
        const float nr = apr[64 + p] - 1.0f, ni = api[64 + p], den = lr * lr + li * li; const float cre = (nr * lr + ni * li) / den, cim = (ni * lr - nr * li) / den;
        const float br = b_re[g * 1024 + idx], bi = b_im[g * 1024 + idx]; bbr[idx] = cre * br - cim * bi; bbi[idx] = cre * bi + cim * br; }
    __syncthreads();
    for (int idx = tid; idx < 32 * 256; idx += NTHR) { const int d = idx >> 8, co = (idx >> 4) & 15, ci = idx & 15; float a = 0.f;
        for (int p = 0; p < 64; ++p) { const float cr = ccr[co * 64 + p], cm = cci[co * 64 + p], ar = apr[d * 64 + p], ai = api[d * 64 + p];
            const float car = cr * ar - cm * ai, cai = cr * ai + cm * ar; a += car * bbr[p * 16 + ci] - cai * bbi[p * 16 + ci]; }
        Kd[idx] = a; }
    __syncthreads();
    for (int idx = tid; idx < 512 * 80; idx += NTHR) { const int row = idx / 80, q = idx % 80, i = row >> 4, co = row & 15; float v[8];
        if (q < 64) { const int j = q >> 1, ci0 = (q & 1) * 8;
#pragma unroll
            for (int e = 0; e < 8; ++e) v[e] = (j <= i) ? Kd[(i - j) * 256 + co * 16 + ci0 + e] : 0.f; }
        else if (q < 72) { const int p0 = (q - 64) * 8;
#pragma unroll
            for (int e = 0; e < 8; ++e) { const int p = p0 + e; v[e] = ccr[co * 64 + p] * apr[(i + 1) * 64 + p] - cci[co * 64 + p] * api[(i + 1) * 64 + p]; } }
        else { const int p0 = (q - 72) * 8;
#pragma unroll
            for (int e = 0; e < 8; ++e) { const int p = p0 + e; v[e] = -(ccr[co * 64 + p] * api[(i + 1) * 64 + p] + cci[co * 64 + p] * apr[(i + 1) * 64 + p]); } }
        v4u o; o.x = pk2(v[0], v[1]); o.y = pk2(v[2], v[3]); o.z = pk2(v[4], v[5]); o.w = pk2(v[6], v[7]);
        *(GAS v4u*)(BTY + ((size_t)g * 512 + row) * AGW + q * 8) = o; }
    for (int idx = tid; idx < 128 * 64; idx += NTHR) { const int row = idx >> 6, q = idx & 63, p = row & 63, part = row >> 6, j = q >> 1, ci0 = (q & 1) * 8; float v[8];
        const float ar = apr[(31 - j) * 64 + p], ai = api[(31 - j) * 64 + p];
#pragma unroll
        for (int e = 0; e < 8; ++e) { const float br = bbr[p * 16 + ci0 + e], bi = bbi[p * 16 + ci0 + e]; v[e] = part ? (ar * bi + ai * br) : (ar * br - ai * bi); }
        v4u o; o.x = pk2(v[0], v[1]); o.y = pk2(v[2], v[3]); o.z = pk2(v[4], v[5]); o.w = pk2(v[6], v[7]);
        *(GAS v4u*)(BTS + ((size_t)g * 128 + row) * 512 + q * 8) = o; }
    if (tid < 64) { AP32[(g * 64 + tid) * 2] = apr[32 * 64 + tid]; AP32[(g * 64 + tid) * 2 + 1] = api[32 * 64 + tid]; }
    __syncthreads();
}

using pg8::Unit;
template <bool RS, bool F8 = false, bool O8 = false> struct EpiPlain {
    static constexpr bool PERM = true, AFTER_DRAIN = false, FP8 = F8;
    bf16* O; int ldc; int zdiv; long zC1, zC2; const LAS float* rstd;
    __device__ __forceinline__ void operator()(const f32x4 (&acc)[2][2][4][2], const Unit& u, int wr, int wc, int fr, int fq) const {
        const long zoff = (long)(u.z / zdiv) * zC1 + (long)(u.z % zdiv) * zC2;
        const int row0 = u.pm * 256 + wr * 64 + fr, col0 = u.pn * 256 + wc * 32 + 8 * fq;
#pragma unroll
        for (int ai = 0; ai < 2; ++ai)
#pragma unroll
            for (int m = 0; m < 4; ++m) { const int row = row0 + ai * 128 + m * 16; const size_t eo = (size_t)zoff + (size_t)row * ldc + col0;
                float sc = F8 ? W8_INV : 1.f; if (RS) sc *= rstd[row - u.pm * 256];
#pragma unroll
                for (int bj = 0; bj < 2; ++bj) { const f32x4 v0 = acc[ai][bj][m][0] * sc, v1 = acc[ai][bj][m][1] * sc;
                    if constexpr (O8) { v2u w; w.x = pk4_fp8(v0[0], v0[1], v0[2], v0[3]); w.y = pk4_fp8(v1[0], v1[1], v1[2], v1[3]); *(v2u*)((unsigned char*)O + eo + bj * 128) = w; }
                    else { v4u w; w.x = pg8::cvt_pk_bf16(v0[0], v0[1]); w.y = pg8::cvt_pk_bf16(v0[2], v0[3]); w.z = pg8::cvt_pk_bf16(v1[0], v1[1]); w.w = pg8::cvt_pk_bf16(v1[2], v1[3]);
                        *(v4u*)(O + eo + bj * 128) = w; } } }
    }
};
struct EpiProj {
    static constexpr bool PERM = true, AFTER_DRAIN = false;
    bf16* projb; bf16* Ag;
    __device__ __forceinline__ void operator()(const f32x4 (&acc)[2][2][4][2], const Unit& u, int wr, int wc, int fr, int fq) const {
        const int row0 = u.pm * 256 + wr * 64 + fr;
#pragma unroll
        for (int bj = 0; bj < 2; ++bj) { const int colg = u.pn * 256 + bj * 128 + wc * 32, c0 = colg + 8 * fq;
            if (colg >= INC) continue;
#pragma unroll
            for (int ai = 0; ai < 2; ++ai)
#pragma unroll
                for (int m = 0; m < 4; ++m) { const int row = row0 + ai * 128 + m * 16; const f32x4 v0 = acc[ai][bj][m][0], v1 = acc[ai][bj][m][1]; v4u w;
                    w.x = pg8::cvt_pk_bf16(v0[0], v0[1]); w.y = pg8::cvt_pk_bf16(v0[2], v0[3]); w.z = pg8::cvt_pk_bf16(v1[0], v1[1]); w.w = pg8::cvt_pk_bf16(v1[2], v1[3]);
                    if (colg < PJW) *(v4u*)(projb + (size_t)row * PJW + c0) = w;
                    else { const int ch = c0 - PJW, g = ch >> 4, c = ch & 15; *(v4u*)(Ag + ((size_t)g * 256 + (row >> 5)) * AGW + (row & 31) * 16 + c) = w; } } }
    }
};
struct EpiS5State {
    static constexpr bool PERM = false, AFTER_DRAIN = false;
    float* Sc;
    __device__ __forceinline__ void operator()(const f32x4 (&acc)[2][2][4][2], const Unit& u, int wr, int wc, int fr, int fq) const {
        const int row0 = wr * 64 + fr, col0 = wc * 32 + 4 * fq;
#pragma unroll
        for (int ai = 0; ai < 2; ++ai)
#pragma unroll
            for (int m = 0; m < 4; ++m) { float* rowp = Sc + ((size_t)u.z * 256 + row0 + ai * 128 + m * 16) * 128 + col0;
#pragma unroll
                for (int n = 0; n < 2; ++n) *(f32x4*)(rowp + n * 16) = acc[ai][0][m][n]; }
    }
};
__device__ __forceinline__ float gelu_tanh(float v) {
    const float t = v * (0.7978845608028654f + 0.7978845608028654f * 0.044715f * v * v);
    return v * __builtin_amdgcn_rcpf(1.0f + __builtin_amdgcn_exp2f(-2.885390081777927f * t));
}
struct EpiS5Y {
    static constexpr bool PERM = true, AFTER_DRAIN = false;
    const bf16* Ag; const float* dsk; bf16* Y;
    __device__ __forceinline__ void operator()(const f32x4 (&acc)[2][2][4][2], const Unit& u, int wr, int wc, int fr, int fq) const {
        const int g = u.z, row0 = wr * 64 + fr;
        v4u ub2[2][8]; f32x4 dd[2][2];
#pragma unroll
        for (int bj = 0; bj < 2; ++bj) { const int c0 = u.pn * 256 + bj * 128 + wc * 32 + 8 * fq, co = c0 & 15;
            dd[bj][0] = *(const f32x4*)(dsk + g * 16 + co); dd[bj][1] = *(const f32x4*)(dsk + g * 16 + co + 4);
#pragma unroll
            for (int q = 0; q < 8; ++q) ub2[bj][q] = *(const v4u*)(Ag + ((size_t)g * 256 + row0 + (q >> 2) * 128 + (q & 3) * 16) * AGW + c0); }
#pragma unroll
        for (int bj = 0; bj < 2; ++bj) { const int c0 = u.pn * 256 + bj * 128 + wc * 32 + 8 * fq, i = c0 >> 4, co = c0 & 15;
            const f32x4 d0 = dd[bj][0], d1 = dd[bj][1];
#pragma unroll
            for (int ai = 0; ai < 2; ++ai)
#pragma unroll
                for (int m = 0; m < 4; ++m) { const int r = row0 + ai * 128 + m * 16;
                    const v4u uu = ub2[bj][ai * 4 + m];
                    f32x4 v0 = acc[ai][bj][m][0], v1 = acc[ai][bj][m][1];
                    v0[0] += d0[0] * bflo(uu.x); v0[1] += d0[1] * bfhi(uu.x); v0[2] += d0[2] * bflo(uu.y); v0[3] += d0[3] * bfhi(uu.y);
                    v1[0] += d1[0] * bflo(uu.z); v1[1] += d1[1] * bfhi(uu.z); v1[2] += d1[2] * bflo(uu.w); v1[3] += d1[3] * bfhi(uu.w);
                    v4u w; w.x = pg8::cvt_pk_bf16(gelu_tanh(v0[0]), gelu_tanh(v0[1])); w.y = pg8::cvt_pk_bf16(gelu_tanh(v0[2]), gelu_tanh(v0[3]));
                    w.z = pg8::cvt_pk_bf16(gelu_tanh(v1[0]), gelu_tanh(v1[1])); w.w = pg8::cvt_pk_bf16(gelu_tanh(v1[2]), gelu_tanh(v1[3]));
                    *(v4u*)(Y + ((size_t)(r * 32 + i)) * SSMW + g * 16 + co) = w; } }
    }
};

struct EpiGlu {
    static constexpr bool PERM = true, AFTER_DRAIN = false;
    const bf16* Y; const float* bias; bf16* O;
    __device__ __forceinline__ void operator()(const f32x4 (&acc)[2][2][4][2], const Unit& u, int wr, int wc, int fr, int fq) const {
        const int row0 = u.pm * 256 + wr * 64 + fr;
        v4u yb2[2][8]; f32x4 bb[2][2];
#pragma unroll
        for (int bj = 0; bj < 2; ++bj) { const int c0 = u.pn * 256 + bj * 128 + wc * 32 + 8 * fq;
            bb[bj][0] = *(const f32x4*)(bias + c0); bb[bj][1] = *(const f32x4*)(bias + c0 + 4);
#pragma unroll
            for (int q = 0; q < 8; ++q) yb2[bj][q] = *(const v4u*)(Y + (size_t)(row0 + (q >> 2) * 128 + (q & 3) * 16) * SSMW + c0); }
#pragma unroll
        for (int bj = 0; bj < 2; ++bj) { const int c0 = u.pn * 256 + bj * 128 + wc * 32 + 8 * fq;
            const f32x4 b0 = bb[bj][0], b1 = bb[bj][1];
#pragma unroll
            for (int ai = 0; ai < 2; ++ai)
#pragma unroll
                for (int m = 0; m < 4; ++m) { const size_t off = (size_t)(row0 + ai * 128 + m * 16) * SSMW + c0;
                    const v4u yy = yb2[bj][ai * 4 + m]; const f32x4 z0 = acc[ai][bj][m][0] + b0, z1 = acc[ai][bj][m][1] + b1;
#define SG(z) __builtin_amdgcn_rcpf(1.0f + __builtin_amdgcn_exp2f(-1.4426950408889634f * (z)))
                    v4u w; w.x = pg8::cvt_pk_bf16(bflo(yy.x) * SG(z0[0]), bfhi(yy.x) * SG(z0[1])); w.y = pg8::cvt_pk_bf16(bflo(yy.y) * SG(z0[2]), bfhi(yy.y) * SG(z0[3]));
                    w.z = pg8::cvt_pk_bf16(bflo(yy.z) * SG(z1[0]), bfhi(yy.z) * SG(z1[1])); w.w = pg8::cvt_pk_bf16(bflo(yy.w) * SG(z1[2]), bfhi(yy.w) * SG(z1[3]));
#undef SG
                    *(v4u*)(O + off) = w; } }
    }
};
template <bool F8 = false> struct EpiResid {
    static constexpr bool PERM = false, AFTER_DRAIN = false, FP8 = F8;
    const float* res; float* Xo; bf16* Xb; float* ssq; unsigned char* X8;
    __device__ __forceinline__ void operator()(const f32x4 (&acc)[2][2][4][2], const Unit& u, int wr, int wc, int fr, int fq) const {
        const int row0 = u.pm * 256 + wr * 64 + fr, col0 = u.pn * 256 + wc * 32 + 4 * fq;
        constexpr int RB = 4;
        f32x4 rb[RB][4];
#define ER_LOAD(idx) do { const size_t off_ = (size_t)(row0 + ((idx) >> 2) * 128 + ((idx) & 3) * 16) * D + col0; _Pragma("unroll") for (int q = 0; q < 4; ++q) rb[(idx) % RB][q] = *(const f32x4*)(res + off_ + (q >> 1) * 128 + (q & 1) * 16); } while (0)
#pragma unroll
        for (int i = 0; i < RB - 1; ++i) ER_LOAD(i);
#pragma unroll
        for (int idx = 0; idx < 8; ++idx) { const int ai = idx >> 2, m = idx & 3, row = row0 + ai * 128 + m * 16; const size_t off = (size_t)row * D + col0; float s = 0.f;
            if (idx + RB - 1 < 8) ER_LOAD(idx + RB - 1);
#pragma unroll
            for (int bj = 0; bj < 2; ++bj)
#pragma unroll
                for (int n = 0; n < 2; ++n) { const size_t o2 = off + bj * 128 + n * 16; const f32x4 v = rb[idx % RB][bj * 2 + n] + acc[ai][bj][m][n] * (F8 ? W8_INV : 1.0f);
                    *(f32x4*)(Xo + o2) = v; if (Xb) { v2u w; w.x = pg8::cvt_pk_bf16(v[0], v[1]); w.y = pg8::cvt_pk_bf16(v[2], v[3]); *(v2u*)(Xb + o2) = w; }
                    if (X8) *(unsigned*)(X8 + o2) = pk4_fp8(v[0], v[1], v[2], v[3]);
                    s += (v[0] * v[0] + v[1] * v[1]) + (v[2] * v[2] + v[3] * v[3]); }
            s += __shfl_xor(s, 16); s += __shfl_xor(s, 32);
            if (fq == 0) ssq[(size_t)row * 32 + u.pn * 4 + wc] = s; }
#undef ER_LOAD
    }
};

template <bool FOLD = false> struct EpiSoftmax {
    static constexpr bool PERM = true, AFTER_DRAIN = true, FP8 = FOLD;
    bf16* Pm; const LAS float* rstd;
    __device__ __forceinline__ void fused(f32x4 (&acc)[2][2][4][2], const Unit& u, int wr, int wc, int fr, int fq, PG8_LAS unsigned char* lds, int wid, int lane) const {
        PG8_LAS float* Rm = (PG8_LAS float*)lds;
        PG8_LAS float* Rs = Rm + 1024;
        constexpr float CS = 1.4426950408889634f * 0.04419417382415922f;
        float mx[2][4];
        if constexpr (FOLD) {
#pragma unroll
            for (int ai = 0; ai < 2; ++ai)
#pragma unroll
                for (int m = 0; m < 4; ++m) { const float rs = rstd[ai * 128 + wr * 64 + m * 16 + fr];
#pragma unroll
                    for (int bj = 0; bj < 2; ++bj)
#pragma unroll
                        for (int n = 0; n < 2; ++n) acc[ai][bj][m][n] *= rs; } }
#pragma unroll
        for (int ai = 0; ai < 2; ++ai)
#pragma unroll
            for (int m = 0; m < 4; ++m) { float v = -3.0e38f;
#pragma unroll
                for (int bj = 0; bj < 2; ++bj)
#pragma unroll
                    for (int n = 0; n < 2; ++n) { const f32x4 a = acc[ai][bj][m][n]; v = fmaxf(v, fmaxf(fmaxf(a[0], a[1]), fmaxf(a[2], a[3]))); }
                v = fmaxf(v, __shfl_xor(v, 16)); v = fmaxf(v, __shfl_xor(v, 32));
                if (fq == 0) Rm[(ai * 128 + wr * 64 + m * 16 + fr) * 4 + wc] = v; }
        asm volatile("s_waitcnt lgkmcnt(0)" ::: "memory"); __builtin_amdgcn_s_barrier(); asm volatile("" ::: "memory");
#pragma unroll
        for (int ai = 0; ai < 2; ++ai)
#pragma unroll
            for (int m = 0; m < 4; ++m) { const int r = ai * 128 + wr * 64 + m * 16 + fr; const f32x4 q = *(const PG8_LAS f32x4*)(Rm + r * 4);
                const float rm = fmaxf(fmaxf(q[0], q[1]), fmaxf(q[2], q[3])) * CS; mx[ai][m] = rm; float s = 0.f;
#pragma unroll
                for (int bj = 0; bj < 2; ++bj)
#pragma unroll
                    for (int n = 0; n < 2; ++n) { f32x4 a = acc[ai][bj][m][n];
#pragma unroll
                        for (int e = 0; e < 4; ++e) { a[e] = __builtin_amdgcn_exp2f(fmaf(a[e], CS, -rm)); s += a[e]; }
                        acc[ai][bj][m][n] = a; }
                s += __shfl_xor(s, 16); s += __shfl_xor(s, 32);
                if (fq == 0) Rs[r * 4 + wc] = s; }
        asm volatile("s_waitcnt lgkmcnt(0)" ::: "memory"); __builtin_amdgcn_s_barrier(); asm volatile("" ::: "memory");
        bf16* base = Pm + (size_t)(FOLD ? u.z * XH + u.pn : u.z) * SEQ * MEM;
#pragma unroll
        for (int ai = 0; ai < 2; ++ai)
#pragma unroll
            for (int m = 0; m < 4; ++m) { const int r = ai * 128 + wr * 64 + m * 16 + fr; const f32x4 q = *(const PG8_LAS f32x4*)(Rs + r * 4);
                const float inv = __builtin_amdgcn_rcpf((q[0] + q[1]) + (q[2] + q[3]));
                bf16* rowp = base + (size_t)(u.pm * 256 + r) * MEM + wc * 32 + 8 * fq;
#pragma unroll
                for (int bj = 0; bj < 2; ++bj) { const f32x4 v0 = acc[ai][bj][m][0] * inv, v1 = acc[ai][bj][m][1] * inv; v4u w;
                    w.x = pg8::cvt_pk_bf16(v0[0], v0[1]); w.y = pg8::cvt_pk_bf16(v0[2], v0[3]); w.z = pg8::cvt_pk_bf16(v1[0], v1[1]); w.w = pg8::cvt_pk_bf16(v1[2], v1[3]);
                    *(v4u*)(rowp + bj * 128) = w; } }
        (void)mx;
    }
};

template <bool GATHER_> struct MoeSched {
    static constexpr bool GATHER = GATHER_;
    int NB, nN, G, c, lda; const char* A; const char* B; long tA, eB, tB;
    const LAS int* blkE; const LAS int* tokTab;
    __device__ __forceinline__ bool next(int i, Unit& u) const { const int L = i * G + c; if (L >= NB * nN) return false; u.z = L / nN; u.pn = L % nN; u.pm = i; return true; }
    __device__ __forceinline__ void ptrs(const Unit& u, const char*& a, const char*& b_) const { const int e = blkE[u.z]; a = GATHER_ ? A : A + (long)u.z * tA; b_ = B + (long)e * eB + (long)u.pn * tB; }
    __device__ __forceinline__ unsigned row_off(int ui, int row) const { return (unsigned)tokTab[ui * 256 + row] * (unsigned)lda; }
    __device__ __forceinline__ bool half1(const Unit& u) const { return blkE[320 + u.z] > 128; }
    __device__ __forceinline__ void a_ready(const Unit&) const {}
    __device__ __forceinline__ void done(const Unit&) const {}
};
struct EpiMoeUp {
    static constexpr bool PERM = true, AFTER_DRAIN = false, FP8 = true;
    const LAS int* blkE; const LAS int* tokTab; const float* ssq; const float* bup; unsigned char* ACT;
    __device__ __forceinline__ void operator()(const f32x4 (&acc)[2][2][4][2], const Unit& u, int wr, int wc, int fr, int fq) const {
        asm volatile("" : "+v"(fr), "+v"(fq));
        const int e = blkE[u.z], c0 = u.pn * 128 + wc * 32 + 8 * fq, row0 = wr * 64 + fr;
        const float* bg = bup + (size_t)e * 2 * FF + c0; const f32x4 g0 = *(const f32x4*)bg, g1 = *(const f32x4*)(bg + 4), l0 = *(const f32x4*)(bg + FF), l1 = *(const f32x4*)(bg + FF + 4);
        float rsb[8];
#pragma unroll
        for (int q = 0; q < 8; ++q) rsb[q] = ssq[tokTab[u.pm * 256 + row0 + (q >> 2) * 128 + (q & 3) * 16]] * W8_INV;
#pragma unroll
        for (int ai = 0; ai < 2; ++ai)
#pragma unroll
            for (int m = 0; m < 4; ++m) { const int r = row0 + ai * 128 + m * 16; const float rs = rsb[ai * 4 + m];
                float a[8];
#pragma unroll
                for (int j = 0; j < 8; ++j) { const float gb = j < 4 ? g0[j & 3] : g1[j & 3], lb = j < 4 ? l0[j & 3] : l1[j & 3];
                    const float gl = fminf(acc[ai][0][m][j >> 2][j & 3] * rs + gb, 7.0f), ln = fminf(fmaxf(acc[ai][1][m][j >> 2][j & 3] * rs + lb, -7.0f), 7.0f);
                    a[j] = gl * __builtin_amdgcn_rcpf(1.0f + __builtin_amdgcn_exp2f(-1.702f * 1.4426950408889634f * gl)) * (ln + 1.0f); }
                v2u w; w.x = pk4_fp8(a[0], a[1], a[2], a[3]); w.y = pk4_fp8(a[4], a[5], a[6], a[7]);
                *(v2u*)(ACT + ((size_t)u.z * 256 + r) * FF + c0) = w; }
    }
};
constexpr float Y8_SCALE = 32.0f, Y8_INV = 1.0f / 32.0f;
struct EpiMoeDown {
    static constexpr bool PERM = true, AFTER_DRAIN = false, FP8 = true;
    const LAS int* blkE; const float* bdn; unsigned char* YK;
    __device__ __forceinline__ void operator()(const f32x4 (&acc)[2][2][4][2], const Unit& u, int wr, int wc, int fr, int fq) const {
        const int e = blkE[u.z], row0 = wr * 64 + fr;
        f32x4 bq[2][2];
#pragma unroll
        for (int bj = 0; bj < 2; ++bj) { const int c0 = u.pn * 256 + bj * 128 + wc * 32 + 8 * fq; bq[bj][0] = *(const f32x4*)(bdn + (size_t)e * D + c0); bq[bj][1] = *(const f32x4*)(bdn + (size_t)e * D + c0 + 4); }
#pragma unroll
        for (int bj = 0; bj < 2; ++bj) { const int c0 = u.pn * 256 + bj * 128 + wc * 32 + 8 * fq; const f32x4 b0 = bq[bj][0] * Y8_SCALE, b1 = bq[bj][1] * Y8_SCALE;
#pragma unroll
            for (int ai = 0; ai < 2; ++ai)
#pragma unroll
                for (int m = 0; m < 4; ++m) { const int r = row0 + ai * 128 + m * 16; const f32x4 v0 = acc[ai][bj][m][0] * (W8_INV * Y8_SCALE) + b0, v1 = acc[ai][bj][m][1] * (W8_INV * Y8_SCALE) + b1; v2u w;
                    w.x = pk4_fp8(v0[0], v0[1], v0[2], v0[3]); w.y = pk4_fp8(v1[0], v1[1], v1[2], v1[3]);
                    *(v2u*)(YK + ((size_t)u.z * 256 + r) * D + c0) = w; } }
    }
};
__device__ __forceinline__ int moe_block_table(const unsigned* counts, LAS int* blkE, int tid) {
    if (tid < 64) {
        const int cnt = tid < E ? (int)counts[tid * CNT_STRIDE] : 0, nb = (cnt + 255) >> 8;
        int inc = nb;
#pragma unroll
        for (int o = 1; o < 64; o <<= 1) { const int v = __shfl_up(inc, o); if (tid >= o) inc += v; }
        const int base = inc - nb;
        for (int j = 0; j < nb; ++j) { blkE[base + j] = tid; blkE[160 + base + j] = j; const int left = cnt - j * 256; blkE[320 + base + j] = left < 256 ? left : 256; }
        if (tid == 63) blkE[480] = inc;
    }
    __syncthreads();
    return blkE[480];
}

struct TItem { const float* src; bf16* dst; const float* gain; int N, ldk; };
template <bool GAIN> __device__ __forceinline__ void titem_load(const TItem& d, int lane, f32x4 (&r)[16], f32x4 (&g)[4]) {
    const int q = lane & 15, kg = lane >> 4; const float* p = d.src + (size_t)(8 * kg) * d.N + 4 * q;
#pragma unroll
    for (int j = 0; j < 16; ++j) r[j] = *(const GAS f32x4*)(p + (size_t)(32 * (j >> 3) + (j & 7)) * d.N);
    if constexpr (GAIN) {
#pragma unroll
        for (int j4 = 0; j4 < 4; ++j4) g[j4] = *(const GAS f32x4*)(d.gain + 32 * (j4 >> 1) + 8 * kg + 4 * (j4 & 1)); }
    asm volatile("" ::: "memory"); __builtin_amdgcn_sched_barrier(0);
}
template <bool GAIN> __device__ __forceinline__ void titem_store(const TItem& d, int lane, const f32x4 (&r)[16], const f32x4 (&g)[4]) {
    const int q = lane & 15, kg = lane >> 4;
    bf16* o = d.dst + (size_t)(4 * q) * d.ldk + 8 * kg;
#define TG(j) (GAIN ? g[(j) >> 2][(j) & 3] : 1.0f)
#pragma unroll
    for (int i = 0; i < 4; ++i)
#pragma unroll
        for (int h = 0; h < 2; ++h) { v4u w;
            w.x = pg8::cvt_pk_bf16(r[8 * h + 0][i] * TG(8 * h + 0), r[8 * h + 1][i] * TG(8 * h + 1)); w.y = pg8::cvt_pk_bf16(r[8 * h + 2][i] * TG(8 * h + 2), r[8 * h + 3][i] * TG(8 * h + 3));
            w.z = pg8::cvt_pk_bf16(r[8 * h + 4][i] * TG(8 * h + 4), r[8 * h + 5][i] * TG(8 * h + 5)); w.w = pg8::cvt_pk_bf16(r[8 * h + 6][i] * TG(8 * h + 6), r[8 * h + 7][i] * TG(8 * h + 7));
            *(GAS v4u*)(o + (size_t)i * d.ldk + 32 * h) = w; }
#undef TG
}
template <bool GAIN, bool NT = false> __device__ __forceinline__ void titem8_load(const TItem& d, int lane, f32x4 (&r)[16], f32x4 (&g)[4]) {
    const int q = lane & 7, kg = lane >> 3; const unsigned lo = (unsigned)((16 * kg) * d.N + 4 * q) * 4u;
    const GAS char* base = (const GAS char*)d.src;
#pragma unroll
    for (int j = 0; j < 16; ++j) { const GAS f32x4* p = (const GAS f32x4*)(base + (size_t)j * (size_t)d.N * 4 + lo); r[j] = NT ? __builtin_nontemporal_load(p) : *p; }
    if constexpr (GAIN) { const GAS char* gb = (const GAS char*)d.gain; const unsigned go = (unsigned)(16 * kg) * 4u;
#pragma unroll
        for (int j4 = 0; j4 < 4; ++j4) g[j4] = *(const GAS f32x4*)(gb + 16 * j4 + go); }
    asm volatile("" ::: "memory"); __builtin_amdgcn_sched_barrier(0);
}
template <bool GAIN, bool NT = false> __device__ __forceinline__ void titem8_store(const TItem& d, int lane, const f32x4 (&r)[16], const f32x4 (&g)[4]) {
    const int q = lane & 7, kg = lane >> 3; const unsigned lo = (unsigned)((4 * q) * d.ldk + 16 * kg);
    GAS char* base = (GAS char*)d.dst;
    f32x4 s[16];
#pragma unroll
    for (int j = 0; j < 16; ++j) s[j] = r[j] * ((GAIN ? g[j >> 2][j & 3] : 1.0f) * W8_SCALE);
#pragma unroll
    for (int i = 0; i < 4; ++i) { v4u w;
        w.x = pk4_fp8w(s[0][i], s[1][i], s[2][i], s[3][i]); w.y = pk4_fp8w(s[4][i], s[5][i], s[6][i], s[7][i]);
        w.z = pk4_fp8w(s[8][i], s[9][i], s[10][i], s[11][i]); w.w = pk4_fp8w(s[12][i], s[13][i], s[14][i], s[15][i]);
        GAS v4u* p = (GAS v4u*)(base + (size_t)i * (size_t)d.ldk + lo);
        if (NT) __builtin_nontemporal_store(w, p); else *p = w; }
}
#define TSTREAM(n_, DEC, LOAD, STORE) do { f32x4 ra[16], rb[16], ga[4], gb[4]; int it0 = gw; \
        if (it0 < (n_)) { TItem d0 = DEC(it0); LOAD(d0, lane, ra, ga); \
            for (;;) { const int it1 = it0 + NGW; \
                if (!(it1 < (n_))) { STORE(d0, lane, ra, ga); break; } \
                TItem d1 = DEC(it1); LOAD(d1, lane, rb, gb); STORE(d0, lane, ra, ga);            \
                it0 = it1 + NGW; \
                if (!(it0 < (n_))) { STORE(d1, lane, rb, gb); break; } \
                d0 = DEC(it0); LOAD(d0, lane, ra, ga); STORE(d1, lane, rb, gb); } } } while (0)

#define TI8S_NT titem8_store<false, true>
#define TI8L_NT titem8_load<false, true>
struct MoeSchedUpCv : MoeSched<true> {
    const float* wdn; unsigned char* wdn8; int wave;
    __device__ __forceinline__ TItem dec_dn(int it) const { constexpr int I_DN = (FF / 128) * (D / 32); TItem d; int r = it; const int e = r / I_DN; r -= e * I_DN;
        const int nb_ = D / 32, kb = r / nb_, nbi = r % nb_; d.src = wdn + (size_t)e * FF * D + (size_t)(128 * kb) * D + 32 * nbi; d.dst = (bf16*)(wdn8 + (size_t)e * D * FF + (size_t)(32 * nbi) * FF + 128 * kb);
        d.gain = wdn; d.N = D; d.ldk = FF; return d; }
    __device__ __forceinline__ void convert_share() const {
        const int lane = lane_id_now(), gw = c * NWAVES + wave, NGW = G * NWAVES;
        constexpr int NIT = E * (FF / 128) * (D / 32);
        TSTREAM(NIT, dec_dn, TI8L_NT, TI8S_NT);
    }
    __device__ __forceinline__ void done(const Unit& u) const { if (u.pm == (c & 7)) convert_share(); }
};

constexpr int CV_I_UP = (D / 128) * (2 * FF / 32), CV_ITEMS = E * CV_I_UP;
constexpr int CV_BATCH = 4;
struct CvWork { const float* wup; const float* gain; unsigned char* wup8; volatile LAS int* cur; volatile LAS unsigned* rel; unsigned* q; int wave; };
__device__ __forceinline__ bool cv_one(const CvWork& w) {
    if (w.wave == 0) return false;
    int it = __builtin_amdgcn_readfirstlane(w.cur[2 * w.wave]); const int end = __builtin_amdgcn_readfirstlane(w.cur[2 * w.wave + 1]);
    if (it >= end) {
        if (it > CV_ITEMS) return false;
        unsigned base = 0u; if (lane_id_now() == 0) base = __hip_atomic_fetch_add(w.q, (unsigned)CV_BATCH, __ATOMIC_RELAXED, __HIP_MEMORY_SCOPE_AGENT);
        base = __builtin_amdgcn_readfirstlane(base);
        if (base >= (unsigned)CV_ITEMS) { w.cur[2 * w.wave] = CV_ITEMS + 1; w.cur[2 * w.wave + 1] = 0; return false; }
        it = (int)base; w.cur[2 * w.wave + 1] = (int)base + CV_BATCH;
    }
    TItem d; { int r = it; const int e = r / CV_I_UP; r -= e * CV_I_UP; const int nb_ = 2 * FF / 32, kb = r / nb_, nbi = r % nb_;
        d.src = w.wup + (size_t)e * D * 2 * FF + (size_t)(128 * kb) * (2 * FF) + 32 * nbi; d.dst = (bf16*)(w.wup8 + (size_t)e * 2 * FF * D + (size_t)(32 * nbi) * D + 128 * kb);
        d.gain = w.gain + 128 * kb; d.N = 2 * FF; d.ldk = D; }
    const int lane = lane_id_now();
    f32x4 r[16], g[4]; titem8_load<true, true>(d, lane, r, g); titem8_store<true, true>(d, lane, r, g);
    w.cur[2 * w.wave] = it + 1;
    return true;
}
__device__ __forceinline__ void cv_flush(const CvWork& w) { while (cv_one(w)) {} }
__device__ __forceinline__ void xcd_barrier_cv(const XcdBarrier& b, const CvWork& w) {
    asm volatile("s_waitcnt vmcnt(0)" ::: "memory");
    const unsigned g0 = w.rel[0];
    __syncthreads();
    if (b.wave == 0) {
        xb_wave0(b, w.rel + 1, g0 + 1u);
        w.rel[0] = g0 + 1u;
    } else if (b.wave != 0) {
        unsigned guard = 0;
        while (w.rel[0] == g0) { if (w.rel[1] == g0 + 1u) { __builtin_amdgcn_s_sleep(1); continue; }
            if (!cv_one(w)) __builtin_amdgcn_s_sleep(4); if (++guard > (1u << 22)) break; }
    }
    asm volatile("s_waitcnt lgkmcnt(0)" ::: "memory"); __builtin_amdgcn_s_barrier(); asm volatile("" ::: "memory");
}

namespace mla {
typedef short s16x4 __attribute__((ext_vector_type(4)));
typedef float f32x16 __attribute__((ext_vector_type(16)));
constexpr int KVBLK = 64, QB = 256;
constexpr int SHM_V = KVBLK * 128 * 2, SHM_K = KVBLK * 128 * 2, SHM_P = KVBLK * 64 * 2;
constexpr int BUFB = SHM_V + SHM_K + SHM_P, V_OFF = 0, K_OFF = SHM_V, P_OFF = SHM_V + SHM_K, NBUF = 3, W_OFF = NBUF * BUFB;
constexpr float C2 = 1.4426950408889634f * 0.07216878364870322f;
#define KSWZ(row, colB) ((row) * 256 + ((colB) ^ (((row) & 7) << 4)))
#define KPSWZ(row, colB) ((row) * 128 + ((colB) ^ ((((row) >> 1) & 7) << 4)))
#define SBAR() __builtin_amdgcn_sched_barrier(0)
__device__ __forceinline__ int v_st(int k, int c) { const int kk = (k & ~0xC) | ((k & 4) << 1) | ((k & 8) >> 1); return ((kk >> 3) * 4 + (c >> 5)) * 512 + ((kk & 7) * 32 + (c & 31)) * 2; }
__device__ __forceinline__ int v_rd_base(int lane) { return ((lane & 3) << 3) | (((lane >> 2) & 3) << 6) | (((lane >> 4) & 1) << 5) | (((lane >> 5) & 1) << 8); }
constexpr int v_rd_off(int d0, int ks, int half) { return d0 * 512 + ks * 4096 + half * 2048; }
__device__ __forceinline__ int crow(int r, int hi) { return (r & 3) + 8 * (r >> 2) + 4 * hi; }
__device__ __forceinline__ unsigned cvtpk(float lo, float hi) { unsigned r; asm volatile("v_cvt_pk_bf16_f32 %0, %1, %2" : "=v"(r) : "v"(lo), "v"(hi)); return r; }

__device__ __forceinline__ void mask_tile(f32x16& p0, f32x16& p1, int dq) {
    const float NEG = -__builtin_inff();
#pragma unroll
    for (int r = 0; r < 16; ++r) { const int c = (r & 3) + 8 * (r >> 2);
        if (dq - c < 0) p0[r] = NEG;
        if (dq - c - 32 < 0) p1[r] = NEG; }
}
__device__ __forceinline__ void partialSM(f32x16& p0, f32x16& p1, float& m_reg, float& mn, float& alpha) {
    float pmax = p0[0];
#pragma unroll
    for (int r = 1; r < 16; ++r) pmax = fmaxf(pmax, p0[r]);
#pragma unroll
    for (int r = 0; r < 16; ++r) pmax = fmaxf(pmax, p1[r]);
    { auto rr = __builtin_amdgcn_permlane32_swap(__float_as_uint(pmax), __float_as_uint(pmax), false, false);
      pmax = fmaxf(__uint_as_float(rr[0]), __uint_as_float(rr[1])); }
    mn = fmaxf(m_reg, pmax); alpha = __builtin_amdgcn_exp2f((m_reg - mn) * C2); m_reg = mn;
    const float mnL = -mn * C2;
#pragma unroll
    for (int r = 0; r < 16; ++r) p0[r] = __builtin_amdgcn_exp2f(fmaf(p0[r], C2, mnL));
#pragma unroll
    for (int r = 0; r < 16; ++r) p1[r] = __builtin_amdgcn_exp2f(fmaf(p1[r], C2, mnL));
}
__device__ __forceinline__ void finishSM(f32x16& p0, f32x16& p1, float alpha, float& l_reg, bf16x8& pa0, bf16x8& pa1, bf16x8& pa2, bf16x8& pa3) {
    float ps = 0;
#pragma unroll
    for (int r = 0; r < 16; ++r) ps += p0[r];
#pragma unroll
    for (int r = 0; r < 16; ++r) ps += p1[r];
    { auto rr = __builtin_amdgcn_permlane32_swap(__float_as_uint(ps), __float_as_uint(ps), false, false);
      ps = __uint_as_float(rr[0]) + __uint_as_float(rr[1]); }
    l_reg = l_reg * alpha + ps;
#define PK4(P, B_, OUT) do { unsigned a0 = cvtpk(P[B_+0], P[B_+1]), a1 = cvtpk(P[B_+2], P[B_+3]);                          \
        unsigned b0 = cvtpk(P[B_+4], P[B_+5]), b1 = cvtpk(P[B_+6], P[B_+7]);                                             \
        auto r0 = __builtin_amdgcn_permlane32_swap(a0, b0, false, false); auto r1 = __builtin_amdgcn_permlane32_swap(a1, b1, false, false); \
        v4u w = {r0[0], r1[0], r0[1], r1[1]}; OUT = *reinterpret_cast<bf16x8*>(&w); } while (0)
    PK4(p0, 0, pa0); PK4(p0, 8, pa1); PK4(p1, 0, pa2); PK4(p1, 8, pa3);
#undef PK4
}
__device__ __forceinline__ void qkt(f32x16& p0, f32x16& p1, LAS unsigned char* lds  , int r32, int hi, const bf16x8* qr) {
    p0 = f32x16{}; p1 = f32x16{};
    const LAS unsigned char* kb[4];
#pragma unroll
    for (int dd = 0; dd < 4; ++dd) kb[dd] = lds + K_OFF + KSWZ(r32, (dd * 16 + hi * 8) * 2);
#pragma unroll
    for (int d0 = 0; d0 < 8; ++d0) { const LAS unsigned char* a = kb[d0 & 3] + (d0 >> 2) * 128;
        const bf16x8 b0 = *(const LAS bf16x8*)(a);
        const bf16x8 b1 = *(const LAS bf16x8*)(a + 32 * 256);
        p0 = __builtin_amdgcn_mfma_f32_32x32x16_bf16(b0, qr[d0], p0, 0, 0, 0);
        p1 = __builtin_amdgcn_mfma_f32_32x32x16_bf16(b1, qr[d0], p1, 0, 0, 0); }
#pragma unroll
    for (int e = 0; e < 4; ++e) { const LAS unsigned char* a = lds + P_OFF + KPSWZ(r32, (e * 2 + hi) * 16);
        const bf16x8 b0 = *(const LAS bf16x8*)(a);
        const bf16x8 b1 = *(const LAS bf16x8*)(a + 32 * 128);
        p0 = __builtin_amdgcn_mfma_f32_32x32x16_bf16(b0, qr[8 + e], p0, 0, 0, 0);
        p1 = __builtin_amdgcn_mfma_f32_32x32x16_bf16(b1, qr[8 + e], p1, 0, 0, 0); }
}
__device__ __forceinline__ void pv_tile(f32x16* o, int vb0  , bf16x8 pa0, bf16x8 pa1, bf16x8 pa2, bf16x8 pa3) {
#define TRRD(dst, off) asm volatile("ds_read_b64_tr_b16 %0, %1 offset:%2" : "=&v"(dst) : "v"(vb0), "i"(off) : "memory")
#define PV_D0(d0) do { s16x4 l0, l1, l2, l3, h0, h1, h2, h3; constexpr int b_ = V_OFF + v_rd_off(d0, 0, 0); \
        TRRD(l0, b_); TRRD(h0, b_ + 2048); TRRD(l1, b_ + 4096); TRRD(h1, b_ + 6144); TRRD(l2, b_ + 8192); TRRD(h2, b_ + 10240); TRRD(l3, b_ + 12288); TRRD(h3, b_ + 14336); \
        asm volatile("s_waitcnt lgkmcnt(0)" ::: "memory"); SBAR();   \
        o[d0] = __builtin_amdgcn_mfma_f32_32x32x16_bf16(pa0, (bf16x8){l0[0], l0[1], l0[2], l0[3], h0[0], h0[1], h0[2], h0[3]}, o[d0], 0, 0, 0);   \
        o[d0] = __builtin_amdgcn_mfma_f32_32x32x16_bf16(pa1, (bf16x8){l1[0], l1[1], l1[2], l1[3], h1[0], h1[1], h1[2], h1[3]}, o[d0], 0, 0, 0);   \
        o[d0] = __builtin_amdgcn_mfma_f32_32x32x16_bf16(pa2, (bf16x8){l2[0], l2[1], l2[2], l2[3], h2[0], h2[1], h2[2], h2[3]}, o[d0], 0, 0, 0);   \
        o[d0] = __builtin_amdgcn_mfma_f32_32x32x16_bf16(pa3, (bf16x8){l3[0], l3[1], l3[2], l3[3], h3[0], h3[1], h3[2], h3[3]}, o[d0], 0, 0, 0); } while (0)
    PV_D0(0); PV_D0(1); PV_D0(2); PV_D0(3);
#undef PV_D0
#undef TRRD
}

__device__ __forceinline__ void attn_unit(LAS unsigned char* lds, int b, int h, int qb, const bf16* Q  , const bf16* KV  , const bf16* KPE  ,
                                          const float* ROPE  , bf16* O  , const int wave_) {
    int tid_ = wave_ * 64 + lane_id_now(); asm volatile("" : "+v"(tid_));
    const int tid = tid_, wid = __builtin_amdgcn_readfirstlane(tid >> 6), lane = tid & 63, r32 = lane & 31, hi = lane >> 5;
    const int NT = ((15 - qb) * 128 + 128) / KVBLK;
    const int qlo = (wid < 4 ? qb * 128 + wid * 32 : (15 - qb) * 128 + (wid - 4) * 32), qm = qlo + r32 - 4 * hi;
    const size_t tok0 = (size_t)b * SEQ;
    bf16x8 qr[12];
    { const size_t t = tok0 + qlo + r32; const bf16* qp = Q + t * 1536 + h * 192 + hi * 8;
#pragma unroll
      for (int d0 = 0; d0 < 12; ++d0) qr[d0] = *(const bf16x8*)(qp + d0 * 16);
      const float* rp = ROPE + t * 64 + hi * 8;
#pragma unroll
      for (int e = 0; e < 2; ++e) {
          const f32x4 c0 = *(const f32x4*)(rp + 16 * e), c1 = *(const f32x4*)(rp + 16 * e + 4), s0 = *(const f32x4*)(rp + 32 + 16 * e), s1 = *(const f32x4*)(rp + 32 + 16 * e + 4);
          const v4u xa = *reinterpret_cast<v4u*>(&qr[8 + e]), xb = *reinterpret_cast<v4u*>(&qr[10 + e]); v4u ya, yb;
#define ROPE2(W, CL, CH, SL, SH) { const float a0 = bflo(xa.W), a1 = bfhi(xa.W), b0 = bflo(xb.W), b1 = bfhi(xb.W); \
          ya.W = cvtpk(a0 * CL - b0 * SL, a1 * CH - b1 * SH); yb.W = cvtpk(b0 * CL + a0 * SL, b1 * CH + a1 * SH); }
          ROPE2(x, c0[0], c0[1], s0[0], s0[1]); ROPE2(y, c0[2], c0[3], s0[2], s0[3]); ROPE2(z, c1[0], c1[1], s1[0], s1[1]); ROPE2(w, c1[2], c1[3], s1[2], s1[3]);
#undef ROPE2
          qr[8 + e] = *reinterpret_cast<bf16x8*>(&ya); qr[10 + e] = *reinterpret_cast<bf16x8*>(&yb); } }
    const int vb0 = (int)(uintptr_t)(lds) + v_rd_base(lane);
    LAS float* wsf = (LAS float*)(lds + W_OFF) + wid * 64; LAS float* li_l = wsf; LAS float* al_l = wsf + 32;
    unsigned so[5];
#pragma unroll
    for (int p = 0; p < 2; ++p) { const int s = p * 512 + tid;
        { const int sub = s >> 5, within = s & 31, kk = (sub >> 2) * 8 + (within >> 2), k = (kk & ~0xC) | ((kk & 4) << 1) | ((kk & 8) >> 1), c = (sub & 3) * 32 + (within & 3) * 8;
          so[p] = (unsigned)(k * 2048 + h * 256 + 128 + c); }
        { const int row = s >> 4, chunk = (s & 15) ^ (row & 7); so[2 + p] = (unsigned)(row * 2048 + h * 256 + chunk * 8); } }
    { const int row = tid >> 3, chunk = (tid & 7) ^ ((row >> 1) & 7); so[4] = (unsigned)(row * 64 + chunk * 8); }
    const bf16* KVt = KV + tok0 * 2048; const bf16* KPt = KPE + tok0 * 64;
#define AISSUE(tile, bufoff) do { const bf16* kv_ = KVt + (size_t)(tile) * (KVBLK * 2048); const bf16* kp_ = KPt + (size_t)(tile) * (KVBLK * 64); \
        __builtin_amdgcn_global_load_lds((const unsigned*)(kv_ + so[0]), (LAS unsigned*)(lds + (bufoff) + V_OFF + wid * 1024), 16, 0, 0); \
        __builtin_amdgcn_global_load_lds((const unsigned*)(kv_ + so[1]), (LAS unsigned*)(lds + (bufoff) + V_OFF + 8192 + wid * 1024), 16, 0, 0); \
        __builtin_amdgcn_global_load_lds((const unsigned*)(kv_ + so[2]), (LAS unsigned*)(lds + (bufoff) + K_OFF + wid * 1024), 16, 0, 0); \
        __builtin_amdgcn_global_load_lds((const unsigned*)(kv_ + so[3]), (LAS unsigned*)(lds + (bufoff) + K_OFF + 8192 + wid * 1024), 16, 0, 0); \
        __builtin_amdgcn_global_load_lds((const unsigned*)(kp_ + so[4]), (LAS unsigned*)(lds + (bufoff) + P_OFF + wid * 1024), 16, 0, 0); } while (0)
    float m_reg = -1e30f, l_reg = 0.f; f32x16 o[4] = {};
    f32x16 p0, p1; float mn, alpha; bf16x8 pa0, pa1, pa2, pa3;
    asm volatile("s_waitcnt vmcnt(0)" ::: "memory");
    AISSUE(0, 0); AISSUE(1, BUFB);
    int bc = 0, bl = 2 * BUFB;
    for (int t = 0; t < NT; ++t) {
        asm volatile("s_waitcnt vmcnt(5)" ::: "memory"); __builtin_amdgcn_s_barrier();
        { const int tn = (t + 2 < NT) ? t + 2 : NT - 1; AISSUE(tn, bl); }
        const int kb_ = t * KVBLK;
        if (kb_ <= qlo + 31) {
            SBAR(); qkt(p0, p1, lds + bc, r32, hi, qr);
            if (kb_ + KVBLK - 1 > qlo) mask_tile(p0, p1, qm - kb_);
            partialSM(p0, p1, m_reg, mn, alpha);
            if (__any(alpha < 1.f)) { if (hi == 0) al_l[r32] = alpha; LDS_WAIT();
#pragma unroll
                for (int d_ = 0; d_ < 4; ++d_)
#pragma unroll
                    for (int r = 0; r < 16; ++r) o[d_][r] *= al_l[crow(r, hi)]; }
            finishSM(p0, p1, alpha, l_reg, pa0, pa1, pa2, pa3); SBAR();
            pv_tile(o, vb0 + bc, pa0, pa1, pa2, pa3); }
        bc = (bc == 2 * BUFB) ? 0 : bc + BUFB; bl = (bl == 2 * BUFB) ? 0 : bl + BUFB;
    }
#undef AISSUE
    asm volatile("s_waitcnt vmcnt(0)" ::: "memory");
    if (hi == 0) li_l[r32] = l_reg; LDS_WAIT();
    bf16* Ow = O + (tok0 + qlo) * 1024 + h * 128;
#pragma unroll
    for (int r = 0; r < 16; ++r) { const int orow = crow(r, hi); const float rl = __builtin_amdgcn_rcpf(li_l[orow]);
#pragma unroll
        for (int d0 = 0; d0 < 4; ++d0) { const float v = o[d0][r] * rl; const float vn = __shfl_xor(v, 1);
            if ((r32 & 1) == 0) *(unsigned*)(Ow + (size_t)orow * 1024 + d0 * 32 + r32) = cvtpk(v, vn); } }
    __syncthreads();
}
#undef KSWZ
#undef KPSWZ
#undef SBAR
}

struct Args { const void* in[36]; float* out; unsigned char* ws; int ph_lo, ph_hi, li, pad; };
constexpr int N_PHASES = 15;

__device__ __forceinline__ void mla_thin_token(int t, int lane, const bf16* projb, const float* qg, const float* kvg, const int* pos, bf16* cqn, bf16* ckvn, bf16* kpe, float* rope) {
    const unsigned* pr = (const unsigned*)(projb + (size_t)t * PJW);
    unsigned wq[3], wk[2]; float sq = 0.f, sk = 0.f;
    v2f gq[3], gk[2];
#pragma unroll
    for (int j = 0; j < 3; ++j) { wq[j] = pr[lane + 64 * j]; gq[j] = *(const v2f*)(qg + 2 * (lane + 64 * j)); }
#pragma unroll
    for (int j = 0; j < 2; ++j) { wk[j] = pr[192 + lane + 64 * j]; gk[j] = *(const v2f*)(kvg + 2 * (lane + 64 * j)); }
    const int pos_t = pos[t]; const bf16* kp = projb + (size_t)t * PJW + 640; const float x1 = bf2f(kp[lane & 31]), x2 = bf2f(kp[(lane & 31) + 32]);
#pragma unroll
    for (int j = 0; j < 3; ++j) { const float a = bflo(wq[j]), b = bfhi(wq[j]); sq += a * a + b * b; }
#pragma unroll
    for (int j = 0; j < 2; ++j) { const float a = bflo(wk[j]), b = bfhi(wk[j]); sk += a * a + b * b; }
    const float rq = rsqrtf(wave_sum(sq) * (1.f / QL) + EPS), rk = rsqrtf(wave_sum(sk) * (1.f / KVL) + EPS);
#pragma unroll
    for (int j = 0; j < 3; ++j) ((unsigned*)(cqn + (size_t)t * QL))[lane + 64 * j] = pk2(bflo(wq[j]) * rq * gq[j][0], bfhi(wq[j]) * rq * gq[j][1]);
#pragma unroll
    for (int j = 0; j < 2; ++j) ((unsigned*)(ckvn + (size_t)t * KVL))[lane + 64 * j] = pk2(bflo(wk[j]) * rk * gk[j][0], bfhi(wk[j]) * rk * gk[j][1]);
    if (lane < 32) {
        const float inv = 1.0f / powf(10000.0f, (float)(2 * lane) / 64.0f), ang = (float)pos_t * inv, c = cosf(ang), s = sinf(ang);
        rope[(size_t)t * 64 + lane] = c; rope[(size_t)t * 64 + 32 + lane] = s;
        kpe[(size_t)t * 64 + lane] = (bf16)f2bf(x1 * c - x2 * s); kpe[(size_t)t * 64 + 32 + lane] = (bf16)f2bf(x2 * c + x1 * s);
    }
}
__device__ __forceinline__ void s5_scan_group(int g, LAS unsigned char* lds, const float* Sc, const float* AP32, bf16* Ag, int tid) {
    LAS f32x4* S4 = (LAS f32x4*)lds;
    const GAS f32x4* src = (const GAS f32x4*)(Sc + (size_t)g * 256 * 128);
#pragma unroll 16
    for (int i = tid; i < 256 * 32; i += NTHR) S4[i] = src[i];
    __syncthreads();
    if (tid < 256) { const int b = tid >> 6, p = tid & 63; const float ar = AP32[(g * 64 + p) * 2], ai = AP32[(g * 64 + p) * 2 + 1]; float xr = 0.f, xi = 0.f;
        const LAS float* S = (const LAS float*)lds;
        for (int ch = 0; ch < NCH; ++ch) { const int row = b * NCH + ch; bf16* o = Ag + ((size_t)g * 256 + row) * AGW + 512;
            o[p] = (bf16)f2bf(xr); o[64 + p] = (bf16)f2bf(xi);
            const float sr = S[row * 128 + p], si = S[row * 128 + 64 + p];
            const float nr = ar * xr - ai * xi + sr, ni = ar * xi + ai * xr + si; xr = nr; xi = ni; } }
    VM_WAIT(); __syncthreads();
}

__device__ __forceinline__ void route_tile(int tile, LAS unsigned char* lds, const float* X2, const float* ssq2, float* rstd2, const bf16* WRH, const bf16* WRL, const float* brt,
                                           unsigned* counts, int* SELE, int* SELP, float* SELG, int* LIST, int tid) {
    typedef float f32x16 __attribute__((ext_vector_type(16)));
    const int wid = tid >> 6, lane = tid & 63, r32 = lane & 31, hi = lane >> 5, t0 = tile * 32;
    f32x16 acc = {};
    const float* xp = X2 + (size_t)(t0 + r32) * D + wid * 256 + hi * 8;
    const bf16* wh = WRH + (size_t)r32 * D + wid * 256 + hi * 8; const bf16* wl = WRL + (size_t)r32 * D + wid * 256 + hi * 8;
#pragma unroll 4
    for (int s = 0; s < 16; ++s) {
        const f32x4 a = *(const f32x4*)(xp + 16 * s), b = *(const f32x4*)(xp + 16 * s + 4);
        float xv[8] = {a[0], a[1], a[2], a[3], b[0], b[1], b[2], b[3]}; unsigned hh[8], ll[8];
#pragma unroll
        for (int j = 0; j < 8; ++j) { hh[j] = f2bf(xv[j]); ll[j] = f2bf(xv[j] - __builtin_bit_cast(float, hh[j] << 16)); }
        v4u ph = {hh[0] | (hh[1] << 16), hh[2] | (hh[3] << 16), hh[4] | (hh[5] << 16), hh[6] | (hh[7] << 16)}, pl = {ll[0] | (ll[1] << 16), ll[2] | (ll[3] << 16), ll[4] | (ll[5] << 16), ll[6] | (ll[7] << 16)};
        const bf16x8 xh = *reinterpret_cast<bf16x8*>(&ph), xl = *reinterpret_cast<bf16x8*>(&pl);
        const bf16x8 bh = *(const bf16x8*)(wh + 16 * s), bl = *(const bf16x8*)(wl + 16 * s);
        acc = __builtin_amdgcn_mfma_f32_32x32x16_bf16(xh, bh, acc, 0, 0, 0);
        acc = __builtin_amdgcn_mfma_f32_32x32x16_bf16(xl, bh, acc, 0, 0, 0);
        acc = __builtin_amdgcn_mfma_f32_32x32x16_bf16(xh, bl, acc, 0, 0, 0);
    }
    LAS float* red = (LAS float*)lds;
    LAS float* lg = red + 8 * 32 * 33;
#pragma unroll
    for (int r = 0; r < 16; ++r) red[(wid * 32 + ((r & 3) + 8 * (r >> 2) + 4 * hi)) * 33 + r32] = acc[r];
    __syncthreads();
    for (int idx = tid; idx < 1024; idx += NTHR) { const int tk = idx >> 5, e = idx & 31; float s = 0.f;
#pragma unroll
        for (int w = 0; w < 8; ++w) s += red[(w * 32 + tk) * 33 + e];
        lg[tk * 33 + e] = s; }
    __syncthreads();
    if (tid < 32) { const int t = t0 + tid; float sq = 0.f;
#pragma unroll
        for (int k = 0; k < 8; ++k) { const f32x4 v = *(const f32x4*)(ssq2 + (size_t)t * 32 + 4 * k); sq += v[0]; sq += v[1]; sq += v[2]; sq += v[3]; }
        const float rs = rsqrtf(sq * (1.f / D) + EPS); rstd2[t] = rs;
        float l[E];
#pragma unroll
        for (int e = 0; e < E; ++e) l[e] = lg[tid * 33 + e] * rs + brt[e];
        float tv[TOPK]; int ti[TOPK];
#pragma unroll
        for (int k = 0; k < TOPK; ++k) { float best = -INFINITY; int bi = 0;
#pragma unroll
            for (int e = 0; e < E; ++e) if (l[e] > best) { best = l[e]; bi = e; }
            tv[k] = best; ti[k] = bi;
#pragma unroll
            for (int e = 0; e < E; ++e) if (e == bi) l[e] = -INFINITY; }
        float sum = 0.f, ex[TOPK];
#pragma unroll
        for (int k = 0; k < TOPK; ++k) { ex[k] = expf(tv[k] - tv[0]); sum += ex[k]; }
        LAS unsigned* lcnt = (LAS unsigned*)(lg + 32 * 33); LAS unsigned* lbase = lcnt + 32;
        lcnt[tid] = 0u; LDS_WAIT();
        int lp[TOPK];
#pragma unroll
        for (int k = 0; k < TOPK; ++k) lp[k] = (int)__hip_atomic_fetch_add(&lcnt[ti[k]], 1u, __ATOMIC_RELAXED, __HIP_MEMORY_SCOPE_WORKGROUP);
        LDS_WAIT();
        { const unsigned n = lcnt[tid]; lbase[tid] = n ? atomicAdd(&counts[tid * CNT_STRIDE], n) : 0u; }
        LDS_WAIT();
#pragma unroll
        for (int k = 0; k < TOPK; ++k) { const int pos = (int)lbase[ti[k]] + lp[k];
            SELE[t * TOPK + k] = ti[k]; SELP[t * TOPK + k] = pos; SELG[t * TOPK + k] = ex[k] / sum; LIST[(size_t)ti[k] * T + pos] = t; } }
    __syncthreads();
}

__global__ void __launch_bounds__(NTHR, 2) fwd(Args args) {
    extern __shared__ __attribute__((aligned(16))) unsigned char lds_raw[];
    LAS unsigned char* lds = (LAS unsigned char*)lds_raw;
    volatile LAS unsigned* MISC = (volatile LAS unsigned*)(lds + MISC_OFF);
    int wave_ = __builtin_amdgcn_readfirstlane((int)threadIdx.x >> 6); asm volatile("" : "+s"(wave_));
    const int wave = wave_;
#define LANE_NOW() ({ int l_ = lane_id_now(); asm volatile("" : "+v"(l_)); l_; })
    const int NG = gridDim.x, bx = blockIdx.x;
    unsigned char* ws = args.ws;
    unsigned* ctl = (unsigned*)(ws + WS_CTL);
    { const int tid = wave * 64 + LANE_NOW();
      for (int u = tid; u < (LDS_BYTES - LDSCTL_OFF) / 4; u += NTHR) ((LAS unsigned*)(lds + LDSCTL_OFF))[u] = 0u; }
    __syncthreads();
    const int lo = args.ph_lo, hi = args.ph_hi;
    const bool multi = (hi - lo) > 1;
    XcdBarrier bar; bar.bar = ctl + CW_BAR + args.li * XCD_BAR_WORDS; bar.x = 0; bar.st = nullptr; bar.wave = wave;
    if (multi) bar = xcd_barrier_post(ctl + CW_BAR + args.li * XCD_BAR_WORDS, MISC + 8, wave);
#define IN(k) (lo <= (k) && (k) < hi)
#define BOTH(k) (IN(k) && IN((k) + 1))
#define GRID_BAR() xcd_barrier(bar)
#define GRID_BAR_CV() xcd_barrier_cv(bar, cvw)
#if defined(PROBE_PHASE) || defined(PROBE_RANGE)
#define PRB(p, T_) ((args.li == 1) ? (T_)(ws + WS_END1 + (8u << 20)) : (T_)(p))
#else
#define PRB(p, T_) ((T_)(p))
#endif
#define INP(i) ((const float*)args.in[i])
#define WSP(T_, off) ((T_*)(ws + (off)))
    const CvWork cvw{INP(31), INP(28), WSP(unsigned char, WS_WUP), (volatile LAS int*)(MISC + 16), MISC + 12, ctl + CW_CVQ, wave};
    if (IN(0)) {
        const int lane = LANE_NOW(), tid = wave * 64 + lane; (void)tid; (void)lane;
        const int gw = bx * NWAVES + wave, NGW = NG * NWAVES;
        constexpr int I_IN = (D / 64) * (INC / 64), I_QB = (QL / 64) * (1536 / 64), I_KVB = (KVL / 64) * (2048 / 64), I_GLU = (SSMW / 64) * (SSMW / 64), I_SQ = (D / 64) * (D / 64);
        constexpr int I_UP = (D / 64) * (2 * FF / 64), I_DN = (FF / 64) * (D / 64);
#define TI_MAT(W_, K_, N_, WT_, G_) { const int nb_ = (N_) / 64, kb = r / nb_, nbi = r % nb_; d.src = (W_) + (size_t)(64 * kb) * (N_) + 64 * nbi; d.dst = (WT_) + (size_t)(64 * nbi) * (K_) + 64 * kb; \
            d.gain = (G_) + 64 * kb; d.N = (N_); d.ldk = (K_); }
#define TI_MAT8(W_, K_, N_, WT_, G_) { const int nb_ = (N_) / 32, kb = r / nb_, nbi = r % nb_; d.src = (W_) + (size_t)(128 * kb) * (N_) + 32 * nbi; d.dst = (bf16*)((unsigned char*)(WT_) + (size_t)(32 * nbi) * (K_) + 128 * kb); \
            d.gain = (G_) + 128 * kb; d.N = (N_); d.ldk = (K_); }
        auto dec_up = [&](int it) { TItem d; int r = it; const int e = r / I_UP; r -= e * I_UP; TI_MAT8(INP(31) + (size_t)e * D * 2 * FF, D, 2 * FF, WSP(unsigned char, WS_WUP) + (size_t)e * 2 * FF * D, INP(28)); return d; };
        auto dec_dn = [&](int it) { TItem d; int r = it; const int e = r / I_DN; r -= e * I_DN; TI_MAT8(INP(33) + (size_t)e * FF * D, FF, D, WSP(unsigned char, WS_WDN) + (size_t)e * D * FF, INP(28)); return d; };
        auto dec_xq = [&](int it) { TItem d; int r = it; TI_MAT8(INP(24), D, D, WSP(unsigned char, WS_WXQ8), INP(22)); return d; };
        auto dec_xo = [&](int it) { TItem d; int r = it; TI_MAT8(INP(27), D, D, WSP(unsigned char, WS_WXO8), INP(22)); return d; };
        auto dec_16 = [&](int it) { TItem d; int r = it;
            if (r < I_IN) { TI_MAT(INP(4), D, INC, WSP(bf16, WS_WIN), INP(22)); return d; } r -= I_IN;
            if (r < I_QB) { TI_MAT(INP(6), QL, 1536, WSP(bf16, WS_WQB), INP(22)); return d; } r -= I_QB;
            if (r < I_KVB) { TI_MAT(INP(8), KVL, 2048, WSP(bf16, WS_WKVB), INP(22)); return d; } r -= I_KVB;
            if (r < I_GLU) { TI_MAT(INP(17), SSMW, SSMW, WSP(bf16, WS_WGLU), INP(22)); return d; } r -= I_GLU;
            if (r < I_SQ) { TI_MAT(INP(25), D, D, WSP(bf16, WS_WXK), INP(22)); return d; } r -= I_SQ;
            if (r < I_SQ) { TI_MAT(INP(26), D, D, WSP(bf16, WS_WXV), INP(22)); return d; } r -= I_SQ;
            TI_MAT(INP(21), D, D, WSP(bf16, WS_WOUT), INP(22)); return d; };
#undef TI_MAT
#undef TI_MAT8
        if (bx < G) { s5_setup(bx, lds, INP(9), INP(10), INP(11), INP(12), INP(13), INP(14), INP(15), WSP(bf16, WS_BTY), WSP(bf16, WS_BTS), WSP(float, WS_AP32), tid); }
        else {
            const int gw = (bx - G) * NWAVES + wave, NGW = (NG - G) * NWAVES, gt = (bx - G) * NTHR + tid, NGT = (NG - G) * NTHR;
            for (int i = gt; i < D * D / 4; i += NGT) { const int row = (i * 4) / D; const f32x4 w = ((const GAS f32x4*)INP(24))[i]; const float g = INP(22)[row]; v2u o; o.x = pk2(w.x * g, w.y * g); o.y = pk2(w.z * g, w.w * g);
                ((GAS v2u*)WSP(bf16, WS_WXQN))[i] = o; }
            TSTREAM(I_SQ, dec_xo, titem8_load<false>, titem8_store<false>);
            TSTREAM(I_IN + I_QB + I_KVB + I_GLU + 3 * I_SQ, dec_16, titem_load<false>, titem_store<false>);
            for (int i = gt; i < E * D; i += NGT) { const int e = i / D, k = i % D; const float w = INP(29)[(size_t)k * E + e] * INP(28)[k]; const unsigned h = f2bf(w);
                WSP(bf16, WS_WRH)[i] = (bf16)h; WSP(bf16, WS_WRL)[i] = (bf16)f2bf(w - __builtin_bit_cast(float, h << 16)); }
            for (int i = gt; i < (INCP - INC) * D / 8; i += NGT) ((GAS v4u*)(WSP(bf16, WS_WIN) + (size_t)INC * D))[i] = (v4u){0u, 0u, 0u, 0u};
            for (int m = gw; m < T; m += NGW) rms_row_to_bf16(INP(0) + (size_t)m * D, INP(3), WSP(bf16, WS_HB) + (size_t)m * D, lane);
            for (int m = gw; m < TM; m += NGW) rms_row_to_bf16(INP(1) + (size_t)m * D, INP(23), WSP(bf16, WS_MEMN) + (size_t)m * D, lane);
        }
        if (BOTH(0)) GRID_BAR_CV();
    }
    if (IN(1)) {
        const int lane = LANE_NOW(), tid = wave * 64 + lane; (void)tid; (void)lane;
        { pg8::Geo geo{D * 2, D * 2, 128L * D * 2, 128L * D * 2, D / 64};
          pg8::Sched S; S.init(0, T / 256, INCP / 256, 1, NG, bx, WSP(bf16, WS_HB), 256L * D * 2, 0, WSP(bf16, WS_WIN), 256L * D * 2, 0);
          EpiProj Ep{WSP(bf16, WS_PROJB), WSP(bf16, WS_AG)};
          pg8::gemm_phase<EpiProj, pg8::Sched, true, true>(lds + RING_OFF, geo, S, Ep, wave); }
        { pg8::Geo geo{D * 2, D * 2, 128L * D * 2, 128L * D * 2, D / 64};
          const int c = (bx >= 224) ? bx - 224 : (1 << 30);
          pg8::Sched S; S.init(1, TM / 256, D / 256, 1, 32, c, WSP(bf16, WS_MEMN), 256L * D * 2, 0, WSP(bf16, WS_WXK), 256L * D * 2, 0);
          EpiPlain<false> Ep{WSP(bf16, WS_XK), D, 1, 0, 0, nullptr};
          pg8::gemm_phase<EpiPlain<false>, pg8::Sched, true, true>(lds + RING_OFF, geo, S, Ep, wave); }
        if (BOTH(1)) GRID_BAR_CV();
    }
    if (IN(2)) {
        const int lane = LANE_NOW(), tid = wave * 64 + lane; (void)tid; (void)lane;
        { const int gw = bx * NWAVES + wave, NGW = NG * NWAVES;
          for (int t = gw; t < T; t += NGW) mla_thin_token(t, lane, WSP(bf16, WS_PROJB), INP(5), INP(7), ((const int*)args.in[2]), WSP(bf16, WS_CQN), WSP(bf16, WS_CKVN), WSP(bf16, WS_KPE), WSP(float, WS_ROPE)); }
        __syncthreads();
        { pg8::Geo geo{AGW * 2, 512 * 2, 128L * AGW * 2, 0, 512 / 64};
          pg8::Sched S; S.init(1, 1, 1, G, NG, bx, WSP(bf16, WS_AG), 0, 256L * AGW * 2, WSP(bf16, WS_BTS), 0, 128L * 512 * 2);
          EpiS5State Ep{WSP(float, WS_SC)};
          pg8::gemm_phase<EpiS5State, pg8::Sched, true, true>(lds + RING_OFF, geo, S, Ep, wave); }
        { pg8::Geo geo{D * 2, D * 2, 128L * D * 2, 128L * D * 2, D / 64};
          const int c = (bx >= 64 && bx < 96) ? bx - 64 : (1 << 30);
          pg8::Sched S; S.init(1, D / 256, TM / 256, 1, 32, c, WSP(bf16, WS_WXV), 256L * D * 2, 0, WSP(bf16, WS_MEMN), 256L * D * 2, 0);
          EpiPlain<false> Ep{WSP(bf16, WS_XVT), TM, 1, 0, 0, nullptr};
          pg8::gemm_phase<EpiPlain<false>, pg8::Sched, true, true>(lds + RING_OFF, geo, S, Ep, wave); }
        if (BOTH(2)) GRID_BAR_CV();
    }
    if (IN(3)) {
        const int lane = LANE_NOW(), tid = wave * 64 + lane; (void)tid; (void)lane;
        if (bx < 128) {
            s5_scan_group(bx >> 1, lds, WSP(float, WS_SC), WSP(float, WS_AP32), WSP(bf16, WS_AG), tid);
            pg8::Geo geo{AGW * 2, AGW * 2, 128L * AGW * 2, 128L * AGW * 2, AGW / 64};
            pg8::Sched S; S.init(1, 1, 2, G, 128, bx, WSP(bf16, WS_AG), 0, 256L * AGW * 2, WSP(bf16, WS_BTY), 256L * AGW * 2, 512L * AGW * 2);
            EpiS5Y Ep{WSP(bf16, WS_AG), INP(16), WSP(bf16, WS_Y)};
            pg8::gemm_phase<EpiS5Y, pg8::Sched, true, true>(lds + RING_OFF, geo, S, Ep, wave);
        }
        { pg8::Geo geo{KVL * 2, KVL * 2, 128L * KVL * 2, 128L * KVL * 2, KVL / 64};
          pg8::Sched S; S.init(0, T / 256, 2048 / 256, 1, NG, bx, WSP(bf16, WS_CKVN), 256L * KVL * 2, 0, WSP(bf16, WS_WKVB), 256L * KVL * 2, 0);
          EpiPlain<false> Ep{WSP(bf16, WS_KV), 2048, 1, 0, 0, nullptr};
          pg8::gemm_phase<EpiPlain<false>, pg8::Sched, true, true>(lds + RING_OFF, geo, S, Ep, wave); }
        { pg8::Geo geo{QL * 2, QL * 2, 128L * QL * 2, 128L * QL * 2, QL / 64};
          const int c = (bx >= 128) ? bx - 128 : (1 << 30);
          pg8::Sched S; S.init(0, T / 256, 1536 / 256, 1, 128, c, WSP(bf16, WS_CQN), 256L * QL * 2, 0, WSP(bf16, WS_WQB), 256L * QL * 2, 0);
          EpiPlain<false> Ep{WSP(bf16, WS_Q), 1536, 1, 0, 0, nullptr};
          pg8::gemm_phase<EpiPlain<false>, pg8::Sched, true, true>(lds + RING_OFF, geo, S, Ep, wave); }
        { pg8::Geo geo{D * 2, D * 2, 128L * D * 2, 128L * D * 2, XD / 64};
          const int c = (bx >= 128) ? bx - 128 : (1 << 30);
          pg8::Sched S; S.init(1, 1, D / 256, BATCH * XH, 128, c, WSP(bf16, WS_XK), 0, (long)MEM * D * 2, WSP(bf16, WS_WXQN), 256L * D * 2, 0);
          S.split_z(XH, XD * 2, XD * 2);
          EpiPlain<false, false, true> Ep{(bf16*)WSP(unsigned char, WS_WKT8), D, 1, 256L * D, 0, nullptr};
          pg8::gemm_phase<EpiPlain<false, false, true>, pg8::Sched, true, true>(lds + RING_OFF, geo, S, Ep, wave); }
        if (BOTH(3)) GRID_BAR_CV();
    }
    if (IN(4)) {
        const int lane = LANE_NOW(), tid = wave * 64 + lane; (void)tid; (void)lane;
        const int vcu = (NG % 8 == 0) ? (bx % 8) * (NG / 8) + bx / 8 : bx;
        if (vcu < BATCH * H * 8) { const int L = vcu, bh = L >> 3, qb = L & 7;
            mla::attn_unit(lds + RING_OFF, bh >> 3, bh & 7, qb, WSP(bf16, WS_Q), WSP(bf16, WS_KV), WSP(bf16, WS_KPE), WSP(float, WS_ROPE), WSP(bf16, WS_ATTO), wave); }
        { const int qb = vcu & 7, c = (vcu < 256 && qb >= 4) ? (vcu >> 3) * 4 + (qb - 4) : (1 << 30);
          pg8::Geo geo{SSMW * 2, SSMW * 2, 128L * SSMW * 2, 128L * SSMW * 2, SSMW / 64};
          pg8::Sched S; S.init(1, T / 256, SSMW / 256, 1, 128, c, WSP(bf16, WS_Y), 256L * SSMW * 2, 0, WSP(bf16, WS_WGLU), 256L * SSMW * 2, 0);
          EpiGlu Ep{WSP(bf16, WS_Y), INP(18), WSP(bf16, WS_SSMO)};
          pg8::gemm_phase<EpiGlu, pg8::Sched, true, true>(lds + RING_OFF, geo, S, Ep, wave); }
        if (BOTH(4)) GRID_BAR_CV();
    }
    if (IN(5)) {
        const int lane = LANE_NOW(), tid = wave * 64 + lane; (void)tid; (void)lane;
        const int gw = bx * NWAVES + wave, NGW = NG * NWAVES;
        for (int t = gw; t < T; t += NGW) {
#pragma unroll
            for (int half = 0; half < 2; ++half) { const bf16* src = (half ? WSP(bf16, WS_SSMO) : WSP(bf16, WS_ATTO)) + (size_t)t * 1024; const float* gn = half ? INP(20) : INP(19);
                const v4u a = ((const v4u*)src)[lane], b = ((const v4u*)src)[64 + lane];
                f32x4 gpre[4];
#pragma unroll
                for (int jj = 0; jj < 2; ++jj) { const int k0 = (jj * 64 + lane) * 8; gpre[2 * jj] = *(const f32x4*)(gn + k0); gpre[2 * jj + 1] = *(const f32x4*)(gn + k0 + 4); }
                float v[16] = {bflo(a.x), bfhi(a.x), bflo(a.y), bfhi(a.y), bflo(a.z), bfhi(a.z), bflo(a.w), bfhi(a.w), bflo(b.x), bfhi(b.x), bflo(b.y), bfhi(b.y), bflo(b.z), bfhi(b.z), bflo(b.w), bfhi(b.w)};
                float s = 0.f;
#pragma unroll
                for (int e = 0; e < 16; ++e) s += v[e] * v[e];
                const float r = rsqrtf(wave_sum(s) * (1.f / 1024) + EPS);
#pragma unroll
                for (int jj = 0; jj < 2; ++jj) { const int k0 = (jj * 64 + lane) * 8; const f32x4 g0 = gpre[2 * jj], g1 = gpre[2 * jj + 1]; v4u w;
                    w.x = pk2(v[8 * jj + 0] * r * g0[0], v[8 * jj + 1] * r * g0[1]); w.y = pk2(v[8 * jj + 2] * r * g0[2], v[8 * jj + 3] * r * g0[3]);
                    w.z = pk2(v[8 * jj + 4] * r * g1[0], v[8 * jj + 5] * r * g1[1]); w.w = pk2(v[8 * jj + 6] * r * g1[2], v[8 * jj + 7] * r * g1[3]);
                    *(v4u*)(WSP(bf16, WS_MIXED) + (size_t)t * D + half * 1024 + k0) = w; } } }
        if (BOTH(5)) GRID_BAR_CV();
#if defined(PROBE_BAR)
        if (BOTH(5)) { for (int i_ = 0; i_ < 10; ++i_) GRID_BAR(); }
#endif
    }
    if (IN(6)) {
        const int lane = LANE_NOW(), tid = wave * 64 + lane; (void)tid; (void)lane;
        pg8::Geo geo{D * 2, D * 2, 128L * D * 2, 128L * D * 2, D / 64};
        pg8::Sched S; S.init(0, T / 256, D / 256, 1, NG, bx, WSP(bf16, WS_MIXED), 256L * D * 2, 0, WSP(bf16, WS_WOUT), 256L * D * 2, 0);
        EpiResid<> Ep{INP(0), WSP(float, WS_X1), nullptr, WSP(float, WS_SSQP1), WSP(unsigned char, WS_X1F8)};
        pg8::gemm_phase<EpiResid<>, pg8::Sched, true, true>(lds + RING_OFF, geo, S, Ep, wave);
        if (BOTH(6)) GRID_BAR_CV();
    }
    if (IN(7)) {
        const int lane = LANE_NOW(), tid = wave * 64 + lane; (void)tid; (void)lane;
        pg8::Geo geo{D, D, 128L * D, 128L * D, D / 128};
        pg8::Sched S; S.init(1, SEQ / 256, XH, BATCH, NG, bx, WSP(unsigned char, WS_X1F8), 256L * D, (long)SEQ * D, WSP(unsigned char, WS_WKT8), 256L * D, (long)XH * MEM * D);
        LAS float* rt = (LAS float*)(lds + TOK_OFF);
        { pg8::Unit u0; if (S.next(0, u0) && tid < 256) { const float* pp = WSP(float, WS_SSQP1) + (size_t)((u0.z * (SEQ / 256) + u0.pm) * 256 + tid) * 32; float sq = 0.f;
#pragma unroll
                for (int k = 0; k < 8; ++k) { const f32x4 v = *(const f32x4*)(pp + 4 * k); sq += v[0]; sq += v[1]; sq += v[2]; sq += v[3]; }
                rt[tid] = rsqrtf(sq * (1.f / D) + EPS); }
            __syncthreads(); }
        EpiSoftmax<true> Ep{WSP(bf16, WS_PX), rt};
        pg8::gemm_phase<EpiSoftmax<true>, pg8::Sched, false, true>(lds + RING_OFF, geo, S, Ep, wave);
        if (BOTH(7)) GRID_BAR_CV();
    }
    if (IN(9)) {
        const int lane = LANE_NOW(), tid = wave * 64 + lane; (void)tid; (void)lane;
        pg8::Geo geo{MEM * 2, TM * 2, 128L * MEM * 2, 128L * TM * 2, MEM / 64};
        pg8::Sched S; S.init(1, SEQ / 256, XD / 256, BATCH * XH, NG, bx, WSP(bf16, WS_PX), 256L * MEM * 2, (long)XH * SEQ * MEM * 2, WSP(bf16, WS_XVT), 256L * TM * 2, (long)MEM * 2);
        S.split_z(XH, (long)SEQ * MEM * 2, (long)XD * TM * 2);
        EpiPlain<false, false, true> Ep{(bf16*)WSP(unsigned char, WS_XO8), D, XH, (long)SEQ * D, XD, nullptr};
        pg8::gemm_phase<EpiPlain<false, false, true>, pg8::Sched, true, true>(lds + RING_OFF, geo, S, Ep, wave);
        if (BOTH(9)) GRID_BAR_CV();
    }
    if (IN(10)) {
        const int lane = LANE_NOW(), tid = wave * 64 + lane; (void)tid; (void)lane;
        pg8::Geo geo{D, D, 128L * D, 128L * D, D / 128};
        pg8::Sched S; S.init(0, T / 256, D / 256, 1, NG, bx, WSP(unsigned char, WS_XO8), 256L * D, 0, WSP(unsigned char, WS_WXO8), 256L * D, 0);
        EpiResid<true> Ep{WSP(float, WS_X1), WSP(float, WS_X2), nullptr, WSP(float, WS_SSQP2), WSP(unsigned char, WS_X2F8)};
        pg8::gemm_phase<EpiResid<true>, pg8::Sched, true, true>(lds + RING_OFF, geo, S, Ep, wave);
        if (BOTH(10)) GRID_BAR_CV();
    }
    if (IN(11)) {
        const int lane = LANE_NOW(), tid = wave * 64 + lane; (void)tid; (void)lane;
        for (int tile = bx; tile < T / 32; tile += NG)
            route_tile(tile, lds, WSP(float, WS_X2), WSP(float, WS_SSQP2), WSP(float, WS_RSTD2), WSP(bf16, WS_WRH), WSP(bf16, WS_WRL), INP(30), PRB(ctl + CW_CNT, unsigned*), PRB(WSP(int, WS_SELE), int*), PRB(WSP(int, WS_SELP), int*), PRB(WSP(float, WS_SELG), float*), PRB(WSP(int, WS_LIST), int*) + (args.li == 1 ? (1 << 20) : 0), tid);
        cv_flush(cvw);
        if (BOTH(11)) GRID_BAR();
    }
    if (IN(12)) {
        const int lane = LANE_NOW(), tid = wave * 64 + lane; (void)tid; (void)lane;
        LAS int* blkE = (LAS int*)(lds + BLK_OFF); LAS int* tokTab = (LAS int*)(lds + TOK_OFF);
        const unsigned* counts = ctl + CW_CNT;
        const int NBt = moe_block_table(counts, blkE, tid);
        { int tokv[MAXU / 2];
#pragma unroll
          for (int k = 0; k < MAXU / 2; ++k) { const int i = 2 * k + (tid >> 8), L = i * NG + bx, r = tid & 255; int v = 0;
              if (L < NBt * 16) { const int blk = L >> 4, e = blkE[blk], j = blkE[160 + blk]; if (r < blkE[320 + blk]) v = WSP(int, WS_LIST)[(size_t)e * T + j * 256 + r]; }
              tokv[k] = v; }
#pragma unroll
          for (int k = 0; k < MAXU / 2; ++k) tokTab[(2 * k + (tid >> 8)) * 256 + (tid & 255)] = tokv[k]; }
        __syncthreads();
        pg8::Geo geo{D, D, 0, (long)FF * D, D / 128};
        MoeSchedUpCv S{{NBt, 16, NG, bx, D, (const char*)WSP(unsigned char, WS_X2F8), (const char*)WSP(unsigned char, WS_WUP), 0, (long)2 * FF * D, 128L * D, blkE, tokTab}, INP(33), WSP(unsigned char, WS_WDN), wave};
        EpiMoeUp Ep{blkE, tokTab, WSP(float, WS_RSTD2), INP(32), WSP(unsigned char, WS_ACT)};
        pg8::gemm_phase<EpiMoeUp, MoeSchedUpCv, true, true>(lds + RING_OFF, geo, S, Ep, wave);
        if (BOTH(12)) GRID_BAR();
    }
    if (IN(13)) {
        const int lane = LANE_NOW(), tid = wave * 64 + lane; (void)tid; (void)lane;
        LAS int* blkE = (LAS int*)(lds + BLK_OFF);
        __syncthreads();
        const int NBt = moe_block_table(ctl + CW_CNT, blkE, tid);
        pg8::Geo geo{FF, FF, 128L * FF, 128L * FF, FF / 128};
        MoeSched<false> S{NBt, 8, NG, bx, FF, (const char*)WSP(unsigned char, WS_ACT), (const char*)WSP(unsigned char, WS_WDN), 256L * FF, (long)D * FF, 256L * FF, blkE, nullptr};
        EpiMoeDown Ep{blkE, INP(34), WSP(unsigned char, WS_YK)};
        pg8::gemm_phase<EpiMoeDown, MoeSched<false>, true, true>(lds + RING_OFF, geo, S, Ep, wave);
        if (BOTH(13)) GRID_BAR();
    }
    if (IN(14)) {
        const int lane = LANE_NOW(), tid = wave * 64 + lane; (void)tid; (void)lane;
        const int gw = bx * NWAVES + wave, NGW = NG * NWAVES;
        const unsigned* counts = ctl + CW_CNT;
        int pb = 0;
        { const int nb = (lane < E) ? (((int)counts[(lane & 31) * CNT_STRIDE] + 255) >> 8) : 0; int inc = nb;
#pragma unroll
          for (int o = 1; o < 32; o <<= 1) { const int v = __shfl_up(inc, o); if ((lane & 31) >= o) inc += v; }
          pb = inc - nb; }
        const float* X2 = WSP(float, WS_X2); const unsigned char* YK = WSP(unsigned char, WS_YK); const float* fn = INP(35); float* out = args.out;
        f32x4 fg[8];
#pragma unroll
        for (int j = 0; j < 8; ++j) fg[j] = *(const f32x4*)(fn + (j * 64 + lane) * 4);
        for (int t = gw; t < T; t += NGW) {
            size_t so[TOPK]; float gk[TOPK];
#pragma unroll
            for (int k = 0; k < TOPK; ++k) { const int e = WSP(int, WS_SELE)[t * TOPK + k], p = WSP(int, WS_SELP)[t * TOPK + k]; gk[k] = WSP(float, WS_SELG)[t * TOPK + k] * Y8_INV;
                so[k] = ((size_t)__shfl(pb, e) * 256 + p) * D; }
            f32x4 v[8]; float s = 0.f;
#pragma unroll
            for (int j = 0; j < 8; ++j) { const int cidx = (j * 64 + lane) * 4; f32x4 a = *(const f32x4*)(X2 + (size_t)t * D + cidx);
#pragma unroll
                for (int k = 0; k < TOPK; ++k) { const unsigned y = *(const unsigned*)(YK + so[k] + cidx); const v2f lo = __builtin_amdgcn_cvt_pk_f32_fp8(y, false), hi = __builtin_amdgcn_cvt_pk_f32_fp8(y, true);
                    a[0] += gk[k] * lo[0]; a[1] += gk[k] * lo[1]; a[2] += gk[k] * hi[0]; a[3] += gk[k] * hi[1]; }
                v[j] = a; s += (a[0] * a[0] + a[1] * a[1]) + (a[2] * a[2] + a[3] * a[3]); }
            const float r = rsqrtf(wave_sum(s) * (1.f / D) + EPS);
#pragma unroll
            for (int j = 0; j < 8; ++j) { const int cidx = (j * 64 + lane) * 4; *(f32x4*)(out + (size_t)t * D + cidx) = v[j] * r * fg[j]; }
        }
    }
#if defined(PROBE_READ)
    if (IN(15)) {
        const int lane = LANE_NOW(), tid = wave * 64 + lane; (void)tid; (void)lane;
        const int gw = bx * NWAVES + wave, NGW = NG * NWAVES;
        constexpr int I_UP = (D / 64) * (2 * FF / 64), I_DN = (FF / 64) * (D / 64);
        f32x4 sum = {0.f, 0.f, 0.f, 0.f};
#define TI_MAT8(W_, K_, N_, WT_, G_) { const int nb_ = (N_) / 64, kb = r / nb_, nbi = r % nb_; d.src = (W_) + (size_t)(64 * kb) * (N_) + 64 * nbi; d.dst = (bf16*)((unsigned char*)(WT_) + (size_t)(64 * nbi) * (K_) + 64 * kb); \
            d.gain = (G_) + 64 * kb; d.N = (N_); d.ldk = (K_); }
        auto dec_up = [&](int it) { TItem d; int r = it; const int e = r / I_UP; r -= e * I_UP; TI_MAT8(INP(31) + (size_t)e * D * 2 * FF, D, 2 * FF, WSP(unsigned char, WS_WUP) + (size_t)e * 2 * FF * D, INP(28)); return d; };
        auto dec_dn = [&](int it) { TItem d; int r = it; const int e = r / I_DN; r -= e * I_DN; TI_MAT8(INP(33) + (size_t)e * FF * D, FF, D, WSP(unsigned char, WS_WDN) + (size_t)e * D * FF, INP(28)); return d; };
#undef TI_MAT8
#define PR_STORE(d_, lane_, r_, g_) do { _Pragma("unroll") for (int j_ = 0; j_ < 16; ++j_) sum += r_[j_]; } while (0)
        TSTREAM(E * I_UP, dec_up, titem8_load<false>, PR_STORE);
        TSTREAM(E * I_DN, dec_dn, titem8_load<false>, PR_STORE);
#undef PR_STORE
        *(f32x4*)(ws + WS_END1 + (16u << 20) + ((size_t)gw * 64 + lane) * 16) = sum;
    }
#endif
#undef IN
#undef BOTH
#undef GRID_BAR
}

extern "C" void kernel_launch(void* const* d_in, const int* in_sizes, int n_in, void* d_out, int out_size, void* d_ws, size_t ws_size, hipStream_t stream) {
    static int grid = 0;
    if (grid == 0) {
        if (n_in != 36 || out_size != T * D || ws_size < WS_END1) { fprintf(stderr, "kernel_launch: built for 36 inputs, %d outputs, >= %zu bytes of workspace; got %d, %d, %zu; nothing launched\n", T * D, (size_t)WS_END1, n_in, out_size, ws_size); grid = -1; return; }
        int dev = 0, cus = 0, per_cu = 0;
        if (hipGetDevice(&dev) != hipSuccess || hipDeviceGetAttribute(&cus, hipDeviceAttributeMultiprocessorCount, dev) != hipSuccess) { fprintf(stderr, "kernel_launch: device query failed\n"); grid = -1; return; }
        if (hipFuncSetAttribute((const void*)fwd, hipFuncAttributeMaxDynamicSharedMemorySize, LDS_BYTES) != hipSuccess) { fprintf(stderr, "kernel_launch: hipFuncSetAttribute failed\n"); grid = -1; return; }
        if (hipOccupancyMaxActiveBlocksPerMultiprocessor(&per_cu, (const void*)fwd, NTHR, LDS_BYTES) != hipSuccess || per_cu < 1) fprintf(stderr, "kernel_launch: occupancy query reports %d\n", per_cu);
        (void)hipGetLastError();
        grid = 256;
        if (cus < 256) { fprintf(stderr, "kernel_launch: %d CUs < 256: the grid would not be resident; nothing launched\n", cus); grid = -1; return; }
    }
    if (grid < 0) return;
    (void)hipMemsetAsync((char*)d_ws + WS_CTL, 0, CTL_ZERO_BYTES, stream);
    Args a{};
    for (int i = 0; i < 36; ++i) a.in[i] = d_in[i];
    a.out = (float*)d_out; a.ws = (unsigned char*)d_ws;
#if defined(PROBE_RANGE)
    a.ph_lo = 0; a.ph_hi = PROBE_RANGE_HI; a.li = 0; hipLaunchKernelGGL(fwd, dim3(grid), dim3(NTHR), LDS_BYTES, stream, a);
    a.ph_lo = PROBE_RANGE_LO; a.ph_hi = PROBE_RANGE_HI; a.li = 1; hipLaunchKernelGGL(fwd, dim3(grid), dim3(NTHR), LDS_BYTES, stream, a);
    a.ph_lo = PROBE_RANGE_HI; a.ph_hi = N_PHASES; a.li = 2; hipLaunchKernelGGL(fwd, dim3(grid), dim3(NTHR), LDS_BYTES, stream, a);
#elif defined(PROBE_READ)
    a.ph_lo = 0; a.ph_hi = N_PHASES; a.li = 0; hipLaunchKernelGGL(fwd, dim3(grid), dim3(NTHR), LDS_BYTES, stream, a);
    a.ph_lo = 15; a.ph_hi = 16; a.li = 1; hipLaunchKernelGGL(fwd, dim3(grid), dim3(NTHR), LDS_BYTES, stream, a);
#elif defined(PROBE_PHASE)
    a.ph_lo = 0; a.ph_hi = PROBE_PHASE + 1; a.li = 0; hipLaunchKernelGGL(fwd, dim3(grid), dim3(NTHR), LDS_BYTES, stream, a);
    a.ph_lo = PROBE_PHASE; a.ph_hi = PROBE_PHASE + 1; a.li = 1; hipLaunchKernelGGL(fwd, dim3(grid), dim3(NTHR), LDS_BYTES, stream, a);
    if (PROBE_PHASE + 1 < N_PHASES) { a.ph_lo = PROBE_PHASE + 1; a.ph_hi = N_PHASES; a.li = 2; hipLaunchKernelGGL(fwd, dim3(grid), dim3(NTHR), LDS_BYTES, stream, a); }
#else
    a.ph_lo = 0; a.ph_hi = N_PHASES;
    hipLaunchKernelGGL(fwd, dim3(grid), dim3(NTHR), LDS_BYTES, stream, a);
#endif
}
```

```cpp
#include <hip/hip_runtime.h>
#include <cstdio>
#include <cstdint>

constexpr int D = 2048, BATCH = 4, SEQ = 2048, T = BATCH * SEQ;
constexpr int MEM = 256, TM = BATCH * MEM;
constexpr int H = 8, DN = 128, DR = 64, DV = 128, QL = 384, KVL = 256;
constexpr int SSMW = 1024, G = 64, P = 64, C = 16;
constexpr int XH = 4, XD = 512;
constexpr int E = 32, TOPK = 4, FF = 2048;
constexpr int INC = 1728, INCP = 1792;
constexpr int PJW = 704;
constexpr int LCH = 32, NCH = SEQ / LCH;
constexpr int AGW = 640;
constexpr float EPS = 1e-6f;

__device__ __forceinline__ int lane_id_now() { unsigned z = 0u; asm volatile("" : "+v"(z)); return (int)__builtin_amdgcn_mbcnt_hi(~0u, __builtin_amdgcn_mbcnt_lo(~0u, z)); }
namespace pg8 {
#define PG8_LAS __attribute__((address_space(3)))
typedef unsigned short bf16_t;
typedef short bf16x8 __attribute__((ext_vector_type(8)));
typedef float f32x4 __attribute__((ext_vector_type(4)));
typedef float f32x2 __attribute__((ext_vector_type(2)));
typedef unsigned u32x4 __attribute__((ext_vector_type(4)));
typedef unsigned u32x2 __attribute__((ext_vector_type(2)));
constexpr int BM = 256, BK = 64, HALF = 128, HTB = HALF * BK * 2  , STAGE_BYTES = 8 * HTB, NXCD = 8, WGM = 8;

__host__ __device__ __forceinline__ int lds_byte(int r, int c) { const int st = (r >> 4) * 2 + (c >> 5), rr = r & 15, cc = c & 31, ob = rr * 64 + cc * 2; return st * 1024 + (ob ^ (((ob >> 9) & 1) << 5)); }
__host__ __device__ __forceinline__ void stage_rc(int b, int& R, int& C) { const int st = b / 1024, sb = b % 1024, swz = sb ^ (((sb >> 9) & 1) << 5); R = (st >> 1) * 16 + swz / 64; C = (st & 1) * 32 + (swz % 64) / 2; }
__host__ __device__ __forceinline__ int perm32(int rho) { const int n = rho >> 4, i = rho & 15; return 8 * (i >> 2) + 4 * n + (i & 3); }

struct Unit { int pm, pn, z; };
struct Geo { int lda, ldb; long hstepA, hstepB; int nt; };

struct Sched {
    int nM, nN, nZ, total, G, c, mode, zdiv;
    const char* A; const char* B; long tA, tB, zA, zB, zA2, zB2;
    __device__ __forceinline__ void init(int mode_, int nM_, int nN_, int nZ_, int G_, int c_, const void* A_, long tA_, long zA_, const void* B_, long tB_, long zB_) {
        mode = mode_; nM = nM_; nN = nN_; nZ = nZ_; total = nM_ * nN_ * nZ_; G = G_; c = c_; A = (const char*)A_; B = (const char*)B_; tA = tA_; tB = tB_; zA = zA_; zB = zB_; zdiv = 1 << 30; zA2 = 0; zB2 = 0; }
    __device__ __forceinline__ void split_z(int zdiv_, long zA2_, long zB2_) { zdiv = zdiv_; zA2 = zA2_; zB2 = zB2_; }
    __device__ __forceinline__ bool next(int i, Unit& u) const {
        const long L = (long)i * G + c; if (L >= total) return false;
        if (mode == 0) {
            int wgid = (int)L; { const int q = total / NXCD, r = total % NXCD, xcd = wgid % NXCD, off = wgid / NXCD; wgid = (xcd < r ? xcd * (q + 1) : r * (q + 1) + (xcd - r) * q) + off; }
            const int nig = WGM * nN, gid = wgid / nig, fm = gid * WGM, gsz = (nM - fm) < WGM ? (nM - fm) : WGM;
            u.pm = fm + ((wgid % nig) % gsz); u.pn = (wgid % nig) / gsz; u.z = 0;
        } else { const int l = (int)L; u.pn = l % nN; u.pm = (l / nN) % nM; u.z = l / (nN * nM); }
        return true;
    }
    __device__ __forceinline__ void ptrs(const Unit& u, const char*& a, const char*& b) const { const int z1 = (zdiv == (1 << 30)) ? u.z : u.z / zdiv, z2 = (zdiv == (1 << 30)) ? 0 : u.z % zdiv;
        a = A + (long)z1 * zA + (long)z2 * zA2 + (long)u.pm * tA; b = B + (long)z1 * zB + (long)z2 * zB2 + (long)u.pn * tB; }
    static constexpr bool GATHER = false;
    __device__ __forceinline__ bool half1(const Unit&) const { return true; }
    __device__ __forceinline__ unsigned row_off(int, int) const { return 0u; }
    __device__ __forceinline__ void a_ready(const Unit&) const {}
    __device__ __forceinline__ void done(const Unit&) const {}
};
template <class E, class = void> struct epi_fp8 { static constexpr bool v = false; };
template <class E> struct epi_fp8<E, decltype((void)E::FP8)> { static constexpr bool v = E::FP8; };
typedef int i32x4 __attribute__((ext_vector_type(4)));
typedef int i32x8 __attribute__((ext_vector_type(8)));
__device__ __forceinline__ unsigned cvt_pk_bf16(float lo, float hi) { unsigned r; asm volatile("v_cvt_pk_bf16_f32 %0, %1, %2" : "=v"(r) : "v"(lo), "v"(hi)); return r; }

template <class Epi, class Sched, bool ALIGN_EPI = false, bool SP2 = false>
__device__ __forceinline__ void gemm_phase(PG8_LAS unsigned char* lds, const Geo geo, const Sched& S, const Epi& E, const int wave_) {
    int tid_ = wave_ * 64 + lane_id_now(); asm volatile("" : "+v"(tid_));
    const int tid = tid_, wid = __builtin_amdgcn_readfirstlane(tid >> 6), lane = tid & 63, wr = wid >> 2, wc = wid & 3, fr = lane & 15, fq = lane >> 4;
    const int nt = geo.nt;
    unsigned voffA[2], voffB[2];
#pragma unroll
    for (int i = 0; i < 2; ++i) { int R, C; stage_rc(tid * 16 + i * 8192, R, C); const int Rb = Epi::PERM ? ((R & ~31) + perm32(R & 31)) : R;
        voffA[i] = (unsigned)(R * geo.lda + C * 2); voffB[i] = (unsigned)(Rb * geo.ldb + C * 2); }
    unsigned c0[2], c1[2], n0[2], n1[2];
#pragma unroll
    for (int i = 0; i < 2; ++i) { c0[i] = voffA[i]; c1[i] = voffA[i]; n0[i] = voffA[i]; n1[i] = voffA[i]; }
    const size_t kstep = (size_t)(BK * 2);
    const size_t hstepA = (size_t)geo.hstepA, hstepB = (size_t)geo.hstepB;
    const unsigned ldsw = (unsigned)wid * 1024u;
    const int aoff = lds_byte(wr * 64 + fr, fq * 8), boff = lds_byte(wc * 32 + fr, fq * 8);
#define PG8_SA(b, h) (((b) * 2 + (h)) * HTB)
#define PG8_SB(b, h) ((4 + (b) * 2 + (h)) * HTB)
#define PG8_STAGE(bufoff, gbase, voff) do { _Pragma("unroll") for (int _i = 0; _i < 2; ++_i) \
        __builtin_amdgcn_global_load_lds((const unsigned*)((const char*)(gbase) + (voff)[_i]), (PG8_LAS unsigned*)(lds + (bufoff) + ldsw + _i * 8192), 16, 0, 0); } while (0)
#define PG8_LD16(off) __builtin_bit_cast(i32x4, *(const PG8_LAS bf16x8*)(lds + (off)))
#define PG8_LDA(dst, b, h) do { _Pragma("unroll") for (int m = 0; m < 4; ++m) { if constexpr (epi_fp8<Epi>::v) dst##8[m] = __builtin_shufflevector(PG8_LD16(PG8_SA(b, h) + aoff + m * 2048), PG8_LD16(PG8_SA(b, h) + aoff + m * 2048 + 1024), 0, 1, 2, 3, 4, 5, 6, 7); \
        else { _Pragma("unroll") for (int k = 0; k < 2; ++k) dst[m][k] = *(const PG8_LAS bf16x8*)(lds + PG8_SA(b, h) + aoff + m * 2048 + k * 1024); } } } while (0)
#define PG8_LDB(dst, b, h) do { _Pragma("unroll") for (int n = 0; n < 2; ++n) { if constexpr (epi_fp8<Epi>::v) dst##8[n] = __builtin_shufflevector(PG8_LD16(PG8_SB(b, h) + boff + n * 2048), PG8_LD16(PG8_SB(b, h) + boff + n * 2048 + 1024), 0, 1, 2, 3, 4, 5, 6, 7); \
        else { _Pragma("unroll") for (int k = 0; k < 2; ++k) dst[n][k] = *(const PG8_LAS bf16x8*)(lds + PG8_SB(b, h) + boff + n * 2048 + k * 1024); } } } while (0)
#define PG8_MMA(ai, bj, At, Bt) do { __builtin_amdgcn_s_setprio(1); \
        if constexpr (epi_fp8<Epi>::v) { _Pragma("unroll") for (int m = 0; m < 4; ++m) _Pragma("unroll") for (int n = 0; n < 2; ++n) \
            asm volatile("v_mfma_f32_16x16x128_f8f6f4 %0, %1, %2, %0" : "+v"(acc[ai][bj][m][n]) : "v"(Bt##8[n]), "v"(At##8[m])); }     \
        else { _Pragma("unroll") for (int m = 0; m < 4; ++m) _Pragma("unroll") for (int n = 0; n < 2; ++n) _Pragma("unroll") for (int k = 0; k < 2; ++k) \
            acc[ai][bj][m][n] = __builtin_amdgcn_mfma_f32_16x16x32_bf16(Bt[n][k], At[m][k], acc[ai][bj][m][n], 0, 0, 0); } \
        __builtin_amdgcn_s_setprio(0); } while (0)
#define PG8_WAIT_V(n) asm volatile("s_waitcnt vmcnt(" #n ")" ::: "memory")
#define PG8_WAIT_L(n) asm volatile("s_waitcnt lgkmcnt(" #n ")" ::: "memory")
#define PG8_BAR __builtin_amdgcn_s_barrier()
#define PG8_SCHED __builtin_amdgcn_sched_barrier(0)
    Unit cur, nxt; int ui = 0;
    if (!S.next(0, cur)) return;
    f32x4 acc[2][2][4][2];
#pragma unroll
    for (int a = 0; a < 2; ++a)
#pragma unroll
        for (int b = 0; b < 2; ++b)
#pragma unroll
            for (int m = 0; m < 4; ++m)
#pragma unroll
                for (int n = 0; n < 2; ++n) acc[a][b][m][n] = (f32x4){0.f, 0.f, 0.f, 0.f};
    bf16x8 At[4][2], B0[2][2], B1[2][2];
    i32x8 At8[4], B08[2], B18[2];
    const char* cA; const char* cB; S.ptrs(cur, cA, cB);
    S.a_ready(cur);
    if constexpr (Sched::GATHER) {
#pragma unroll
        for (int i = 0; i < 2; ++i) { int R, C; stage_rc(tid * 16 + i * 8192, R, C); c0[i] = S.row_off(0, R) + (unsigned)(C * 2); c1[i] = S.row_off(0, 128 + R) + (unsigned)(C * 2); n0[i] = c0[i]; n1[i] = c1[i]; } }
    static_assert(SP2, "only the two-super-phase loop is kept in this file");
    PG8_STAGE(PG8_SB(0, 0), cB, voffB); PG8_STAGE(PG8_SB(0, 1), cB + hstepB, voffB); PG8_STAGE(PG8_SA(0, 0), cA, c0); PG8_STAGE(PG8_SA(0, 1), cA + hstepA, c1);
    if (wr == 1) PG8_BAR;
    PG8_WAIT_V(2); PG8_BAR;
    PG8_STAGE(PG8_SB(1, 0), cB + kstep, voffB); PG8_STAGE(PG8_SA(1, 0), cA + kstep, c0); PG8_STAGE(PG8_SB(1, 1), cB + hstepB + kstep, voffB);
    PG8_WAIT_V(6); PG8_BAR;
    for (;;) {
        const bool has_next = S.next(ui + 1, nxt);
        const char* nA = cA; const char* nB = cB; if (has_next) S.ptrs(nxt, nA, nB);
        const bool h1 = S.half1(cur);
        for (int t = 0; t < nt; t += 2) {
            const bool last = (t == nt - 2);
            const char* a1 = cA + (size_t)(t + 1) * kstep;
            const char* a2 = last ? nA : cA + (size_t)(t + 2) * kstep; const char* b2 = last ? nB : cB + (size_t)(t + 2) * kstep;
            const char* a3 = a2 + kstep; const char* b3 = b2 + kstep;
            if (last && has_next) { S.a_ready(nxt);
                if constexpr (Sched::GATHER) {
#pragma unroll
                    for (int i = 0; i < 2; ++i) { int R, C; stage_rc(tid * 16 + i * 8192, R, C); n0[i] = S.row_off(ui + 1, R) + (unsigned)(C * 2); n1[i] = S.row_off(ui + 1, 128 + R) + (unsigned)(C * 2); } } }
            const unsigned s0[2] = {last ? n0[0] : c0[0], last ? n0[1] : c0[1]}, s1[2] = {last ? n1[0] : c1[0], last ? n1[1] : c1[1]};
            PG8_LDB(B0, 0, 0); PG8_LDB(B1, 0, 1); PG8_SCHED; PG8_LDA(At, 0, 0); PG8_STAGE(PG8_SA(1, 1), a1 + hstepA, c1);
            PG8_WAIT_V(8); PG8_WAIT_L(0); PG8_BAR; PG8_MMA(0, 0, At, B0); PG8_MMA(0, 1, At, B1); PG8_BAR; PG8_SCHED;
            PG8_LDA(At, 0, 1); PG8_STAGE(PG8_SB(0, 0), b2, voffB); PG8_STAGE(PG8_SB(0, 1), b2 + hstepB, voffB); PG8_STAGE(PG8_SA(0, 0), a2, s0);
            PG8_WAIT_V(8); PG8_WAIT_L(0); PG8_BAR; if (h1) { PG8_MMA(1, 0, At, B0); PG8_MMA(1, 1, At, B1); } PG8_BAR; PG8_SCHED;
            PG8_LDB(B0, 1, 0); PG8_LDB(B1, 1, 1); PG8_SCHED; PG8_LDA(At, 1, 0); PG8_STAGE(PG8_SA(0, 1), a2 + hstepA, s1);
            PG8_WAIT_V(8); PG8_WAIT_L(0); PG8_BAR; PG8_MMA(0, 0, At, B0); PG8_MMA(0, 1, At, B1); PG8_BAR; PG8_SCHED;
            PG8_LDA(At, 1, 1); PG8_STAGE(PG8_SB(1, 0), b3, voffB); PG8_STAGE(PG8_SB(1, 1), b3 + hstepB, voffB); PG8_STAGE(PG8_SA(1, 0), a3, s0);
            PG8_WAIT_V(8); PG8_WAIT_L(0); PG8_BAR; if (h1) { PG8_MMA(1, 0, At, B0); PG8_MMA(1, 1, At, B1); } PG8_BAR; PG8_SCHED;
        }
        if constexpr (epi_fp8<Epi>::v) { asm volatile("s_nop 7\n\ts_nop 7\n\ts_nop 7" ::: "memory"); }
        if constexpr (ALIGN_EPI) { if (wr == 0) PG8_BAR; }
        if constexpr (!Epi::AFTER_DRAIN) { E(acc, cur, wr, wc, fr, fq); S.done(cur); }
        if (!has_next) break;
#pragma unroll
        for (int a = 0; a < 2; ++a)
#pragma unroll
            for (int b = 0; b < 2; ++b)
#pragma unroll
                for (int m = 0; m < 4; ++m)
#pragma unroll
                    for (int n = 0; n < 2; ++n) acc[a][b][m][n] = (f32x4){0.f, 0.f, 0.f, 0.f};
        cur = nxt; cA = nA; cB = nB; ++ui;
#pragma unroll
        for (int i = 0; i < 2; ++i) { c0[i] = n0[i]; c1[i] = n1[i]; }
        if constexpr (ALIGN_EPI) { if (wr == 1) PG8_BAR; }
    }
    PG8_WAIT_V(0);
    if constexpr (!ALIGN_EPI) { if (wr == 0) PG8_BAR; }
    PG8_BAR;
    if constexpr (Epi::AFTER_DRAIN) { E.fused(acc, cur, wr, wc, fr, fq, lds, wid, lane); S.done(cur); }
#undef PG8_SA
#undef PG8_SB
#undef PG8_STAGE
#undef PG8_LDA
#undef PG8_LD16
#undef PG8_LDB
#undef PG8_MMA
#undef PG8_WAIT_V
#undef PG8_WAIT_L
#undef PG8_BAR
#undef PG8_SCHED
}
}

constexpr size_t MiB = 1u << 20;
constexpr size_t al256(size_t x) { return (x + 255) & ~(size_t)255; }
constexpr size_t WS_CTL = 0, CTL_ZERO_BYTES = 1 * MiB;
constexpr int CW_BAR = 4096;
constexpr int CW_CNT = 49152, CNT_STRIDE = 64;
constexpr int CW_CVQ = 16384;
constexpr int CW_SSQ2 = 32768;
constexpr size_t WS_WIN = 1 * MiB;
constexpr size_t WS_WQB = WS_WIN + al256((size_t)INCP * D * 2);
constexpr size_t WS_WKVB = WS_WQB + al256((size_t)1536 * QL * 2);
constexpr size_t WS_WGLU = WS_WKVB + al256((size_t)2048 * KVL * 2);
constexpr size_t WS_WOUT = WS_WGLU + al256((size_t)SSMW * SSMW * 2);
constexpr size_t WS_WXQ = WS_WOUT + al256((size_t)D * D * 2);
constexpr size_t WS_WXK = WS_WXQ + al256((size_t)D * D * 2);
constexpr size_t WS_WXV = WS_WXK + al256((size_t)D * D * 2);
constexpr size_t WS_WXO = WS_WXV + al256((size_t)D * D * 2);
constexpr size_t WS_BTY = WS_WXO + al256((size_t)D * D * 2);
constexpr size_t WS_BTS = WS_BTY + al256((size_t)G * 512 * AGW * 2);
constexpr size_t WS_AP32 = WS_BTS + al256((size_t)G * 128 * 512 * 2);
constexpr size_t WS_HB = WS_AP32 + al256((size_t)G * P * 2 * 4);
constexpr size_t WS_MEMN = WS_HB + al256((size_t)T * D * 2);
constexpr size_t WS_PROJB = WS_MEMN + al256((size_t)TM * D * 2);
constexpr size_t WS_AG = WS_PROJB + al256((size_t)T * PJW * 2);
constexpr size_t WS_SC = WS_AG + al256((size_t)G * 256 * AGW * 2);
constexpr size_t WS_CQN = WS_SC + al256((size_t)G * 256 * 128 * 4);
constexpr size_t WS_CKVN = WS_CQN + al256((size_t)T * QL * 2);
constexpr size_t WS_KPE = WS_CKVN + al256((size_t)T * KVL * 2);
constexpr size_t WS_ROPE = WS_KPE + al256((size_t)T * DR * 2);
constexpr size_t WS_Q = WS_ROPE + al256((size_t)T * 64 * 4);
constexpr size_t WS_KV = WS_Q + al256((size_t)T * 1536 * 2);
constexpr size_t WS_XK = WS_KV + al256((size_t)T * 2048 * 2);
constexpr size_t WS_XVT = WS_XK + al256((size_t)TM * D * 2);
constexpr size_t WS_Y = WS_XVT + al256((size_t)D * TM * 2);
constexpr size_t WS_ATTO = WS_Y + al256((size_t)T * SSMW * 2);
constexpr size_t WS_SSMO = WS_ATTO + al256((size_t)T * 1024 * 2);
constexpr size_t WS_X1 = WS_SSMO + al256((size_t)T * 1024 * 2);
constexpr size_t WS_X1B = WS_X1 + al256((size_t)T * D * 4);
constexpr size_t WS_XQ = WS_X1B + al256((size_t)T * D * 2);
constexpr size_t WS_PX = WS_XQ + al256((size_t)T * D * 2);
constexpr size_t WS_WXQN = WS_XQ;
constexpr size_t WS_WKT8 = WS_XQ + (size_t)D * D * 2;
constexpr size_t WS_XO = WS_PX + al256((size_t)BATCH * XH * SEQ * MEM * 2);
constexpr size_t WS_X2 = WS_XO + al256((size_t)T * D * 2);
constexpr size_t WS_X2B = WS_X2 + al256((size_t)T * D * 4);
constexpr size_t WS_WRH = WS_X2B + al256((size_t)T * D * 2);
constexpr size_t WS_WRL = WS_WRH + al256((size_t)E * D * 2);
constexpr size_t WS_SELE = WS_WRL + al256((size_t)E * D * 2);
constexpr size_t WS_SELP = WS_SELE + al256((size_t)T * TOPK * 4);
constexpr size_t WS_SELG = WS_SELP + al256((size_t)T * TOPK * 4);
constexpr size_t WS_LIST = WS_SELG + al256((size_t)T * TOPK * 4);
constexpr int NSLOT = (T * TOPK / 256 + E) * 256;
constexpr size_t WS_ACT = WS_LIST + al256((size_t)E * T * 4);
constexpr size_t WS_YK = WS_ACT + al256((size_t)NSLOT * FF * 2);
constexpr size_t WS_WUP = WS_YK + al256((size_t)NSLOT * D * 2);
constexpr size_t WS_WDN = WS_WUP + al256((size_t)E * 2 * FF * D * 2);
constexpr size_t WS_X2F8 = WS_WDN + al256((size_t)E * D * FF * 2);
constexpr size_t WS_X1F8 = WS_X2F8 + al256((size_t)T * D);
constexpr size_t WS_XO8 = WS_X1F8 + al256((size_t)T * D);
constexpr size_t WS_WXQ8 = WS_XO8 + al256((size_t)T * D);
constexpr size_t WS_WXO8 = WS_WXQ8 + al256((size_t)D * D);
constexpr size_t WS_MIXED = WS_WXO8 + al256((size_t)D * D);
constexpr size_t WS_SSQP1 = WS_MIXED + al256((size_t)T * D * 2);
constexpr size_t WS_SSQP2 = WS_SSQP1 + al256((size_t)T * 32 * 4);
constexpr size_t WS_RSTD2 = WS_SSQP2 + al256((size_t)T * 32 * 4);
constexpr size_t WS_XV8 = WS_XVT;
constexpr size_t WS_VWT = WS_XO8;
constexpr size_t WS_END1 = WS_RSTD2 + al256((size_t)T * 4);

constexpr int NWAVES = 8, NTHR = 512;
constexpr int RING_OFF = 0, RING_BYTES = 131072;
constexpr int LDSCTL_OFF = RING_BYTES, MISC_OFF = LDSCTL_OFF + 320;
constexpr int TOK_OFF = LDSCTL_OFF + 1024, MAXU = 10;
constexpr int BLK_OFF = TOK_OFF + MAXU * 1024;
constexpr int LDS_BYTES = 147456;
static_assert(BLK_OFF + 480 * 4 <= LDS_BYTES, "LDS map");

#define GAS __attribute__((address_space(1)))
#define LAS __attribute__((address_space(3)))
typedef unsigned short bf16;
typedef unsigned v4u __attribute__((ext_vector_type(4)));
typedef unsigned v2u __attribute__((ext_vector_type(2)));
typedef float v2f __attribute__((ext_vector_type(2)));
typedef float f32x4 __attribute__((ext_vector_type(4)));
typedef short bf16x8 __attribute__((ext_vector_type(8)));
#define LDS_WAIT() asm volatile("s_waitcnt lgkmcnt(0)" ::: "memory")
#define VM_WAIT() asm volatile("s_waitcnt vmcnt(0)" ::: "memory")
__device__ __forceinline__ unsigned f2bf(float f) { unsigned u = __builtin_bit_cast(unsigned, f); return (u + 0x7fffu + ((u >> 16) & 1u)) >> 16; }
__device__ __forceinline__ unsigned pk2(float lo, float hi) { return f2bf(lo) | (f2bf(hi) << 16); }
__device__ __forceinline__ float bf2f(unsigned short h) { return __builtin_bit_cast(float, (unsigned)h << 16); }
__device__ __forceinline__ float bflo(unsigned w) { return __builtin_bit_cast(float, w << 16); }
__device__ __forceinline__ float bfhi(unsigned w) { return __builtin_bit_cast(float, w & 0xffff0000u); }

__device__ __forceinline__ float clamp448(float v) { return fminf(fmaxf(v, -448.0f), 448.0f); }
__device__ __forceinline__ float clamp448m(float v) { return __builtin_amdgcn_fmed3f(v, -448.0f, 448.0f); }
__device__ __forceinline__ unsigned pk4_fp8w(float a, float b, float c, float d) {
    int p = __builtin_amdgcn_cvt_pk_fp8_f32(clamp448m(a), clamp448m(b), 0, false); p = __builtin_amdgcn_cvt_pk_fp8_f32(clamp448m(c), clamp448m(d), p, true); return (unsigned)p; }
__device__ __forceinline__ unsigned pk4_fp8(float a, float b, float c, float d) {
    int p = __builtin_amdgcn_cvt_pk_fp8_f32(clamp448(a), clamp448(b), 0, false); p = __builtin_amdgcn_cvt_pk_fp8_f32(clamp448(c), clamp448(d), p, true); return (unsigned)p; }
constexpr float W8_SCALE = 256.0f, W8_INV = 1.0f / 256.0f;

#define XB_TMO      128
#define XB_XCNT(j)  (256  + 64 * (j))
#define XB_XSUB(j)  (1280 + 64 * (j))
#define XB_XGEN(j)  (2304 + 64 * (j))
#define XB_TOP      3328
#define XB_TOPGEN   3392
#define XB_FLAG(j)  (3456 + (j))
#define XCD_BAR_WORDS 3520
#define XB_SPIN_CAP (1u << 18)

__device__ __forceinline__ unsigned xb_ld(unsigned* p)              { return __hip_atomic_load(p, __ATOMIC_RELAXED, __HIP_MEMORY_SCOPE_AGENT); }
__device__ __forceinline__ unsigned xb_add(unsigned* p, unsigned v) { return __hip_atomic_fetch_add(p, v, __ATOMIC_RELAXED, __HIP_MEMORY_SCOPE_AGENT); }
__device__ __forceinline__ unsigned xb_xcc_id() { return (unsigned)__builtin_amdgcn_s_getreg((3 << 11) | 20) & 0xFu; }
#define XB_SPIN(cond, bar) do { unsigned _sp = 0; while (cond) { __builtin_amdgcn_s_sleep(1); \
    if ((++_sp & 255u) == 0u) { if (xb_ld(&(bar)[XB_TMO])) break; if (_sp > XB_SPIN_CAP) { atomicAdd(&(bar)[XB_TMO], 1u); break; } } } } while (0)

struct XcdBarrier {
    unsigned* bar; unsigned x; int wave;
    volatile LAS unsigned* st;
};
__device__ __forceinline__ bool xb_thread0(int wave) { return wave == 0 && lane_id_now() == 0; }
__device__ __forceinline__ XcdBarrier xcd_barrier_post(unsigned* bar, volatile LAS unsigned* st, int wave) {
    XcdBarrier b; b.bar = bar; b.x = xb_xcc_id(); b.st = st; b.wave = wave;
    if (xb_thread0(wave)) (void)xb_add(&bar[XB_XCNT(b.x)], 1u);
    return b;
}
__device__ __forceinline__ void xcd_barrier_complete(unsigned* bar, unsigned x, unsigned& nloc, unsigned& nx, unsigned& mask) {
    const unsigned G_ = gridDim.x * gridDim.y * gridDim.z;
    unsigned sum, cnt, mine, msk, sp = 0u;
    for (;;) {
        sum = 0u; cnt = 0u; mine = 0u; msk = 0u;
#pragma unroll
        for (unsigned j = 0; j < 16; ++j) { const unsigned c = xb_ld(&bar[XB_XCNT(j)]); sum += c; cnt += (c > 0u) ? 1u : 0u; msk |= (c > 0u) ? (1u << j) : 0u; mine = (j == x) ? c : mine; }
        if (sum == G_) break;
        __builtin_amdgcn_s_sleep(1);
        if ((++sp & 255u) == 0u) { if (xb_ld(&bar[XB_TMO])) break; if (sp > XB_SPIN_CAP) { atomicAdd(&bar[XB_TMO], 1u); break; } }
    }
    nloc = mine > 0u ? mine : 1u; nx = cnt > 0u ? cnt : 1u; mask = msk;
}
__device__ __forceinline__ void xb_wave0(const XcdBarrier& b, volatile LAS unsigned* stopw = nullptr, unsigned stopv = 0u) {
    unsigned* bar = b.bar;
    const int lane = lane_id_now();
    __builtin_amdgcn_s_waitcnt(0);
    unsigned gen = 0u;
    if (lane == 0) {
        unsigned nloc = b.st[0], nx = b.st[1], mask = b.st[2];
        if (nloc == 0u) { xcd_barrier_complete(bar, b.x, nloc, nx, mask); b.st[0] = nloc; b.st[1] = nx; b.st[2] = mask; }
        const unsigned old = xb_add(&bar[XB_XSUB(b.x)], 1u);
        gen = old / nloc;
        if (old + 1u == (gen + 1u) * nloc) {
            __builtin_amdgcn_fence(__ATOMIC_RELEASE, "agent");
            asm volatile("s_waitcnt vmcnt(0)" ::: "memory");
            xb_add(&bar[XB_FLAG(b.x)], 1u);
        }
    }
    gen = (unsigned)__builtin_amdgcn_readfirstlane((int)gen);
    asm volatile("s_waitcnt lgkmcnt(0)" ::: "memory");
    const unsigned mask = b.st[2];
    unsigned sp = 0u;
    for (;;) {
        unsigned f = 0u; if (lane < 16) f = xb_ld(&bar[XB_FLAG(lane)]);
        const bool waiting = (lane < 16) && ((mask >> lane) & 1u) && ((int)(f - gen) <= 0);
        const unsigned long long wm = __builtin_amdgcn_ballot_w64(waiting);
        if (wm == 0ull) break;
        if (stopw && 2 * __builtin_popcountll(wm) <= __builtin_popcount(mask)) { *stopw = stopv; stopw = nullptr; }
        __builtin_amdgcn_s_sleep(1);
        if ((++sp & 255u) == 0u) { if (xb_ld(&bar[XB_TMO])) break; if (sp > XB_SPIN_CAP) { if (lane == 0) atomicAdd(&bar[XB_TMO], 1u); break; } }
    }
    __builtin_amdgcn_fence(__ATOMIC_ACQUIRE, "agent");
    asm volatile("s_waitcnt vmcnt(0)" ::: "memory");
}
__device__ __forceinline__ void xcd_barrier(const XcdBarrier& b) {
    asm volatile("s_waitcnt vmcnt(0)" ::: "memory");
    __syncthreads();
    if (b.wave == 0) xb_wave0(b);
    __syncthreads();
}

__device__ __forceinline__ float wave_sum(float v) {
#pragma unroll
    for (int o = 1; o < 64; o <<= 1) v += __shfl_xor(v, o);
    return v;
}
__device__ __forceinline__ void transpose_item(const float* W, int N, bf16* WT, int ldk, const float* gain, LAS float* scr, int item, int nblk, int lane) {
    const int kb = item / nblk, nb = item % nblk, k0 = 64 * kb, n0 = 32 * nb;
#pragma unroll 8
    for (int i = 0; i < 32; ++i) { const int kk = 2 * i + (lane >> 5); const float g = gain ? gain[k0 + kk] : 1.0f;
        scr[kk * 33 + (lane & 31)] = W[(size_t)(k0 + kk) * N + n0 + (lane & 31)] * g; }
    LDS_WAIT(); asm volatile("" ::: "memory");
    const int c = lane & 7;
#pragma unroll
    for (int j = 0; j < 4; ++j) { const int n = (lane >> 3) + 8 * j; const LAS float* s = scr + (8 * c) * 33 + n;
        v4u o; o.x = pk2(s[0 * 33], s[1 * 33]); o.y = pk2(s[2 * 33], s[3 * 33]); o.z = pk2(s[4 * 33], s[5 * 33]); o.w = pk2(s[6 * 33], s[7 * 33]);
        *(GAS v4u*)(WT + (size_t)(n0 + n) * ldk + k0 + 8 * c) = o; }
    LDS_WAIT(); asm volatile("" ::: "memory");
}
__device__ __forceinline__ void rms_row_to_bf16(const float* xrow, const float* g, bf16* orow, int lane) {
    const GAS f32x4* xr = (const GAS f32x4*)xrow + lane;
    f32x4 v[8], gv[8]; float s = 0.f;
#pragma unroll
    for (int j = 0; j < 8; ++j) { v[j] = xr[64 * j]; gv[j] = ((const GAS f32x4*)g)[lane + 64 * j]; }
#pragma unroll
    for (int j = 0; j < 8; ++j) s += (v[j].x * v[j].x + v[j].y * v[j].y) + (v[j].z * v[j].z + v[j].w * v[j].w);
    const float r = rsqrtf(wave_sum(s) * (1.f / D) + EPS);
    GAS v2u* o8 = (GAS v2u*)orow + lane;
#pragma unroll
    for (int j = 0; j < 8; ++j) { const f32x4 gg = gv[j];
        v2u o; o.x = pk2(v[j].x * r * gg.x, v[j].y * r * gg.y); o.y = pk2(v[j].z * r * gg.z, v[j].w * r * gg.w); o8[64 * j] = o; }
}

__device__ __forceinline__ void s5_setup(int g, LAS unsigned char* lds, const float* lam_re, const float* lam_im, const float* log_dt, const float* b_re, const float* b_im,
                                         const float* c_re, const float* c_im, bf16* BTY, bf16* BTS, float* AP32, int tid) {
    LAS float* apr = (LAS float*)lds;
    LAS float* api = apr + 33 * 64;
    LAS float* bbr = api + 33 * 64;
    LAS float* bbi = bbr + 1024;
    LAS float* ccr = bbi + 1024;
    LAS float* cci = ccr + 1024;
    LAS float* Kd = cci + 1024;
    const float dt = expf(log_dt[g]);
    for (int idx = tid; idx < 33 * 64; idx += NTHR) { const int d = idx >> 6, p = idx & 63; const float lr = lam_re[g * 64 + p], li = lam_im[g * 64 + p];
        const float mag = expf((float)d * (lr * dt)), ang = (float)d * (li * dt); apr[idx] = mag * cosf(ang); api[idx] = mag * sinf(ang); }
    for (int idx = tid; idx < 1024; idx += NTHR) { ccr[idx] = c_re[g * 1024 + idx]; cci[idx] = c_im[g * 1024 + idx]; }
    __syncthreads();
    for (int idx = tid; idx < 1024; idx += NTHR) { const int p = idx >> 4; const float lr = lam_re[g * 64 + p], li = lam_im[g * 64 + p];
        const float nr = apr[64 + p] - 1.0f, ni = api[64 + p], den = lr * lr + li * li; const float cre = (nr * lr + ni * li) / den, cim = (ni * lr - nr * li) / den;
        const float br = b_re[g * 1024 + idx], bi = b_im[g * 1024 + idx]; bbr[idx] = cre * br - cim * bi; bbi[idx] = cre * bi + cim * br; }
    __syncthreads();
    for (int idx = tid; idx < 32 * 256; idx += NTHR) { const int d = idx >> 8, co = (idx >> 4) & 15, ci = idx & 15; float a = 0.f;
        for (int p = 0; p < 64; ++p) { const float cr = ccr[co * 64 + p], cm = cci[co * 64 + p], ar = apr[d * 64 + p], ai = api[d * 64 + p];
            const float car = cr * ar - cm * ai, cai = cr * ai + cm * ar; a += car * bbr[p * 16 + ci] - cai * bbi[p * 16 + ci]; }
        Kd[idx] = a; }
    __syncthreads();
    for (int idx = tid; idx < 512 * 80; idx += NTHR) { const int row = idx / 80, q = idx % 80, i = row >> 4, co = row & 15; float v[8];
        if (q < 64) { const int j = q >> 1, ci0 = (q & 1) * 8;
#pragma unroll
            for (int e = 0; e < 8; ++e) v[e] = (j <= i) ? Kd[(i - j) * 256 + co * 16 + ci0 + e] : 0.f; }
        else if (q < 72) { const int p0 = (q - 64) * 8;
#pragma unroll
            for (int e = 0; e < 8; ++e) { const int p = p0 + e; v[e] = ccr[co * 64 + p] * apr[(i + 1) * 64 + p] - cci[co * 64 + p] * api[(i + 1) * 64 + p]; } }
        else { const int p0 = (q - 72) * 8;
#pragma unroll
            for (int e = 0; e < 8; ++e) { const int p = p0 + e; v[e] = -(ccr[co * 64 + p] * api[(i + 1) * 64 + p] + cci[co * 64 + p] * apr[(i + 1) * 64 + p]); } }
        v4u o; o.x = pk2(v[0], v[1]); o.y = pk2(v[2], v[3]); o.z = pk2(v[4], v[5]); o.w = pk2(v[6], v[7]);
        *(GAS v4u*)(BTY + ((size_t)g * 512 + row) * AGW + q * 8) = o; }
    for (int idx = tid; idx < 128 * 64; idx += NTHR) { const int row = idx >> 6, q = idx & 63, p = row & 63, part = row >> 6, j = q >> 1, ci0 = (q & 1) * 8; float v[8];
        const float ar = apr[(31 - j) * 64 + p], ai = api[(31 - j) * 64 + p];
#pragma unroll
        for (int e = 0; e < 8; ++e) { const float br = bbr[p * 16 + ci0 + e], bi = bbi[p * 16 + ci0 + e]; v[e] = part ? (ar * bi + ai * br) : (ar * br - ai * bi); }
        v4u o; o.x = pk2(v[0], v[1]); o.y = pk2(v[2], v[3]); o.z = pk2(v[4], v[5]); o.w = pk2(v[6], v[7]);
        *(GAS v4u*)(BTS + ((size_t)g * 128 + row) * 512 + q * 8) = o; }
    if (tid < 64) { AP32[(g * 64 + tid) * 2] = apr[32 * 64 + tid]; AP32[(g * 64 + tid) * 2 + 1] = api[32 * 64 + tid]; }
    __syncthreads();
}

using pg8::Unit;
template <bool RS, bool F8 = false, bool O8 = false> struct EpiPlain {
    static constexpr bool PERM = true, AFTER_DRAIN = false, FP8 = F8;
    bf16* O; int ldc; int zdiv; long zC1, zC2; const LAS float* rstd;
    __device__ __forceinline__ void operator()(const f32x4 (&acc)[2][2][4][2], const Unit& u, int wr, int wc, int fr, int fq) const {
        const long zoff = (long)(u.z / zdiv) * zC1 + (long)(u.z % zdiv) * zC2;
        const int row0 = u.pm * 256 + wr * 64 + fr, col0 = u.pn * 256 + wc * 32 + 8 * fq;
#pragma unroll
        for (int ai = 0; ai < 2; ++ai)
#pragma unroll
            for (int m = 0; m < 4; ++m) { const int row = row0 + ai * 128 + m * 16; const size_t eo = (size_t)zoff + (size_t)row * ldc + col0;
                float sc = F8 ? W8_INV : 1.f; if (RS) sc *= rstd[row - u.pm * 256];
#pragma unroll
                for (int bj = 0; bj < 2; ++bj) { const f32x4 v0 = acc[ai][bj][m][0] * sc, v1 = acc[ai][bj][m][1] * sc;
                    if constexpr (O8) { v2u w; w.x = pk4_fp8(v0[0], v0[1], v0[2], v0[3]); w.y = pk4_fp8(v1[0], v1[1], v1[2], v1[3]); *(v2u*)((unsigned char*)O + eo + bj * 128) = w; }
                    else { v4u w; w.x = pg8::cvt_pk_bf16(v0[0], v0[1]); w.y = pg8::cvt_pk_bf16(v0[2], v0[3]); w.z = pg8::cvt_pk_bf16(v1[0], v1[1]); w.w = pg8::cvt_pk_bf16(v1[2], v1[3]);
                        *(v4u*)(O + eo + bj * 128) = w; } } }
    }
};
struct EpiProj {
    static constexpr bool PERM = true, AFTER_DRAIN = false;
    bf16* projb; bf16* Ag;
    __device__ __forceinline__ void operator()(const f32x4 (&acc)[2][2][4][2], const Unit& u, int wr, int wc, int fr, int fq) const {
        const int row0 = u.pm * 256 + wr * 64 + fr;
#pragma unroll
        for (int bj = 0; bj < 2; ++bj) { const int colg = u.pn * 256 + bj * 128 + wc * 32, c0 = colg + 8 * fq;
            if (colg >= INC) continue;
#pragma unroll
            for (int ai = 0; ai < 2; ++ai)
#pragma unroll
                for (int m = 0; m < 4; ++m) { const int row = row0 + ai * 128 + m * 16; const f32x4 v0 = acc[ai][bj][m][0], v1 = acc[ai][bj][m][1]; v4u w;
                    w.x = pg8::cvt_pk_bf16(v0[0], v0[1]); w.y = pg8::cvt_pk_bf16(v0[2], v0[3]); w.z = pg8::cvt_pk_bf16(v1[0], v1[1]); w.w = pg8::cvt_pk_bf16(v1[2], v1[3]);
                    if (colg < PJW) *(v4u*)(projb + (size_t)row * PJW + c0) = w;
                    else { const int ch = c0 - PJW, g = ch >> 4, c = ch & 15; *(v4u*)(Ag + ((size_t)g * 256 + (row >> 5)) * AGW + (row & 31) * 16 + c) = w; } } }
    }
};
struct EpiS5State {
    static constexpr bool PERM = false, AFTER_DRAIN = false;
    float* Sc;
    __device__ __forceinline__ void operator()(const f32x4 (&acc)[2][2][4][2], const Unit& u, int wr, int wc, int fr, int fq) const {
        const int row0 = wr * 64 + fr, col0 = wc * 32 + 4 * fq;
#pragma unroll
        for (int ai = 0; ai < 2; ++ai)
#pragma unroll
            for (int m = 0; m < 4; ++m) { float* rowp = Sc + ((size_t)u.z * 256 + row0 + ai * 128 + m * 16) * 128 + col0;
#pragma unroll
                for (int n = 0; n < 2; ++n) *(f32x4*)(rowp + n * 16) = acc[ai][0][m][n]; }
    }
};
__device__ __forceinline__ float gelu_tanh(float v) {
    const float t = v * (0.7978845608028654f + 0.7978845608028654f * 0.044715f * v * v);
    return v * __builtin_amdgcn_rcpf(1.0f + __builtin_amdgcn_exp2f(-2.885390081777927f * t));
}
struct EpiS5Y {
    static constexpr bool PERM = true, AFTER_DRAIN = false;
    const bf16* Ag; const float* dsk; bf16* Y;
    __device__ __forceinline__ void operator()(const f32x4 (&acc)[2][2][4][2], const Unit& u, int wr, int wc, int fr, int fq) const {
        const int g = u.z, row0 = wr * 64 + fr;
        v4u ub2[2][8]; f32x4 dd[2][2];
#pragma unroll
        for (int bj = 0; bj < 2; ++bj) { const int c0 = u.pn * 256 + bj * 128 + wc * 32 + 8 * fq, co = c0 & 15;
            dd[bj][0] = *(const f32x4*)(dsk + g * 16 + co); dd[bj][1] = *(const f32x4*)(dsk + g * 16 + co + 4);
#pragma unroll
            for (int q = 0; q < 8; ++q) ub2[bj][q] = *(const v4u*)(Ag + ((size_t)g * 256 + row0 + (q >> 2) * 128 + (q & 3) * 16) * AGW + c0); }
#pragma unroll
        for (int bj = 0; bj < 2; ++bj) { const int c0 = u.pn * 256 + bj * 128 + wc * 32 + 8 * fq, i = c0 >> 4, co = c0 & 15;
            const f32x4 d0 = dd[bj][0], d1 = dd[bj][1];
#pragma unroll
            for (int ai = 0; ai < 2; ++ai)
#pragma unroll
                for (int m = 0; m < 4; ++m) { const int r = row0 + ai * 128 + m * 16;
                    const v4u uu = ub2[bj][ai * 4 + m];
                    f32x4 v0 = acc[ai][bj][m][0], v1 = acc[ai][bj][m][1];
                    v0[0] += d0[0] * bflo(uu.x); v0[1] += d0[1] * bfhi(uu.x); v0[2] += d0[2] * bflo(uu.y); v0[3] += d0[3] * bfhi(uu.y);
                    v1[0] += d1[0] * bflo(uu.z); v1[1] += d1[1] * bfhi(uu.z); v1[2] += d1[2] * bflo(uu.w); v1[3] += d1[3] * bfhi(uu.w);
                    v4u w; w.x = pg8::cvt_pk_bf16(gelu_tanh(v0[0]), gelu_tanh(v0[1])); w.y = pg8::cvt_pk_bf16(gelu_tanh(v0[2]), gelu_tanh(v0[3]));
                    w.z = pg8::cvt_pk_bf16(gelu_tanh(v1[0]), gelu_tanh(v1[1])); w.w = pg8::cvt_pk_bf16(gelu_tanh(v1[2]), gelu_tanh(v1[3]));
                    *(v4u*)(Y + ((size_t)(r * 32 + i)) * SSMW + g * 16 + co) = w; } }
    }
};

struct EpiGlu {
    static constexpr bool PERM = true, AFTER_DRAIN = false;
    const bf16* Y; const float* bias; bf16* O;
    __device__ __forceinline__ void operator()(const f32x4 (&acc)[2][2][4][2], const Unit& u, int wr, int wc, int fr, int fq) const {
        const int row0 = u.pm * 256 + wr * 64 + fr;
        v4u yb2[2][8]; f32x4 bb[2][2];
#pragma unroll
        for (int bj = 0; bj < 2; ++bj) { const int c0 = u.pn * 256 + bj * 128 + wc * 32 + 8 * fq;
            bb[bj][0] = *(const f32x4*)(bias + c0); bb[bj][1] = *(const f32x4*)(bias + c0 + 4);
#pragma unroll
            for (int q = 0; q < 8; ++q) yb2[bj][q] = *(const v4u*)(Y + (size_t)(row0 + (q >> 2) * 128 + (q & 3) * 16) * SSMW + c0); }
#pragma unroll
        for (int bj = 0; bj < 2; ++bj) { const int c0 = u.pn * 256 + bj * 128 + wc * 32 + 8 * fq;
            const f32x4 b0 = bb[bj][0], b1 = bb[bj][1];
#pragma unroll
            for (int ai = 0; ai < 2; ++ai)
#pragma unroll
                for (int m = 0; m < 4; ++m) { const size_t off = (size_t)(row0 + ai * 128 + m * 16) * SSMW + c0;
                    const v4u yy = yb2[bj][ai * 4 + m]; const f32x4 z0 = acc[ai][bj][m][0] + b0, z1 = acc[ai][bj][m][1] + b1;
#define SG(z) __builtin_amdgcn_rcpf(1.0f + __builtin_amdgcn_exp2f(-1.4426950408889634f * (z)))
                    v4u w; w.x = pg8::cvt_pk_bf16(bflo(yy.x) * SG(z0[0]), bfhi(yy.x) * SG(z0[1])); w.y = pg8::cvt_pk_bf16(bflo(yy.y) * SG(z0[2]), bfhi(yy.y) * SG(z0[3]));
                    w.z = pg8::cvt_pk_bf16(bflo(yy.z) * SG(z1[0]), bfhi(yy.z) * SG(z1[1])); w.w = pg8::cvt_pk_bf16(bflo(yy.w) * SG(z1[2]), bfhi(yy.w) * SG(z1[3]));
#undef SG
                    *(v4u*)(O + off) = w; } }
    }
};
template <bool F8 = false> struct EpiResid {
    static constexpr bool PERM = false, AFTER_DRAIN = false, FP8 = F8;
    const float* res; float* Xo; bf16* Xb; float* ssq; unsigned char* X8; int zrows;
    __device__ __forceinline__ void operator()(const f32x4 (&acc)[2][2][4][2], const Unit& u, int wr, int wc, int fr, int fq) const {
        const int row0 = (u.z * zrows + u.pm) * 256 + wr * 64 + fr, col0 = u.pn * 256 + wc * 32 + 4 * fq;
        constexpr int RB = 4;
        f32x4 rb[RB][4];
#define ER_LOAD(idx) do { const size_t off_ = (size_t)(row0 + ((idx) >> 2) * 128 + ((idx) & 3) * 16) * D + col0; _Pragma("unroll") for (int q = 0; q < 4; ++q) rb[(idx) % RB][q] = *(const f32x4*)(res + off_ + (q >> 1) * 128 + (q & 1) * 16); } while (0)
#pragma unroll
        for (int i = 0; i < RB - 1; ++i) ER_LOAD(i);
#pragma unroll
        for (int idx = 0; idx < 8; ++idx) { const int ai = idx >> 2, m = idx & 3, row = row0 + ai * 128 + m * 16; const size_t off = (size_t)row * D + col0; float s = 0.f;
            if (idx + RB - 1 < 8) ER_LOAD(idx + RB - 1);
#pragma unroll
            for (int bj = 0; bj < 2; ++bj)
#pragma unroll
                for (int n = 0; n < 2; ++n) { const size_t o2 = off + bj * 128 + n * 16; const f32x4 v = rb[idx % RB][bj * 2 + n] + acc[ai][bj][m][n] * (F8 ? W8_INV : 1.0f);
                    *(f32x4*)(Xo + o2) = v; if (Xb) { v2u w; w.x = pg8::cvt_pk_bf16(v[0], v[1]); w.y = pg8::cvt_pk_bf16(v[2], v[3]); *(v2u*)(Xb + o2) = w; }
                    if (X8) *(unsigned*)(X8 + o2) = pk4_fp8(v[0], v[1], v[2], v[3]);
                    s += (v[0] * v[0] + v[1] * v[1]) + (v[2] * v[2] + v[3] * v[3]); }
            s += __shfl_xor(s, 16); s += __shfl_xor(s, 32);
            if (fq == 0) ssq[(size_t)row * 32 + u.pn * 4 + wc] = s; }
#undef ER_LOAD
    }
};

template <bool FOLD = false> struct EpiSoftmax {
    static constexpr bool PERM = true, AFTER_DRAIN = true, FP8 = FOLD;
    bf16* Pm; const LAS float* rstd;
    __device__ __forceinline__ void fused(f32x4 (&acc)[2][2][4][2], const Unit& u, int wr, int wc, int fr, int fq, PG8_LAS unsigned char* lds, int wid, int lane) const {
        PG8_LAS float* Rm = (PG8_LAS float*)lds;
        PG8_LAS float* Rs = Rm + 1024;
        constexpr float CS = 1.4426950408889634f * 0.04419417382415922f;
        float mx[2][4];
        if constexpr (FOLD) {
#pragma unroll
            for (int ai = 0; ai < 2; ++ai)
#pragma unroll
                for (int m = 0; m < 4; ++m) { const float rs = rstd[ai * 128 + wr * 64 + m * 16 + fr];
#pragma unroll
                    for (int bj = 0; bj < 2; ++bj)
#pragma unroll
                        for (int n = 0; n < 2; ++n) acc[ai][bj][m][n] *= rs; } }
#pragma unroll
        for (int ai = 0; ai < 2; ++ai)
#pragma unroll
            for (int m = 0; m < 4; ++m) { float v = -3.0e38f;
#pragma unroll
                for (int bj = 0; bj < 2; ++bj)
#pragma unroll
                    for (int n = 0; n < 2; ++n) { const f32x4 a = acc[ai][bj][m][n]; v = fmaxf(v, fmaxf(fmaxf(a[0], a[1]), fmaxf(a[2], a[3]))); }
                v = fmaxf(v, __shfl_xor(v, 16)); v = fmaxf(v, __shfl_xor(v, 32));
                if (fq == 0) Rm[(ai * 128 + wr * 64 + m * 16 + fr) * 4 + wc] = v; }
        asm volatile("s_waitcnt lgkmcnt(0)" ::: "memory"); __builtin_amdgcn_s_barrier(); asm volatile("" ::: "memory");
#pragma unroll
        for (int ai = 0; ai < 2; ++ai)
#pragma unroll
            for (int m = 0; m < 4; ++m) { const int r = ai * 128 + wr * 64 + m * 16 + fr; const f32x4 q = *(const PG8_LAS f32x4*)(Rm + r * 4);
                const float rm = fmaxf(fmaxf(q[0], q[1]), fmaxf(q[2], q[3])) * CS; mx[ai][m] = rm; float s = 0.f;
#pragma unroll
                for (int bj = 0; bj < 2; ++bj)
#pragma unroll
                    for (int n = 0; n < 2; ++n) { f32x4 a = acc[ai][bj][m][n];
#pragma unroll
                        for (int e = 0; e < 4; ++e) { a[e] = __builtin_amdgcn_exp2f(fmaf(a[e], CS, -rm)); s += a[e]; }
                        acc[ai][bj][m][n] = a; }
                s += __shfl_xor(s, 16); s += __shfl_xor(s, 32);
                if (fq == 0) Rs[r * 4 + wc] = s; }
        asm volatile("s_waitcnt lgkmcnt(0)" ::: "memory"); __builtin_amdgcn_s_barrier(); asm volatile("" ::: "memory");
        bf16* base = FOLD ? Pm + (size_t)u.z * SEQ * (XH * MEM) + u.pn * MEM : Pm + (size_t)u.z * SEQ * MEM;
        constexpr int PLD = FOLD ? XH * MEM : MEM;
#pragma unroll
        for (int ai = 0; ai < 2; ++ai)
#pragma unroll
            for (int m = 0; m < 4; ++m) { const int r = ai * 128 + wr * 64 + m * 16 + fr; const f32x4 q = *(const PG8_LAS f32x4*)(Rs + r * 4);
                const float inv = __builtin_amdgcn_rcpf((q[0] + q[1]) + (q[2] + q[3]));
                bf16* rowp = base + (size_t)(u.pm * 256 + r) * PLD + wc * 32 + 8 * fq;
#pragma unroll
                for (int bj = 0; bj < 2; ++bj) { const f32x4 v0 = acc[ai][bj][m][0] * inv, v1 = acc[ai][bj][m][1] * inv; v4u w;
                    w.x = pg8::cvt_pk_bf16(v0[0], v0[1]); w.y = pg8::cvt_pk_bf16(v0[2], v0[3]); w.z = pg8::cvt_pk_bf16(v1[0], v1[1]); w.w = pg8::cvt_pk_bf16(v1[2], v1[3]);
                    *(v4u*)(rowp + bj * 128) = w; } }
        (void)mx;
    }
};

struct EpiVW {
    static constexpr bool PERM = true, AFTER_DRAIN = false, FP8 = true;
    bf16* O;
    __device__ __forceinline__ void operator()(const f32x4 (&acc)[2][2][4][2], const Unit& u, int wr, int wc, int fr, int fq) const {
        const int row0 = u.pm * 256 + wr * 64 + fr;
#pragma unroll
        for (int ai = 0; ai < 2; ++ai)
#pragma unroll
            for (int m = 0; m < 4; ++m) { bf16* rowp = O + ((size_t)u.pn * D + row0 + ai * 128 + m * 16) * (XH * MEM) + u.z * MEM + wc * 32 + 8 * fq;
#pragma unroll
                for (int bj = 0; bj < 2; ++bj) { const f32x4 v0 = acc[ai][bj][m][0] * W8_INV, v1 = acc[ai][bj][m][1] * W8_INV; v4u w;
                    w.x = pg8::cvt_pk_bf16(v0[0], v0[1]); w.y = pg8::cvt_pk_bf16(v0[2], v0[3]); w.z = pg8::cvt_pk_bf16(v1[0], v1[1]); w.w = pg8::cvt_pk_bf16(v1[2], v1[3]);
                    *(v4u*)(rowp + bj * 128) = w; } }
    }
};
template <bool GATHER_> struct MoeSched {
    static constexpr bool GATHER = GATHER_;
    int NB, nN, G, c, lda; const char* A; const char* B; long tA, eB, tB;
    const LAS int* blkE; const LAS int* tokTab;
    __device__ __forceinline__ bool next(int i, Unit& u) const { const int L = i * G + c; if (L >= NB * nN) return false; u.z = L / nN; u.pn = L % nN; u.pm = i; return true; }
    __device__ __forceinline__ void ptrs(const Unit& u, const char*& a, const char*& b_) const { const int e = blkE[u.z]; a = GATHER_ ? A : A + (long)u.z * tA; b_ = B + (long)e * eB + (long)u.pn * tB; }
    __device__ __forceinline__ unsigned row_off(int ui, int row) const { return (unsigned)tokTab[ui * 256 + row] * (unsigned)lda; }
    __device__ __forceinline__ bool half1(const Unit& u) const { return blkE[320 + u.z] > 128; }
    __device__ __forceinline__ void a_ready(const Unit&) const {}
    __device__ __forceinline__ void done(const Unit&) const {}
};
struct EpiMoeUp {
    static constexpr bool PERM = true, AFTER_DRAIN = false, FP8 = true;
    const LAS int* blkE; const LAS int* tokTab; const float* ssq; const float* bup; unsigned char* ACT;
    __device__ __forceinline__ void operator()(const f32x4 (&acc)[2][2][4][2], const Unit& u, int wr, int wc, int fr, int fq) const {
        asm volatile("" : "+v"(fr), "+v"(fq));
        const int e = blkE[u.z], c0 = u.pn * 128 + wc * 32 + 8 * fq, row0 = wr * 64 + fr;
        const float* bg = bup + (size_t)e * 2 * FF + c0; const f32x4 g0 = *(const f32x4*)bg, g1 = *(const f32x4*)(bg + 4), l0 = *(const f32x4*)(bg + FF), l1 = *(const f32x4*)(bg + FF + 4);
        float rsb[8];
#pragma unroll
        for (int q = 0; q < 8; ++q) rsb[q] = ssq[tokTab[u.pm * 256 + row0 + (q >> 2) * 128 + (q & 3) * 16]] * W8_INV;
#pragma unroll
        for (int ai = 0; ai < 2; ++ai)
#pragma unroll
            for (int m = 0; m < 4; ++m) { const int r = row0 + ai * 128 + m * 16; const float rs = rsb[ai * 4 + m];
                float a[8];
#pragma unroll
                for (int j = 0; j < 8; ++j) { const float gb = j < 4 ? g0[j & 3] : g1[j & 3], lb = j < 4 ? l0[j & 3] : l1[j & 3];
                    const float gl = fminf(acc[ai][0][m][j >> 2][j & 3] * rs + gb, 7.0f), ln = fminf(fmaxf(acc[ai][1][m][j >> 2][j & 3] * rs + lb, -7.0f), 7.0f);
                    a[j] = gl * __builtin_amdgcn_rcpf(1.0f + __builtin_amdgcn_exp2f(-1.702f * 1.4426950408889634f * gl)) * (ln + 1.0f); }
                v2u w; w.x = pk4_fp8(a[0], a[1], a[2], a[3]); w.y = pk4_fp8(a[4], a[5], a[6], a[7]);
                *(v2u*)(ACT + ((size_t)u.z * 256 + r) * FF + c0) = w; }
    }
};
constexpr float Y8_SCALE = 32.0f, Y8_INV = 1.0f / 32.0f;
struct EpiMoeDown {
    static constexpr bool PERM = true, AFTER_DRAIN = false, FP8 = true;
    const LAS int* blkE; const float* bdn; unsigned char* YK;
    __device__ __forceinline__ void operator()(const f32x4 (&acc)[2][2][4][2], const Unit& u, int wr, int wc, int fr, int fq) const {
        const int e = blkE[u.z], row0 = wr * 64 + fr;
        f32x4 bq[2][2];
#pragma unroll
        for (int bj = 0; bj < 2; ++bj) { const int c0 = u.pn * 256 + bj * 128 + wc * 32 + 8 * fq; bq[bj][0] = *(const f32x4*)(bdn + (size_t)e * D + c0); bq[bj][1] = *(const f32x4*)(bdn + (size_t)e * D + c0 + 4); }
#pragma unroll
        for (int bj = 0; bj < 2; ++bj) { const int c0 = u.pn * 256 + bj * 128 + wc * 32 + 8 * fq; const f32x4 b0 = bq[bj][0] * Y8_SCALE, b1 = bq[bj][1] * Y8_SCALE;
#pragma unroll
            for (int ai = 0; ai < 2; ++ai)
#pragma unroll
                for (int m = 0; m < 4; ++m) { const int r = row0 + ai * 128 + m * 16; const f32x4 v0 = acc[ai][bj][m][0] * (W8_INV * Y8_SCALE) + b0, v1 = acc[ai][bj][m][1] * (W8_INV * Y8_SCALE) + b1; v2u w;
                    w.x = pk4_fp8(v0[0], v0[1], v0[2], v0[3]); w.y = pk4_fp8(v1[0], v1[1], v1[2], v1[3]);
                    *(v2u*)(YK + ((size_t)u.z * 256 + r) * D + c0) = w; } }
    }
};
__device__ __forceinline__ int moe_block_table(const unsigned* counts, LAS int* blkE, int tid) {
    if (tid < 64) {
        const int cnt = tid < E ? (int)counts[tid * CNT_STRIDE] : 0, nb = (cnt + 255) >> 8;
        int inc = nb;
#pragma unroll
        for (int o = 1; o < 64; o <<= 1) { const int v = __shfl_up(inc, o); if (tid >= o) inc += v; }
        const int base = inc - nb;
        for (int j = 0; j < nb; ++j) { blkE[base + j] = tid; blkE[160 + base + j] = j; const int left = cnt - j * 256; blkE[320 + base + j] = left < 256 ? left : 256; }
        if (tid == 63) blkE[480] = inc;
    }
    __syncthreads();
    return blkE[480];
}

struct TItem { const float* src; bf16* dst; const float* gain; int N, ldk; };
template <bool GAIN> __device__ __forceinline__ void titem_load(const TItem& d, int lane, f32x4 (&r)[16], f32x4 (&g)[4]) {
    const int q = lane & 15, kg = lane >> 4; const float* p = d.src + (size_t)(8 * kg) * d.N + 4 * q;
#pragma unroll
    for (int j = 0; j < 16; ++j) r[j] = *(const GAS f32x4*)(p + (size_t)(32 * (j >> 3) + (j & 7)) * d.N);
    if constexpr (GAIN) {
#pragma unroll
        for (int j4 = 0; j4 < 4; ++j4) g[j4] = *(const GAS f32x4*)(d.gain + 32 * (j4 >> 1) + 8 * kg + 4 * (j4 & 1)); }
    asm volatile("" ::: "memory"); __builtin_amdgcn_sched_barrier(0);
}
template <bool GAIN> __device__ __forceinline__ void titem_store(const TItem& d, int lane, const f32x4 (&r)[16], const f32x4 (&g)[4]) {
    const int q = lane & 15, kg = lane >> 4;
    bf16* o = d.dst + (size_t)(4 * q) * d.ldk + 8 * kg;
#define TG(j) (GAIN ? g[(j) >> 2][(j) & 3] : 1.0f)
#pragma unroll
    for (int i = 0; i < 4; ++i)
#pragma unroll
        for (int h = 0; h < 2; ++h) { v4u w;
            w.x = pg8::cvt_pk_bf16(r[8 * h + 0][i] * TG(8 * h + 0), r[8 * h + 1][i] * TG(8 * h + 1)); w.y = pg8::cvt_pk_bf16(r[8 * h + 2][i] * TG(8 * h + 2), r[8 * h + 3][i] * TG(8 * h + 3));
            w.z = pg8::cvt_pk_bf16(r[8 * h + 4][i] * TG(8 * h + 4), r[8 * h + 5][i] * TG(8 * h + 5)); w.w = pg8::cvt_pk_bf16(r[8 * h + 6][i] * TG(8 * h + 6), r[8 * h + 7][i] * TG(8 * h + 7));
            *(GAS v4u*)(o + (size_t)i * d.ldk + 32 * h) = w; }
#undef TG
}
template <bool GAIN, bool NT = false> __device__ __forceinline__ void titem8_load(const TItem& d, int lane, f32x4 (&r)[16], f32x4 (&g)[4]) {
    const int q = lane & 7, kg = lane >> 3; const unsigned lo = (unsigned)((16 * kg) * d.N + 4 * q) * 4u;
    const GAS char* base = (const GAS char*)d.src;
#pragma unroll
    for (int j = 0; j < 16; ++j) { const GAS f32x4* p = (const GAS f32x4*)(base + (size_t)j * (size_t)d.N * 4 + lo); r[j] = NT ? __builtin_nontemporal_load(p) : *p; }
    if constexpr (GAIN) { const GAS char* gb = (const GAS char*)d.gain; const unsigned go = (unsigned)(16 * kg) * 4u;
#pragma unroll
        for (int j4 = 0; j4 < 4; ++j4) g[j4] = *(const GAS f32x4*)(gb + 16 * j4 + go); }
    asm volatile("" ::: "memory"); __builtin_amdgcn_sched_barrier(0);
}
template <bool GAIN, bool NT = false> __device__ __forceinline__ void titem8_store(const TItem& d, int lane, const f32x4 (&r)[16], const f32x4 (&g)[4]) {
    const int q = lane & 7, kg = lane >> 3; const unsigned lo = (unsigned)((4 * q) * d.ldk + 16 * kg);
    GAS char* base = (GAS char*)d.dst;
    f32x4 s[16];
#pragma unroll
    for (int j = 0; j < 16; ++j) s[j] = r[j] * ((GAIN ? g[j >> 2][j & 3] : 1.0f) * W8_SCALE);
#pragma unroll
    for (int i = 0; i < 4; ++i) { v4u w;
        w.x = pk4_fp8w(s[0][i], s[1][i], s[2][i], s[3][i]); w.y = pk4_fp8w(s[4][i], s[5][i], s[6][i], s[7][i]);
        w.z = pk4_fp8w(s[8][i], s[9][i], s[10][i], s[11][i]); w.w = pk4_fp8w(s[12][i], s[13][i], s[14][i], s[15][i]);
        GAS v4u* p = (GAS v4u*)(base + (size_t)i * (size_t)d.ldk + lo);
        if (NT) __builtin_nontemporal_store(w, p); else *p = w; }
}
#define TSTREAM(n_, DEC, LOAD, STORE) do { f32x4 ra[16], rb[16], ga[4], gb[4]; int it0 = gw; \
        if (it0 < (n_)) { TItem d0 = DEC(it0); LOAD(d0, lane, ra, ga); \
            for (;;) { const int it1 = it0 + NGW; \
                if (!(it1 < (n_))) { STORE(d0, lane, ra, ga); break; } \
                TItem d1 = DEC(it1); LOAD(d1, lane, rb, gb); STORE(d0, lane, ra, ga);            \
                it0 = it1 + NGW; \
                if (!(it0 < (n_))) { STORE(d1, lane, rb, gb); break; } \
                d0 = DEC(it0); LOAD(d0, lane, ra, ga); STORE(d1, lane, rb, gb); } } } while (0)

#define TI8S_NT titem8_store<false, true>
#define TI8L_NT titem8_load<false, true>
struct MoeSchedUpCv : MoeSched<true> {
    const float* wdn; unsigned char* wdn8; int wave;
    __device__ __forceinline__ TItem dec_dn(int it) const { constexpr int I_DN = (FF / 128) * (D / 32); TItem d; int r = it; const int e = r / I_DN; r -= e * I_DN;
        const int nb_ = D / 32, kb = r / nb_, nbi = r % nb_; d.src = wdn + (size_t)e * FF * D + (size_t)(128 * kb) * D + 32 * nbi; d.dst = (bf16*)(wdn8 + (size_t)e * D * FF + (size_t)(32 * nbi) * FF + 128 * kb);
        d.gain = wdn; d.N = D; d.ldk = FF; return d; }
    __device__ __forceinline__ void convert_share() const {
        const int lane = lane_id_now(), gw = c * NWAVES + wave, NGW = G * NWAVES;
        constexpr int NIT = E * (FF / 128) * (D / 32);
        TSTREAM(NIT, dec_dn, TI8L_NT, TI8S_NT);
    }
    __device__ __forceinline__ void done(const Unit& u) const { if (u.pm == (c & 7)) convert_share(); }
};

constexpr int CV_I_UP = (D / 128) * (2 * FF / 32), CV_ITEMS = E * CV_I_UP;
constexpr int CV_BATCH = 4;
struct CvWork { const float* wup; const float* gain; unsigned char* wup8; volatile LAS int* cur; volatile LAS unsigned* rel; unsigned* q; int wave; };
__device__ __forceinline__ bool cv_one(const CvWork& w) {
    if (w.wave == 0) return false;
    int it = __builtin_amdgcn_readfirstlane(w.cur[2 * w.wave]); const int end = __builtin_amdgcn_readfirstlane(w.cur[2 * w.wave + 1]);
    if (it >= end) {
        if (it > CV_ITEMS) return false;
        unsigned base = 0u; if (lane_id_now() == 0) base = __hip_atomic_fetch_add(w.q, (unsigned)CV_BATCH, __ATOMIC_RELAXED, __HIP_MEMORY_SCOPE_AGENT);
        base = __builtin_amdgcn_readfirstlane(base);
        if (base >= (unsigned)CV_ITEMS) { w.cur[2 * w.wave] = CV_ITEMS + 1; w.cur[2 * w.wave + 1] = 0; return false; }
        it = (int)base; w.cur[2 * w.wave + 1] = (int)base + CV_BATCH;
    }
    TItem d; { int r = it; const int e = r / CV_I_UP; r -= e * CV_I_UP; const int nb_ = 2 * FF / 32, kb = r / nb_, nbi = r % nb_;
        d.src = w.wup + (size_t)e * D * 2 * FF + (size_t)(128 * kb) * (2 * FF) + 32 * nbi; d.dst = (bf16*)(w.wup8 + (size_t)e * 2 * FF * D + (size_t)(32 * nbi) * D + 128 * kb);
        d.gain = w.gain + 128 * kb; d.N = 2 * FF; d.ldk = D; }
    const int lane = lane_id_now();
    f32x4 r[16], g[4]; titem8_load<true, true>(d, lane, r, g); titem8_store<true, true>(d, lane, r, g);
    w.cur[2 * w.wave] = it + 1;
    return true;
}
__device__ __forceinline__ void cv_flush(const CvWork& w) { while (cv_one(w)) {} }
__device__ __forceinline__ void xcd_barrier_cv(const XcdBarrier& b, const CvWork& w) {
    asm volatile("s_waitcnt vmcnt(0)" ::: "memory");
    const unsigned g0 = w.rel[0];
    __syncthreads();
    if (b.wave == 0) {
        xb_wave0(b, w.rel + 1, g0 + 1u);
        w.rel[0] = g0 + 1u;
    } else if (b.wave != 0) {
        unsigned guard = 0;
        while (w.rel[0] == g0) { if (w.rel[1] == g0 + 1u) { __builtin_amdgcn_s_sleep(1); continue; }
            if (!cv_one(w)) __builtin_amdgcn_s_sleep(4); if (++guard > (1u << 22)) break; }
    }
    asm volatile("s_waitcnt lgkmcnt(0)" ::: "memory"); __builtin_amdgcn_s_barrier(); asm volatile("" ::: "memory");
}

namespace mla {
typedef short s16x4 __attribute__((ext_vector_type(4)));
typedef float f32x16 __attribute__((ext_vector_type(16)));
constexpr int KVBLK = 64, QB = 256;
constexpr int SHM_V = KVBLK * 128 * 2, SHM_K = KVBLK * 128 * 2, SHM_P = KVBLK * 64 * 2;
constexpr int BUFB = SHM_V + SHM_K + SHM_P, V_OFF = 0, K_OFF = SHM_V, P_OFF = SHM_V + SHM_K, NBUF = 3, W_OFF = NBUF * BUFB;
constexpr float C2 = 1.4426950408889634f * 0.07216878364870322f;
#define KSWZ(row, colB) ((row) * 256 + ((colB) ^ (((row) & 7) << 4)))
#define KPSWZ(row, colB) ((row) * 128 + ((colB) ^ ((((row) >> 1) & 7) << 4)))
#define SBAR() __builtin_amdgcn_sched_barrier(0)
__device__ __forceinline__ int v_st(int k, int c) { const int kk = (k & ~0xC) | ((k & 4) << 1) | ((k & 8) >> 1); return ((kk >> 3) * 4 + (c >> 5)) * 512 + ((kk & 7) * 32 + (c & 31)) * 2; }
__device__ __forceinline__ int v_rd_base(int lane) { return ((lane & 3) << 3) | (((lane >> 2) & 3) << 6) | (((lane >> 4) & 1) << 5) | (((lane >> 5) & 1) << 8); }
constexpr int v_rd_off(int d0, int ks, int half) { return d0 * 512 + ks * 4096 + half * 2048; }
__device__ __forceinline__ int crow(int r, int hi) { return (r & 3) + 8 * (r >> 2) + 4 * hi; }
__device__ __forceinline__ unsigned cvtpk(float lo, float hi) { unsigned r; asm volatile("v_cvt_pk_bf16_f32 %0, %1, %2" : "=v"(r) : "v"(lo), "v"(hi)); return r; }

__device__ __forceinline__ void mask_tile(f32x16& p0, f32x16& p1, int dq) {
    const float NEG = -__builtin_inff();
#pragma unroll
    for (int r = 0; r < 16; ++r) { const int c = (r & 3) + 8 * (r >> 2);
        if (dq - c < 0) p0[r] = NEG;
        if (dq - c - 32 < 0) p1[r] = NEG; }
}
__device__ __forceinline__ void partialSM(f32x16& p0, f32x16& p1, float& m_reg, float& mn, float& alpha) {
    float pmax = p0[0];
#pragma unroll
    for (int r = 1; r < 16; ++r) pmax = fmaxf(pmax, p0[r]);
#pragma unroll
    for (int r = 0; r < 16; ++r) pmax = fmaxf(pmax, p1[r]);
    { auto rr = __builtin_amdgcn_permlane32_swap(__float_as_uint(pmax), __float_as_uint(pmax), false, false);
      pmax = fmaxf(__uint_as_float(rr[0]), __uint_as_float(rr[1])); }
    mn = fmaxf(m_reg, pmax); alpha = __builtin_amdgcn_exp2f((m_reg - mn) * C2); m_reg = mn;
    const float mnL = -mn * C2;
#pragma unroll
    for (int r = 0; r < 16; ++r) p0[r] = __builtin_amdgcn_exp2f(fmaf(p0[r], C2, mnL));
#pragma unroll
    for (int r = 0; r < 16; ++r) p1[r] = __builtin_amdgcn_exp2f(fmaf(p1[r], C2, mnL));
}
__device__ __forceinline__ void finishSM(f32x16& p0, f32x16& p1, float alpha, float& l_reg, bf16x8& pa0, bf16x8& pa1, bf16x8& pa2, bf16x8& pa3) {
    float ps = 0;
#pragma unroll
    for (int r = 0; r < 16; ++r) ps += p0[r];
#pragma unroll
    for (int r = 0; r < 16; ++r) ps += p1[r];
    { auto rr = __builtin_amdgcn_permlane32_swap(__float_as_uint(ps), __float_as_uint(ps), false, false);
      ps = __uint_as_float(rr[0]) + __uint_as_float(rr[1]); }
    l_reg = l_reg * alpha + ps;
#define PK4(P, B_, OUT) do { unsigned a0 = cvtpk(P[B_+0], P[B_+1]), a1 = cvtpk(P[B_+2], P[B_+3]);                          \
        unsigned b0 = cvtpk(P[B_+4], P[B_+5]), b1 = cvtpk(P[B_+6], P[B_+7]);                                             \
        auto r0 = __builtin_amdgcn_permlane32_swap(a0, b0, false, false); auto r1 = __builtin_amdgcn_permlane32_swap(a1, b1, false, false); \
        v4u w = {r0[0], r1[0], r0[1], r1[1]}; OUT = *reinterpret_cast<bf16x8*>(&w); } while (0)
    PK4(p0, 0, pa0); PK4(p0, 8, pa1); PK4(p1, 0, pa2); PK4(p1, 8, pa3);
#undef PK4
}
__device__ __forceinline__ void qkt(f32x16& p0, f32x16& p1, LAS unsigned char* lds  , int r32, int hi, const bf16x8* qr) {
    p0 = f32x16{}; p1 = f32x16{};
    const LAS unsigned char* kb[4];
#pragma unroll
    for (int dd = 0; dd < 4; ++dd) kb[dd] = lds + K_OFF + KSWZ(r32, (dd * 16 + hi * 8) * 2);
#pragma unroll
    for (int d0 = 0; d0 < 8; ++d0) { const LAS unsigned char* a = kb[d0 & 3] + (d0 >> 2) * 128;
        const bf16x8 b0 = *(const LAS bf16x8*)(a);
        const bf16x8 b1 = *(const LAS bf16x8*)(a + 32 * 256);
        p0 = __builtin_amdgcn_mfma_f32_32x32x16_bf16(b0, qr[d0], p0, 0, 0, 0);
        p1 = __builtin_amdgcn_mfma_f32_32x32x16_bf16(b1, qr[d0], p1, 0, 0, 0); }
#pragma unroll
    for (int e = 0; e < 4; ++e) { const LAS unsigned char* a = lds + P_OFF + KPSWZ(r32, (e * 2 + hi) * 16);
        const bf16x8 b0 = *(const LAS bf16x8*)(a);
        const bf16x8 b1 = *(const LAS bf16x8*)(a + 32 * 128);
        p0 = __builtin_amdgcn_mfma_f32_32x32x16_bf16(b0, qr[8 + e], p0, 0, 0, 0);
        p1 = __builtin_amdgcn_mfma_f32_32x32x16_bf16(b1, qr[8 + e], p1, 0, 0, 0); }
}
__device__ __forceinline__ void pv_tile(f32x16* o, int vb0  , bf16x8 pa0, bf16x8 pa1, bf16x8 pa2, bf16x8 pa3) {
#define TRRD(dst, off) asm volatile("ds_read_b64_tr_b16 %0, %1 offset:%2" : "=&v"(dst) : "v"(vb0), "i"(off) : "memory")
#define PV_D0(d0) do { s16x4 l0, l1, l2, l3, h0, h1, h2, h3; constexpr int b_ = V_OFF + v_rd_off(d0, 0, 0); \
        TRRD(l0, b_); TRRD(h0, b_ + 2048); TRRD(l1, b_ + 4096); TRRD(h1, b_ + 6144); TRRD(l2, b_ + 8192); TRRD(h2, b_ + 10240); TRRD(l3, b_ + 12288); TRRD(h3, b_ + 14336); \
        asm volatile("s_waitcnt lgkmcnt(0)" ::: "memory"); SBAR();   \
        o[d0] = __builtin_amdgcn_mfma_f32_32x32x16_bf16(pa0, (bf16x8){l0[0], l0[1], l0[2], l0[3], h0[0], h0[1], h0[2], h0[3]}, o[d0], 0, 0, 0);   \
        o[d0] = __builtin_amdgcn_mfma_f32_32x32x16_bf16(pa1, (bf16x8){l1[0], l1[1], l1[2], l1[3], h1[0], h1[1], h1[2], h1[3]}, o[d0], 0, 0, 0);   \
        o[d0] = __builtin_amdgcn_mfma_f32_32x32x16_bf16(pa2, (bf16x8){l2[0], l2[1], l2[2], l2[3], h2[0], h2[1], h2[2], h2[3]}, o[d0], 0, 0, 0);   \
        o[d0] = __builtin_amdgcn_mfma_f32_32x32x16_bf16(pa3, (bf16x8){l3[0], l3[1], l3[2], l3[3], h3[0], h3[1], h3[2], h3[3]}, o[d0], 0, 0, 0); } while (0)
    PV_D0(0); PV_D0(1); PV_D0(2); PV_D0(3);
#undef PV_D0
#undef TRRD
}

__device__ __forceinline__ void attn_unit(LAS unsigned char* lds, int b, int h, int qb, const bf16* Q  , const bf16* KV  , const bf16* KPE  ,
                                          const float* ROPE  , bf16* O  , const int wave_) {
    int tid_ = wave_ * 64 + lane_id_now(); asm volatile("" : "+v"(tid_));
    const int tid = tid_, wid = __builtin_amdgcn_readfirstlane(tid >> 6), lane = tid & 63, r32 = lane & 31, hi = lane >> 5;
    const int NT = ((15 - qb) * 128 + 128) / KVBLK;
    const int qlo = (wid < 4 ? qb * 128 + wid * 32 : (15 - qb) * 128 + (wid - 4) * 32), qm = qlo + r32 - 4 * hi;
    const size_t tok0 = (size_t)b * SEQ;
    bf16x8 qr[12];
    { const size_t t = tok0 + qlo + r32; const bf16* qp = Q + t * 1536 + h * 192 + hi * 8;
#pragma unroll
      for (int d0 = 0; d0 < 12; ++d0) qr[d0] = *(const bf16x8*)(qp + d0 * 16);
      const float* rp = ROPE + t * 64 + hi * 8;
#pragma unroll
      for (int e = 0; e < 2; ++e) {
          const f32x4 c0 = *(const f32x4*)(rp + 16 * e), c1 = *(const f32x4*)(rp + 16 * e + 4), s0 = *(const f32x4*)(rp + 32 + 16 * e), s1 = *(const f32x4*)(rp + 32 + 16 * e + 4);
          const v4u xa = *reinterpret_cast<v4u*>(&qr[8 + e]), xb = *reinterpret_cast<v4u*>(&qr[10 + e]); v4u ya, yb;
#define ROPE2(W, CL, CH, SL, SH) { const float a0 = bflo(xa.W), a1 = bfhi(xa.W), b0 = bflo(xb.W), b1 = bfhi(xb.W); \
          ya.W = cvtpk(a0 * CL - b0 * SL, a1 * CH - b1 * SH); yb.W = cvtpk(b0 * CL + a0 * SL, b1 * CH + a1 * SH); }
          ROPE2(x, c0[0], c0[1], s0[0], s0[1]); ROPE2(y, c0[2], c0[3], s0[2], s0[3]); ROPE2(z, c1[0], c1[1], s1[0], s1[1]); ROPE2(w, c1[2], c1[3], s1[2], s1[3]);
#undef ROPE2
          qr[8 + e] = *reinterpret_cast<bf16x8*>(&ya); qr[10 + e] = *reinterpret_cast<bf16x8*>(&yb); } }
    const int vb0 = (int)(uintptr_t)(lds) + v_rd_base(lane);
    LAS float* wsf = (LAS float*)(lds + W_OFF) + wid * 64; LAS float* li_l = wsf; LAS float* al_l = wsf + 32;
    unsigned so[5];
#pragma unroll
    for (int p = 0; p < 2; ++p) { const int s = p * 512 + tid;
        { const int sub = s >> 5, within = s & 31, kk = (sub >> 2) * 8 + (within >> 2), k = (kk & ~0xC) | ((kk & 4) << 1) | ((kk & 8) >> 1), c = (sub & 3) * 32 + (within & 3) * 8;
          so[p] = (unsigned)(k * 2048 + h * 256 + 128 + c); }
        { const int row = s >> 4, chunk = (s & 15) ^ (row & 7); so[2 + p] = (unsigned)(row * 2048 + h * 256 + chunk * 8); } }
    { const int row = tid >> 3, chunk = (tid & 7) ^ ((row >> 1) & 7); so[4] = (unsigned)(row * 64 + chunk * 8); }
    const bf16* KVt = KV + tok0 * 2048; const bf16* KPt = KPE + tok0 * 64;
#define AISSUE(tile, bufoff) do { const bf16* kv_ = KVt + (size_t)(tile) * (KVBLK * 2048); const bf16* kp_ = KPt + (size_t)(tile) * (KVBLK * 64); \
        __builtin_amdgcn_global_load_lds((const unsigned*)(kv_ + so[0]), (LAS unsigned*)(lds + (bufoff) + V_OFF + wid * 1024), 16, 0, 0); \
        __builtin_amdgcn_global_load_lds((const unsigned*)(kv_ + so[1]), (LAS unsigned*)(lds + (bufoff) + V_OFF + 8192 + wid * 1024), 16, 0, 0); \
        __builtin_amdgcn_global_load_lds((const unsigned*)(kv_ + so[2]), (LAS unsigned*)(lds + (bufoff) + K_OFF + wid * 1024), 16, 0, 0); \
        __builtin_amdgcn_global_load_lds((const unsigned*)(kv_ + so[3]), (LAS unsigned*)(lds + (bufoff) + K_OFF + 8192 + wid * 1024), 16, 0, 0); \
        __builtin_amdgcn_global_load_lds((const unsigned*)(kp_ + so[4]), (LAS unsigned*)(lds + (bufoff) + P_OFF + wid * 1024), 16, 0, 0); } while (0)
    float m_reg = -1e30f, l_reg = 0.f; f32x16 o[4] = {};
    f32x16 p0, p1; float mn, alpha; bf16x8 pa0, pa1, pa2, pa3;
    asm volatile("s_waitcnt vmcnt(0)" ::: "memory");
    AISSUE(0, 0); AISSUE(1, BUFB);
    int bc = 0, bl = 2 * BUFB;
    for (int t = 0; t < NT; ++t) {
        asm volatile("s_waitcnt vmcnt(5)" ::: "memory"); __builtin_amdgcn_s_barrier();
        { const int tn = (t + 2 < NT) ? t + 2 : NT - 1; AISSUE(tn, bl); }
        const int kb_ = t * KVBLK;
        if (kb_ <= qlo + 31) {
            SBAR(); qkt(p0, p1, lds + bc, r32, hi, qr);
            if (kb_ + KVBLK - 1 > qlo) mask_tile(p0, p1, qm - kb_);
            partialSM(p0, p1, m_reg, mn, alpha);
            if (__any(alpha < 1.f)) { if (hi == 0) al_l[r32] = alpha; LDS_WAIT();
#pragma unroll
                for (int d_ = 0; d_ < 4; ++d_)
#pragma unroll
                    for (int r = 0; r < 16; ++r) o[d_][r] *= al_l[crow(r, hi)]; }
            finishSM(p0, p1, alpha, l_reg, pa0, pa1, pa2, pa3); SBAR();
            pv_tile(o, vb0 + bc, pa0, pa1, pa2, pa3); }
        bc = (bc == 2 * BUFB) ? 0 : bc + BUFB; bl = (bl == 2 * BUFB) ? 0 : bl + BUFB;
    }
#undef AISSUE
    asm volatile("s_waitcnt vmcnt(0)" ::: "memory");
    if (hi == 0) li_l[r32] = l_reg; LDS_WAIT();
    bf16* Ow = O + (tok0 + qlo) * 1024 + h * 128;
#pragma unroll
    for (int r = 0; r < 16; ++r) { const int orow = crow(r, hi); const float rl = __builtin_amdgcn_rcpf(li_l[orow]);
#pragma unroll
        for (int d0 = 0; d0 < 4; ++d0) { const float v = o[d0][r] * rl; const float vn = __shfl_xor(v, 1);
            if ((r32 & 1) == 0) *(unsigned*)(Ow + (size_t)orow * 1024 + d0 * 32 + r32) = cvtpk(v, vn); } }
    __syncthreads();
}
#undef KSWZ
#undef KPSWZ
#undef SBAR
}

struct Args { const void* in[36]; float* out; unsigned char* ws; int ph_lo, ph_hi, li, pad; };
constexpr int N_PHASES = 15;

__device__ __forceinline__ void mla_thin_token(int t, int lane, const bf16* projb, const float* qg, const float* kvg, const int* pos, bf16* cqn, bf16* ckvn, bf16* kpe, float* rope) {
    const unsigned* pr = (const unsigned*)(projb + (size_t)t * PJW);
    unsigned wq[3], wk[2]; float sq = 0.f, sk = 0.f;
    v2f gq[3], gk[2];
#pragma unroll
    for (int j = 0; j < 3; ++j) { wq[j] = pr[lane + 64 * j]; gq[j] = *(const v2f*)(qg + 2 * (lane + 64 * j)); }
#pragma unroll
    for (int j = 0; j < 2; ++j) { wk[j] = pr[192 + lane + 64 * j]; gk[j] = *(const v2f*)(kvg + 2 * (lane + 64 * j)); }
    const int pos_t = pos[t]; const bf16* kp = projb + (size_t)t * PJW + 640; const float x1 = bf2f(kp[lane & 31]), x2 = bf2f(kp[(lane & 31) + 32]);
#pragma unroll
    for (int j = 0; j < 3; ++j) { const float a = bflo(wq[j]), b = bfhi(wq[j]); sq += a * a + b * b; }
#pragma unroll
    for (int j = 0; j < 2; ++j) { const float a = bflo(wk[j]), b = bfhi(wk[j]); sk += a * a + b * b; }
    const float rq = rsqrtf(wave_sum(sq) * (1.f / QL) + EPS), rk = rsqrtf(wave_sum(sk) * (1.f / KVL) + EPS);
#pragma unroll
    for (int j = 0; j < 3; ++j) ((unsigned*)(cqn + (size_t)t * QL))[lane + 64 * j] = pk2(bflo(wq[j]) * rq * gq[j][0], bfhi(wq[j]) * rq * gq[j][1]);
#pragma unroll
    for (int j = 0; j < 2; ++j) ((unsigned*)(ckvn + (size_t)t * KVL))[lane + 64 * j] = pk2(bflo(wk[j]) * rk * gk[j][0], bfhi(wk[j]) * rk * gk[j][1]);
    if (lane < 32) {
        const float inv = 1.0f / powf(10000.0f, (float)(2 * lane) / 64.0f), ang = (float)pos_t * inv, c = cosf(ang), s = sinf(ang);
        rope[(size_t)t * 64 + lane] = c; rope[(size_t)t * 64 + 32 + lane] = s;
        kpe[(size_t)t * 64 + lane] = (bf16)f2bf(x1 * c - x2 * s); kpe[(size_t)t * 64 + 32 + lane] = (bf16)f2bf(x2 * c + x1 * s);
    }
}
__device__ __forceinline__ void s5_scan_group(int g, LAS unsigned char* lds, const float* Sc, const float* AP32, bf16* Ag, int tid) {
    LAS f32x4* S4 = (LAS f32x4*)lds;
    const GAS f32x4* src = (const GAS f32x4*)(Sc + (size_t)g * 256 * 128);
#pragma unroll 16
    for (int i = tid; i < 256 * 32; i += NTHR) S4[i] = src[i];
    __syncthreads();
    if (tid < 256) { const int b = tid >> 6, p = tid & 63; const float ar = AP32[(g * 64 + p) * 2], ai = AP32[(g * 64 + p) * 2 + 1]; float xr = 0.f, xi = 0.f;
        const LAS float* S = (const LAS float*)lds;
        for (int ch = 0; ch < NCH; ++ch) { const int row = b * NCH + ch; bf16* o = Ag + ((size_t)g * 256 + row) * AGW + 512;
            o[p] = (bf16)f2bf(xr); o[64 + p] = (bf16)f2bf(xi);
            const float sr = S[row * 128 + p], si = S[row * 128 + 64 + p];
            const float nr = ar * xr - ai * xi + sr, ni = ar * xi + ai * xr + si; xr = nr; xi = ni; } }
    VM_WAIT(); __syncthreads();
}

__device__ __forceinline__ void route_tile(int tile, LAS unsigned char* lds, const float* X2, const float* ssq2, float* rstd2, const bf16* WRH, const bf16* WRL, const float* brt,
                                           unsigned* counts, int* SELE, int* SELP, float* SELG, int* LIST, int tid) {
    typedef float f32x16 __attribute__((ext_vector_type(16)));
    const int wid = tid >> 6, lane = tid & 63, r32 = lane & 31, hi = lane >> 5, t0 = tile * 32;
    f32x16 acc = {};
    const float* xp = X2 + (size_t)(t0 + r32) * D + wid * 256 + hi * 8;
    const bf16* wh = WRH + (size_t)r32 * D + wid * 256 + hi * 8; const bf16* wl = WRL + (size_t)r32 * D + wid * 256 + hi * 8;
#pragma unroll 4
    for (int s = 0; s < 16; ++s) {
        const f32x4 a = *(const f32x4*)(xp + 16 * s), b = *(const f32x4*)(xp + 16 * s + 4);
        float xv[8] = {a[0], a[1], a[2], a[3], b[0], b[1], b[2], b[3]}; unsigned hh[8], ll[8];
#pragma unroll
        for (int j = 0; j < 8; ++j) { hh[j] = f2bf(xv[j]); ll[j] = f2bf(xv[j] - __builtin_bit_cast(float, hh[j] << 16)); }
        v4u ph = {hh[0] | (hh[1] << 16), hh[2] | (hh[3] << 16), hh[4] | (hh[5] << 16), hh[6] | (hh[7] << 16)}, pl = {ll[0] | (ll[1] << 16), ll[2] | (ll[3] << 16), ll[4] | (ll[5] << 16), ll[6] | (ll[7] << 16)};
        const bf16x8 xh = *reinterpret_cast<bf16x8*>(&ph), xl = *reinterpret_cast<bf16x8*>(&pl);
        const bf16x8 bh = *(const bf16x8*)(wh + 16 * s), bl = *(const bf16x8*)(wl + 16 * s);
        acc = __builtin_amdgcn_mfma_f32_32x32x16_bf16(xh, bh, acc, 0, 0, 0);
        acc = __builtin_amdgcn_mfma_f32_32x32x16_bf16(xl, bh, acc, 0, 0, 0);
        acc = __builtin_amdgcn_mfma_f32_32x32x16_bf16(xh, bl, acc, 0, 0, 0);
    }
    LAS float* red = (LAS float*)lds;
    LAS float* lg = red + 8 * 32 * 33;
#pragma unroll
    for (int r = 0; r < 16; ++r) red[(wid * 32 + ((r & 3) + 8 * (r >> 2) + 4 * hi)) * 33 + r32] = acc[r];
    __syncthreads();
    for (int idx = tid; idx < 1024; idx += NTHR) { const int tk = idx >> 5, e = idx & 31; float s = 0.f;
#pragma unroll
        for (int w = 0; w < 8; ++w) s += red[(w * 32 + tk) * 33 + e];
        lg[tk * 33 + e] = s; }
    __syncthreads();
    if (tid < 32) { const int t = t0 + tid; float sq = 0.f;
#pragma unroll
        for (int k = 0; k < 8; ++k) { const f32x4 v = *(const f32x4*)(ssq2 + (size_t)t * 32 + 4 * k); sq += v[0]; sq += v[1]; sq += v[2]; sq += v[3]; }
        const float rs = rsqrtf(sq * (1.f / D) + EPS); rstd2[t] = rs;
        float l[E];
#pragma unroll
        for (int e = 0; e < E; ++e) l[e] = lg[tid * 33 + e] * rs + brt[e];
        float tv[TOPK]; int ti[TOPK];
#pragma unroll
        for (int k = 0; k < TOPK; ++k) { float best = -INFINITY; int bi = 0;
#pragma unroll
            for (int e = 0; e < E; ++e) if (l[e] > best) { best = l[e]; bi = e; }
            tv[k] = best; ti[k] = bi;
#pragma unroll
            for (int e = 0; e < E; ++e) if (e == bi) l[e] = -INFINITY; }
        float sum = 0.f, ex[TOPK];
#pragma unroll
        for (int k = 0; k < TOPK; ++k) { ex[k] = expf(tv[k] - tv[0]); sum += ex[k]; }
        LAS unsigned* lcnt = (LAS unsigned*)(lg + 32 * 33); LAS unsigned* lbase = lcnt + 32;
        lcnt[tid] = 0u; LDS_WAIT();
        int lp[TOPK];
#pragma unroll
        for (int k = 0; k < TOPK; ++k) lp[k] = (int)__hip_atomic_fetch_add(&lcnt[ti[k]], 1u, __ATOMIC_RELAXED, __HIP_MEMORY_SCOPE_WORKGROUP);
        LDS_WAIT();
        { const unsigned n = lcnt[tid]; lbase[tid] = n ? atomicAdd(&counts[tid * CNT_STRIDE], n) : 0u; }
        LDS_WAIT();
#pragma unroll
        for (int k = 0; k < TOPK; ++k) { const int pos = (int)lbase[ti[k]] + lp[k];
            SELE[t * TOPK + k] = ti[k]; SELP[t * TOPK + k] = pos; SELG[t * TOPK + k] = ex[k] / sum; LIST[(size_t)ti[k] * T + pos] = t; } }
    __syncthreads();
}

__global__ void __launch_bounds__(NTHR, 2) fwd(Args args) {
    extern __shared__ __attribute__((aligned(16))) unsigned char lds_raw[];
    LAS unsigned char* lds = (LAS unsigned char*)lds_raw;
    volatile LAS unsigned* MISC = (volatile LAS unsigned*)(lds + MISC_OFF);
    int wave_ = __builtin_amdgcn_readfirstlane((int)threadIdx.x >> 6); asm volatile("" : "+s"(wave_));
    const int wave = wave_;
#define LANE_NOW() ({ int l_ = lane_id_now(); asm volatile("" : "+v"(l_)); l_; })
    const int NG = gridDim.x, bx = blockIdx.x;
    unsigned char* ws = args.ws;
    unsigned* ctl = (unsigned*)(ws + WS_CTL);
    { const int tid = wave * 64 + LANE_NOW();
      for (int u = tid; u < (LDS_BYTES - LDSCTL_OFF) / 4; u += NTHR) ((LAS unsigned*)(lds + LDSCTL_OFF))[u] = 0u; }
    __syncthreads();
    const int lo = args.ph_lo, hi = args.ph_hi;
    const bool multi = (hi - lo) > 1;
    XcdBarrier bar; bar.bar = ctl + CW_BAR + args.li * XCD_BAR_WORDS; bar.x = 0; bar.st = nullptr; bar.wave = wave;
    if (multi) bar = xcd_barrier_post(ctl + CW_BAR + args.li * XCD_BAR_WORDS, MISC + 8, wave);
#define IN(k) (lo <= (k) && (k) < hi)
#define BOTH(k) (IN(k) && IN((k) + 1))
#define GRID_BAR() xcd_barrier(bar)
#define GRID_BAR_CV() xcd_barrier_cv(bar, cvw)
#if defined(PROBE_PHASE) || defined(PROBE_RANGE)
#define PRB(p, T_) ((args.li == 1) ? (T_)(ws + WS_END1 + (8u << 20)) : (T_)(p))
#else
#define PRB(p, T_) ((T_)(p))
#endif
#define INP(i) ((const float*)args.in[i])
#define WSP(T_, off) ((T_*)(ws + (off)))
    const CvWork cvw{INP(31), INP(28), WSP(unsigned char, WS_WUP), (volatile LAS int*)(MISC + 16), MISC + 12, ctl + CW_CVQ, wave};
    if (IN(0)) {
        const int lane = LANE_NOW(), tid = wave * 64 + lane; (void)tid; (void)lane;
        const int gw = bx * NWAVES + wave, NGW = NG * NWAVES;
        constexpr int I_IN = (D / 64) * (INC / 64), I_QB = (QL / 64) * (1536 / 64), I_KVB = (KVL / 64) * (2048 / 64), I_GLU = (SSMW / 64) * (SSMW / 64), I_SQ = (D / 64) * (D / 64);
        constexpr int I_UP = (D / 64) * (2 * FF / 64), I_DN = (FF / 64) * (D / 64);
#define TI_MAT(W_, K_, N_, WT_, G_) { const int nb_ = (N_) / 64, kb = r / nb_, nbi = r % nb_; d.src = (W_) + (size_t)(64 * kb) * (N_) + 64 * nbi; d.dst = (WT_) + (size_t)(64 * nbi) * (K_) + 64 * kb; \
            d.gain = (G_) + 64 * kb; d.N = (N_); d.ldk = (K_); }
#define TI_MAT8(W_, K_, N_, WT_, G_) { const int nb_ = (N_) / 32, kb = r / nb_, nbi = r % nb_; d.src = (W_) + (size_t)(128 * kb) * (N_) + 32 * nbi; d.dst = (bf16*)((unsigned char*)(WT_) + (size_t)(32 * nbi) * (K_) + 128 * kb); \
            d.gain = (G_) + 128 * kb; d.N = (N_); d.ldk = (K_); }
        auto dec_up = [&](int it) { TItem d; int r = it; const int e = r / I_UP; r -= e * I_UP; TI_MAT8(INP(31) + (size_t)e * D * 2 * FF, D, 2 * FF, WSP(unsigned char, WS_WUP) + (size_t)e * 2 * FF * D, INP(28)); return d; };
        auto dec_dn = [&](int it) { TItem d; int r = it; const int e = r / I_DN; r -= e * I_DN; TI_MAT8(INP(33) + (size_t)e * FF * D, FF, D, WSP(unsigned char, WS_WDN) + (size_t)e * D * FF, INP(28)); return d; };
        auto dec_xq = [&](int it) { TItem d; int r = it; TI_MAT8(INP(24), D, D, WSP(unsigned char, WS_WXQ8), INP(22)); return d; };
        auto dec_xo = [&](int it) { TItem d; int r = it; TI_MAT8(INP(27), D, D, WSP(unsigned char, WS_WXO8), INP(22)); return d; };
        auto dec_16 = [&](int it) { TItem d; int r = it;
            if (r < I_IN) { TI_MAT(INP(4), D, INC, WSP(bf16, WS_WIN), INP(22)); return d; } r -= I_IN;
            if (r < I_QB) { TI_MAT(INP(6), QL, 1536, WSP(bf16, WS_WQB), INP(22)); return d; } r -= I_QB;
            if (r < I_KVB) { TI_MAT(INP(8), KVL, 2048, WSP(bf16, WS_WKVB), INP(22)); return d; } r -= I_KVB;
            if (r < I_GLU) { TI_MAT(INP(17), SSMW, SSMW, WSP(bf16, WS_WGLU), INP(22)); return d; } r -= I_GLU;
            if (r < I_SQ) { TI_MAT(INP(25), D, D, WSP(bf16, WS_WXK), INP(22)); return d; } r -= I_SQ;
            if (r < I_SQ) { TI_MAT(INP(26), D, D, WSP(bf16, WS_WXV), INP(22)); return d; } r -= I_SQ;
            TI_MAT(INP(21), D, D, WSP(bf16, WS_WOUT), INP(22)); return d; };
#undef TI_MAT
#undef TI_MAT8
        if (bx < G) { s5_setup(bx, lds, INP(9), INP(10), INP(11), INP(12), INP(13), INP(14), INP(15), WSP(bf16, WS_BTY), WSP(bf16, WS_BTS), WSP(float, WS_AP32), tid); }
        else {
            const int gw = (bx - G) * NWAVES + wave, NGW = (NG - G) * NWAVES, gt = (bx - G) * NTHR + tid, NGT = (NG - G) * NTHR;
            for (int i = gt; i < D * D / 4; i += NGT) { const int row = (i * 4) / D; const f32x4 w = ((const GAS f32x4*)INP(24))[i]; const float g = INP(22)[row]; v2u o; o.x = pk2(w.x * g, w.y * g); o.y = pk2(w.z * g, w.w * g);
                ((GAS v2u*)WSP(bf16, WS_WXQN))[i] = o; }
            TSTREAM(I_SQ, dec_xo, titem8_load<false>, titem8_store<false>);
            TSTREAM(I_IN + I_QB + I_KVB + I_GLU + 3 * I_SQ, dec_16, titem_load<false>, titem_store<false>);
            for (int i = gt; i < E * D; i += NGT) { const int e = i / D, k = i % D; const float w = INP(29)[(size_t)k * E + e] * INP(28)[k]; const unsigned h = f2bf(w);
                WSP(bf16, WS_WRH)[i] = (bf16)h; WSP(bf16, WS_WRL)[i] = (bf16)f2bf(w - __builtin_bit_cast(float, h << 16)); }
            for (int i = gt; i < (INCP - INC) * D / 8; i += NGT) ((GAS v4u*)(WSP(bf16, WS_WIN) + (size_t)INC * D))[i] = (v4u){0u, 0u, 0u, 0u};
            for (int m = gw; m < T; m += NGW) rms_row_to_bf16(INP(0) + (size_t)m * D, INP(3), WSP(bf16, WS_HB) + (size_t)m * D, lane);
            for (int m = gw; m < TM; m += NGW) rms_row_to_bf16(INP(1) + (size_t)m * D, INP(23), WSP(bf16, WS_MEMN) + (size_t)m * D, lane);
        }
        if (BOTH(0)) GRID_BAR_CV();
    }
    if (IN(1)) {
        const int lane = LANE_NOW(), tid = wave * 64 + lane; (void)tid; (void)lane;
        { pg8::Geo geo{D * 2, D * 2, 128L * D * 2, 128L * D * 2, D / 64};
          pg8::Sched S; S.init(0, T / 256, INCP / 256, 1, NG, bx, WSP(bf16, WS_HB), 256L * D * 2, 0, WSP(bf16, WS_WIN), 256L * D * 2, 0);
          EpiProj Ep{WSP(bf16, WS_PROJB), WSP(bf16, WS_AG)};
          pg8::gemm_phase<EpiProj, pg8::Sched, true, true>(lds + RING_OFF, geo, S, Ep, wave); }
        { pg8::Geo geo{D * 2, D * 2, 128L * D * 2, 128L * D * 2, D / 64};
          const int c = (bx >= 224) ? bx - 224 : (1 << 30);
          pg8::Sched S; S.init(1, TM / 256, D / 256, 1, 32, c, WSP(bf16, WS_MEMN), 256L * D * 2, 0, WSP(bf16, WS_WXK), 256L * D * 2, 0);
          EpiPlain<false> Ep{WSP(bf16, WS_XK), D, 1, 0, 0, nullptr};
          pg8::gemm_phase<EpiPlain<false>, pg8::Sched, true, true>(lds + RING_OFF, geo, S, Ep, wave); }
        if (BOTH(1)) GRID_BAR_CV();
    }
    if (IN(2)) {
        const int lane = LANE_NOW(), tid = wave * 64 + lane; (void)tid; (void)lane;
        { const int gw = bx * NWAVES + wave, NGW = NG * NWAVES;
          for (int t = gw; t < T; t += NGW) mla_thin_token(t, lane, WSP(bf16, WS_PROJB), INP(5), INP(7), ((const int*)args.in[2]), WSP(bf16, WS_CQN), WSP(bf16, WS_CKVN), WSP(bf16, WS_KPE), WSP(float, WS_ROPE)); }
        __syncthreads();
        { pg8::Geo geo{AGW * 2, 512 * 2, 128L * AGW * 2, 0, 512 / 64};
          pg8::Sched S; S.init(1, 1, 1, G, NG, bx, WSP(bf16, WS_AG), 0, 256L * AGW * 2, WSP(bf16, WS_BTS), 0, 128L * 512 * 2);
          EpiS5State Ep{WSP(float, WS_SC)};
          pg8::gemm_phase<EpiS5State, pg8::Sched, true, true>(lds + RING_OFF, geo, S, Ep, wave); }
        { pg8::Geo geo{D * 2, D * 2, 128L * D * 2, 128L * D * 2, D / 64};
          const int c = (bx >= 64 && bx < 96) ? bx - 64 : (1 << 30);
          pg8::Sched S; S.init(1, TM / 256, D / 256, 1, 32, c, WSP(bf16, WS_MEMN), 256L * D * 2, 0, WSP(bf16, WS_WXV), 256L * D * 2, 0);
          EpiPlain<false, false, true> Ep{(bf16*)WSP(unsigned char, WS_XV8), D, 1, 0, 0, nullptr};
          pg8::gemm_phase<EpiPlain<false, false, true>, pg8::Sched, true, true>(lds + RING_OFF, geo, S, Ep, wave); }
        if (BOTH(2)) GRID_BAR_CV();
    }
    if (IN(3)) {
        const int lane = LANE_NOW(), tid = wave * 64 + lane; (void)tid; (void)lane;
        if (bx < 128) {
            s5_scan_group(bx >> 1, lds, WSP(float, WS_SC), WSP(float, WS_AP32), WSP(bf16, WS_AG), tid);
            pg8::Geo geo{AGW * 2, AGW * 2, 128L * AGW * 2, 128L * AGW * 2, AGW / 64};
            pg8::Sched S; S.init(1, 1, 2, G, 128, bx, WSP(bf16, WS_AG), 0, 256L * AGW * 2, WSP(bf16, WS_BTY), 256L * AGW * 2, 512L * AGW * 2);
            EpiS5Y Ep{WSP(bf16, WS_AG), INP(16), WSP(bf16, WS_Y)};
            pg8::gemm_phase<EpiS5Y, pg8::Sched, true, true>(lds + RING_OFF, geo, S, Ep, wave);
        }
        { pg8::Geo geo{KVL * 2, KVL * 2, 128L * KVL * 2, 128L * KVL * 2, KVL / 64};
          pg8::Sched S; S.init(0, T / 256, 2048 / 256, 1, NG, bx, WSP(bf16, WS_CKVN), 256L * KVL * 2, 0, WSP(bf16, WS_WKVB), 256L * KVL * 2, 0);
          EpiPlain<false> Ep{WSP(bf16, WS_KV), 2048, 1, 0, 0, nullptr};
          pg8::gemm_phase<EpiPlain<false>, pg8::Sched, true, true>(lds + RING_OFF, geo, S, Ep, wave); }
        { pg8::Geo geo{QL * 2, QL * 2, 128L * QL * 2, 128L * QL * 2, QL / 64};
          const int c = (bx >= 128) ? bx - 128 : (1 << 30);
          pg8::Sched S; S.init(0, T / 256, 1536 / 256, 1, 128, c, WSP(bf16, WS_CQN), 256L * QL * 2, 0, WSP(bf16, WS_WQB), 256L * QL * 2, 0);
          EpiPlain<false> Ep{WSP(bf16, WS_Q), 1536, 1, 0, 0, nullptr};
          pg8::gemm_phase<EpiPlain<false>, pg8::Sched, true, true>(lds + RING_OFF, geo, S, Ep, wave); }
        { pg8::Geo geo{D * 2, D * 2, 128L * D * 2, 128L * D * 2, XD / 64};
          const int c = (bx >= 128) ? bx - 128 : (1 << 30);
          pg8::Sched S; S.init(1, 1, D / 256, BATCH * XH, 128, c, WSP(bf16, WS_XK), 0, (long)MEM * D * 2, WSP(bf16, WS_WXQN), 256L * D * 2, 0);
          S.split_z(XH, XD * 2, XD * 2);
          EpiPlain<false, false, true> Ep{(bf16*)WSP(unsigned char, WS_WKT8), D, 1, 256L * D, 0, nullptr};
          pg8::gemm_phase<EpiPlain<false, false, true>, pg8::Sched, true, true>(lds + RING_OFF, geo, S, Ep, wave); }
        if (BOTH(3)) GRID_BAR_CV();
    }
    if (IN(4)) {
        const int lane = LANE_NOW(), tid = wave * 64 + lane; (void)tid; (void)lane;
        const int vcu = (NG % 8 == 0) ? (bx % 8) * (NG / 8) + bx / 8 : bx;
        if (vcu < BATCH * H * 8) { const int L = vcu, bh = L >> 3, qb = L & 7;
            mla::attn_unit(lds + RING_OFF, bh >> 3, bh & 7, qb, WSP(bf16, WS_Q), WSP(bf16, WS_KV), WSP(bf16, WS_KPE), WSP(float, WS_ROPE), WSP(bf16, WS_ATTO), wave); }
        { const int qb = vcu & 7, c = (vcu < 256 && qb >= 4) ? (vcu >> 3) * 4 + (qb - 4) : (1 << 30);
          pg8::Geo geo{SSMW * 2, SSMW * 2, 128L * SSMW * 2, 128L * SSMW * 2, SSMW / 64};
          pg8::Sched S; S.init(1, T / 256, SSMW / 256, 1, 128, c, WSP(bf16, WS_Y), 256L * SSMW * 2, 0, WSP(bf16, WS_WGLU), 256L * SSMW * 2, 0);
          EpiGlu Ep{WSP(bf16, WS_Y), INP(18), WSP(bf16, WS_SSMO)};
          pg8::gemm_phase<EpiGlu, pg8::Sched, true, true>(lds + RING_OFF, geo, S, Ep, wave); }
        { const int qb = vcu & 7, c = (vcu < 256 && qb < 4) ? (vcu >> 3) * 4 + qb : (1 << 30);
          pg8::Geo geo{D, D, 128L * D, 128L * D, XD / 128};
          pg8::Sched S; S.init(1, D / 256, TM / 256, XH, 128, c, WSP(unsigned char, WS_WXO8), 256L * D, (long)XD, WSP(unsigned char, WS_XV8), 256L * D, (long)XD);
          EpiVW Ep{WSP(bf16, WS_VWT)};
          pg8::gemm_phase<EpiVW, pg8::Sched, true, true>(lds + RING_OFF, geo, S, Ep, wave); }
        if (BOTH(4)) GRID_BAR_CV();
    }
    if (IN(5)) {
        const int lane = LANE_NOW(), tid = wave * 64 + lane; (void)tid; (void)lane;
        const int gw = bx * NWAVES + wave, NGW = NG * NWAVES;
        for (int t = gw; t < T; t += NGW) {
#pragma unroll
            for (int half = 0; half < 2; ++half) { const bf16* src = (half ? WSP(bf16, WS_SSMO) : WSP(bf16, WS_ATTO)) + (size_t)t * 1024; const float* gn = half ? INP(20) : INP(19);
                const v4u a = ((const v4u*)src)[lane], b = ((const v4u*)src)[64 + lane];
                f32x4 gpre[4];
#pragma unroll
                for (int jj = 0; jj < 2; ++jj) { const int k0 = (jj * 64 + lane) * 8; gpre[2 * jj] = *(const f32x4*)(gn + k0); gpre[2 * jj + 1] = *(const f32x4*)(gn + k0 + 4); }
                float v[16] = {bflo(a.x), bfhi(a.x), bflo(a.y), bfhi(a.y), bflo(a.z), bfhi(a.z), bflo(a.w), bfhi(a.w), bflo(b.x), bfhi(b.x), bflo(b.y), bfhi(b.y), bflo(b.z), bfhi(b.z), bflo(b.w), bfhi(b.w)};
                float s = 0.f;
#pragma unroll
                for (int e = 0; e < 16; ++e) s += v[e] * v[e];
                const float r = rsqrtf(wave_sum(s) * (1.f / 1024) + EPS);
#pragma unroll
                for (int jj = 0; jj < 2; ++jj) { const int k0 = (jj * 64 + lane) * 8; const f32x4 g0 = gpre[2 * jj], g1 = gpre[2 * jj + 1]; v4u w;
                    w.x = pk2(v[8 * jj + 0] * r * g0[0], v[8 * jj + 1] * r * g0[1]); w.y = pk2(v[8 * jj + 2] * r * g0[2], v[8 * jj + 3] * r * g0[3]);
                    w.z = pk2(v[8 * jj + 4] * r * g1[0], v[8 * jj + 5] * r * g1[1]); w.w = pk2(v[8 * jj + 6] * r * g1[2], v[8 * jj + 7] * r * g1[3]);
                    *(v4u*)(WSP(bf16, WS_MIXED) + (size_t)t * D + half * 1024 + k0) = w; } } }
        if (BOTH(5)) GRID_BAR_CV();
#if defined(PROBE_BAR)
        if (BOTH(5)) { for (int i_ = 0; i_ < 10; ++i_) GRID_BAR(); }
#endif
    }
    if (IN(6)) {
        const int lane = LANE_NOW(), tid = wave * 64 + lane; (void)tid; (void)lane;
        pg8::Geo geo{D * 2, D * 2, 128L * D * 2, 128L * D * 2, D / 64};
        pg8::Sched S; S.init(0, T / 256, D / 256, 1, NG, bx, WSP(bf16, WS_MIXED), 256L * D * 2, 0, WSP(bf16, WS_WOUT), 256L * D * 2, 0);
        EpiResid<> Ep{INP(0), WSP(float, WS_X1), nullptr, WSP(float, WS_SSQP1), WSP(unsigned char, WS_X1F8)};
        pg8::gemm_phase<EpiResid<>, pg8::Sched, true, true>(lds + RING_OFF, geo, S, Ep, wave);
        if (BOTH(6)) GRID_BAR_CV();
    }
    if (IN(7)) {
        const int lane = LANE_NOW(), tid = wave * 64 + lane; (void)tid; (void)lane;
        pg8::Geo geo{D, D, 128L * D, 128L * D, D / 128};
        pg8::Sched S; S.init(1, SEQ / 256, XH, BATCH, NG, bx, WSP(unsigned char, WS_X1F8), 256L * D, (long)SEQ * D, WSP(unsigned char, WS_WKT8), 256L * D, (long)XH * MEM * D);
        LAS float* rt = (LAS float*)(lds + TOK_OFF);
        { pg8::Unit u0; if (S.next(0, u0) && tid < 256) { const float* pp = WSP(float, WS_SSQP1) + (size_t)((u0.z * (SEQ / 256) + u0.pm) * 256 + tid) * 32; float sq = 0.f;
#pragma unroll
                for (int k = 0; k < 8; ++k) { const f32x4 v = *(const f32x4*)(pp + 4 * k); sq += v[0]; sq += v[1]; sq += v[2]; sq += v[3]; }
                rt[tid] = rsqrtf(sq * (1.f / D) + EPS); }
            __syncthreads(); }
        EpiSoftmax<true> Ep{WSP(bf16, WS_PX), rt};
        pg8::gemm_phase<EpiSoftmax<true>, pg8::Sched, false, true>(lds + RING_OFF, geo, S, Ep, wave);
        if (BOTH(7)) GRID_BAR_CV();
    }
    if (IN(10)) {
        const int lane = LANE_NOW(), tid = wave * 64 + lane; (void)tid; (void)lane;
        constexpr int PK = XH * MEM;
        pg8::Geo geo{PK * 2, PK * 2, 128L * PK * 2, 128L * PK * 2, PK / 64};
        pg8::Sched S; S.init(1, SEQ / 256, D / 256, BATCH, NG, bx, WSP(bf16, WS_PX), 256L * PK * 2, (long)SEQ * PK * 2, WSP(bf16, WS_VWT), 256L * PK * 2, (long)D * PK * 2);
        EpiResid<false> Ep{WSP(float, WS_X1), WSP(float, WS_X2), nullptr, WSP(float, WS_SSQP2), WSP(unsigned char, WS_X2F8), SEQ / 256};
        pg8::gemm_phase<EpiResid<false>, pg8::Sched, true, true>(lds + RING_OFF, geo, S, Ep, wave);
        if (BOTH(10)) GRID_BAR_CV();
    }
    if (IN(11)) {
        const int lane = LANE_NOW(), tid = wave * 64 + lane; (void)tid; (void)lane;
        for (int tile = bx; tile < T / 32; tile += NG)
            route_tile(tile, lds, WSP(float, WS_X2), WSP(float, WS_SSQP2), WSP(float, WS_RSTD2), WSP(bf16, WS_WRH), WSP(bf16, WS_WRL), INP(30), PRB(ctl + CW_CNT, unsigned*), PRB(WSP(int, WS_SELE), int*), PRB(WSP(int, WS_SELP), int*), PRB(WSP(float, WS_SELG), float*), PRB(WSP(int, WS_LIST), int*) + (args.li == 1 ? (1 << 20) : 0), tid);
        cv_flush(cvw);
        if (BOTH(11)) GRID_BAR();
    }
    if (IN(12)) {
        const int lane = LANE_NOW(), tid = wave * 64 + lane; (void)tid; (void)lane;
        LAS int* blkE = (LAS int*)(lds + BLK_OFF); LAS int* tokTab = (LAS int*)(lds + TOK_OFF);
        const unsigned* counts = ctl + CW_CNT;
        const int NBt = moe_block_table(counts, blkE, tid);
        { int tokv[MAXU / 2];
#pragma unroll
          for (int k = 0; k < MAXU / 2; ++k) { const int i = 2 * k + (tid >> 8), L = i * NG + bx, r = tid & 255; int v = 0;
              if (L < NBt * 16) { const int blk = L >> 4, e = blkE[blk], j = blkE[160 + blk]; if (r < blkE[320 + blk]) v = WSP(int, WS_LIST)[(size_t)e * T + j * 256 + r]; }
              tokv[k] = v; }
#pragma unroll
          for (int k = 0; k < MAXU / 2; ++k) tokTab[(2 * k + (tid >> 8)) * 256 + (tid & 255)] = tokv[k]; }
        __syncthreads();
        pg8::Geo geo{D, D, 0, (long)FF * D, D / 128};
        MoeSchedUpCv S{{NBt, 16, NG, bx, D, (const char*)WSP(unsigned char, WS_X2F8), (const char*)WSP(unsigned char, WS_WUP), 0, (long)2 * FF * D, 128L * D, blkE, tokTab}, INP(33), WSP(unsigned char, WS_WDN), wave};
        EpiMoeUp Ep{blkE, tokTab, WSP(float, WS_RSTD2), INP(32), WSP(unsigned char, WS_ACT)};
        pg8::gemm_phase<EpiMoeUp, MoeSchedUpCv, true, true>(lds + RING_OFF, geo, S, Ep, wave);
        if (BOTH(12)) GRID_BAR();
    }
    if (IN(13)) {
        const int lane = LANE_NOW(), tid = wave * 64 + lane; (void)tid; (void)lane;
        LAS int* blkE = (LAS int*)(lds + BLK_OFF);
        __syncthreads();
        const int NBt = moe_block_table(ctl + CW_CNT, blkE, tid);
        pg8::Geo geo{FF, FF, 128L * FF, 128L * FF, FF / 128};
        MoeSched<false> S{NBt, 8, NG, bx, FF, (const char*)WSP(unsigned char, WS_ACT), (const char*)WSP(unsigned char, WS_WDN), 256L * FF, (long)D * FF, 256L * FF, blkE, nullptr};
        EpiMoeDown Ep{blkE, INP(34), WSP(unsigned char, WS_YK)};
        pg8::gemm_phase<EpiMoeDown, MoeSched<false>, true, true>(lds + RING_OFF, geo, S, Ep, wave);
        if (BOTH(13)) GRID_BAR();
    }
    if (IN(14)) {
        const int lane = LANE_NOW(), tid = wave * 64 + lane; (void)tid; (void)lane;
        const int gw = bx * NWAVES + wave, NGW = NG * NWAVES;
        const unsigned* counts = ctl + CW_CNT;
        int pb = 0;
        { const int nb = (lane < E) ? (((int)counts[(lane & 31) * CNT_STRIDE] + 255) >> 8) : 0; int inc = nb;
#pragma unroll
          for (int o = 1; o < 32; o <<= 1) { const int v = __shfl_up(inc, o); if ((lane & 31) >= o) inc += v; }
          pb = inc - nb; }
        const float* X2 = WSP(float, WS_X2); const unsigned char* YK = WSP(unsigned char, WS_YK); const float* fn = INP(35); float* out = args.out;
        f32x4 fg[8];
#pragma unroll
        for (int j = 0; j < 8; ++j) fg[j] = *(const f32x4*)(fn + (j * 64 + lane) * 4);
        for (int t = gw; t < T; t += NGW) {
            size_t so[TOPK]; float gk[TOPK];
#pragma unroll
            for (int k = 0; k < TOPK; ++k) { const int e = WSP(int, WS_SELE)[t * TOPK + k], p = WSP(int, WS_SELP)[t * TOPK + k]; gk[k] = WSP(float, WS_SELG)[t * TOPK + k] * Y8_INV;
                so[k] = ((size_t)__shfl(pb, e) * 256 + p) * D; }
            f32x4 v[8]; float s = 0.f;
#pragma unroll
            for (int j = 0; j < 8; ++j) { const int cidx = (j * 64 + lane) * 4; f32x4 a = *(const f32x4*)(X2 + (size_t)t * D + cidx);
#pragma unroll
                for (int k = 0; k < TOPK; ++k) { const unsigned y = *(const unsigned*)(YK + so[k] + cidx); const v2f lo = __builtin_amdgcn_cvt_pk_f32_fp8(y, false), hi = __builtin_amdgcn_cvt_pk_f32_fp8(y, true);
                    a[0] += gk[k] * lo[0]; a[1] += gk[k] * lo[1]; a[2] += gk[k] * hi[0]; a[3] += gk[k] * hi[1]; }
                v[j] = a; s += (a[0] * a[0] + a[1] * a[1]) + (a[2] * a[2] + a[3] * a[3]); }
            const float r = rsqrtf(wave_sum(s) * (1.f / D) + EPS);
#pragma unroll
            for (int j = 0; j < 8; ++j) { const int cidx = (j * 64 + lane) * 4; *(f32x4*)(out + (size_t)t * D + cidx) = v[j] * r * fg[j]; }
        }
    }
#if defined(PROBE_READ)
    if (IN(15)) {
        const int lane = LANE_NOW(), tid = wave * 64 + lane; (void)tid; (void)lane;
        const int gw = bx * NWAVES + wave, NGW = NG * NWAVES;
        constexpr int I_UP = (D / 64) * (2 * FF / 64), I_DN = (FF / 64) * (D / 64);
        f32x4 sum = {0.f, 0.f, 0.f, 0.f};
#define TI_MAT8(W_, K_, N_, WT_, G_) { const int nb_ = (N_) / 64, kb = r / nb_, nbi = r % nb_; d.src = (W_) + (size_t)(64 * kb) * (N_) + 64 * nbi; d.dst = (bf16*)((unsigned char*)(WT_) + (size_t)(64 * nbi) * (K_) + 64 * kb); \
            d.gain = (G_) + 64 * kb; d.N = (N_); d.ldk = (K_); }
        auto dec_up = [&](int it) { TItem d; int r = it; const int e = r / I_UP; r -= e * I_UP; TI_MAT8(INP(31) + (size_t)e * D * 2 * FF, D, 2 * FF, WSP(unsigned char, WS_WUP) + (size_t)e * 2 * FF * D, INP(28)); return d; };
        auto dec_dn = [&](int it) { TItem d; int r = it; const int e = r / I_DN; r -= e * I_DN; TI_MAT8(INP(33) + (size_t)e * FF * D, FF, D, WSP(unsigned char, WS_WDN) + (size_t)e * D * FF, INP(28)); return d; };
#undef TI_MAT8
#define PR_STORE(d_, lane_, r_, g_) do { _Pragma("unroll") for (int j_ = 0; j_ < 16; ++j_) sum += r_[j_]; } while (0)
        TSTREAM(E * I_UP, dec_up, titem8_load<false>, PR_STORE);
        TSTREAM(E * I_DN, dec_dn, titem8_load<false>, PR_STORE);
#undef PR_STORE
        *(f32x4*)(ws + WS_END1 + (16u << 20) + ((size_t)gw * 64 + lane) * 16) = sum;
    }
#endif
#undef IN
#undef BOTH
#undef GRID_BAR
}

extern "C" void kernel_launch(void* const* d_in, const int* in_sizes, int n_in, void* d_out, int out_size, void* d_ws, size_t ws_size, hipStream_t stream) {
    static int grid = 0;
    if (grid == 0) {
        if (n_in != 36 || out_size != T * D || ws_size < WS_END1) { fprintf(stderr, "kernel_launch: built for 36 inputs, %d outputs, >= %zu bytes of workspace; got %d, %d, %zu; nothing launched\n", T * D, (size_t)WS_END1, n_in, out_size, ws_size); grid = -1; return; }
        int dev = 0, cus = 0, per_cu = 0;
        if (hipGetDevice(&dev) != hipSuccess || hipDeviceGetAttribute(&cus, hipDeviceAttributeMultiprocessorCount, dev) != hipSuccess) { fprintf(stderr, "kernel_launch: device query failed\n"); grid = -1; return; }
        if (hipFuncSetAttribute((const void*)fwd, hipFuncAttributeMaxDynamicSharedMemorySize, LDS_BYTES) != hipSuccess) { fprintf(stderr, "kernel_launch: hipFuncSetAttribute failed\n"); grid = -1; return; }
        if (hipOccupancyMaxActiveBlocksPerMultiprocessor(&per_cu, (const void*)fwd, NTHR, LDS_BYTES) != hipSuccess || per_cu < 1) fprintf(stderr, "kernel_launch: occupancy query reports %d\n", per_cu);
        (void)hipGetLastError();
        grid = 256;
        if (cus < 256) { fprintf(stderr, "kernel_launch: %d CUs < 256: the grid would not be resident; nothing launched\n", cus); grid = -1; return; }
    }
    if (grid < 0) return;
    (void)hipMemsetAsync((char*)d_ws + WS_CTL, 0, CTL_ZERO_BYTES, stream);
    Args a{};
    for (int i = 0; i < 36; ++i) a.in[i] = d_in[i];
    a.out = (float*)d_out; a.ws = (unsigned char*)d_ws;
#if defined(PROBE_RANGE)
    a.ph_lo = 0; a.ph_hi = PROBE_RANGE_HI; a.li = 0; hipLaunchKernelGGL(fwd, dim3(grid), dim3(NTHR), LDS_BYTES, stream, a);
    a.ph_lo = PROBE_RANGE_LO; a.ph_hi = PROBE_RANGE_HI; a.li = 1; hipLaunchKernelGGL(fwd, dim3(grid), dim3(NTHR), LDS_BYTES, stream, a);
    a.ph_lo = PROBE_RANGE_HI; a.ph_hi = N_PHASES; a.li = 2; hipLaunchKernelGGL(fwd, dim3(grid), dim3(NTHR), LDS_BYTES, stream, a);
#elif defined(PROBE_READ)
    a.ph_lo = 0; a.ph_hi = N_PHASES; a.li = 0; hipLaunchKernelGGL(fwd, dim3(grid), dim3(NTHR), LDS_BYTES, stream, a);
    a.ph_lo = 15; a.ph_hi = 16; a.li = 1; hipLaunchKernelGGL(fwd, dim3(grid), dim3(NTHR), LDS_BYTES, stream, a);
#elif defined(PROBE_PHASE)
    a.ph_lo = 0; a.ph_hi = PROBE_PHASE + 1; a.li = 0; hipLaunchKernelGGL(fwd, dim3(grid), dim3(NTHR), LDS_BYTES, stream, a);
    a.ph_lo = PROBE_PHASE; a.ph_hi = PROBE_PHASE + 1; a.li = 1; hipLaunchKernelGGL(fwd, dim3(grid), dim3(NTHR), LDS_BYTES, stream, a);
    if (PROBE_PHASE + 1 < N_PHASES) { a.ph_lo = PROBE_PHASE + 1; a.ph_hi = N_PHASES; a.li = 2; hipLaunchKernelGGL(fwd, dim3(grid), dim3(NTHR), LDS_BYTES, stream, a); }
#else
    a.ph_lo = 0; a.ph_hi = N_PHASES;
    hipLaunchKernelGGL(fwd, dim3(grid), dim3(NTHR), LDS_BYTES, stream, a);
#endif
}
```

```cpp
#include <hip/hip_runtime.h>
#include <cstdio>
#include <cstdint>

constexpr int D = 2048, BATCH = 4, SEQ = 2048, T = BATCH * SEQ;
constexpr int MEM = 256, TM = BATCH * MEM;
constexpr int H = 8, DN = 128, DR = 64, DV = 128, QL = 384, KVL = 256;
constexpr int SSMW = 1024, G = 64, P = 64, C = 16;
constexpr int XH = 4, XD = 512;
constexpr int E = 32, TOPK = 4, FF = 2048;
constexpr int INC = 1728, INCP = 1792;
constexpr int PJW = 704;
constexpr int LCH = 32, NCH = SEQ / LCH;
constexpr int AGW = 640;
constexpr float EPS = 1e-6f;

__device__ __forceinline__ int lane_id_now() { unsigned z = 0u; asm volatile("" : "+v"(z)); return (int)__builtin_amdgcn_mbcnt_hi(~0u, __builtin_amdgcn_mbcnt_lo(~0u, z)); }
namespace pg8 {
#define PG8_LAS __attribute__((address_space(3)))
typedef unsigned short bf16_t;
typedef short bf16x8 __attribute__((ext_vector_type(8)));
typedef float f32x4 __attribute__((ext_vector_type(4)));
typedef float f32x2 __attribute__((ext_vector_type(2)));
typedef unsigned u32x4 __attribute__((ext_vector_type(4)));
typedef unsigned u32x2 __attribute__((ext_vector_type(2)));
constexpr int BM = 256, BK = 64, HALF = 128, HTB = HALF * BK * 2  , STAGE_BYTES = 8 * HTB, NXCD = 8, WGM = 8;

__host__ __device__ __forceinline__ int lds_byte(int r, int c) { const int st = (r >> 4) * 2 + (c >> 5), rr = r & 15, cc = c & 31, ob = rr * 64 + cc * 2; return st * 1024 + (ob ^ (((ob >> 9) & 1) << 5)); }
__host__ __device__ __forceinline__ void stage_rc(int b, int& R, int& C) { const int st = b / 1024, sb = b % 1024, swz = sb ^ (((sb >> 9) & 1) << 5); R = (st >> 1) * 16 + swz / 64; C = (st & 1) * 32 + (swz % 64) / 2; }
__host__ __device__ __forceinline__ int perm32(int rho) { const int n = rho >> 4, i = rho & 15; return 8 * (i >> 2) + 4 * n + (i & 3); }

struct Unit { int pm, pn, z; };
struct Geo { int lda, ldb; long hstepA, hstepB; int nt; };

struct Sched {
    int nM, nN, nZ, total, G, c, mode, zdiv;
    const char* A; const char* B; long tA, tB, zA, zB, zA2, zB2;
    __device__ __forceinline__ void init(int mode_, int nM_, int nN_, int nZ_, int G_, int c_, const void* A_, long tA_, long zA_, const void* B_, long tB_, long zB_) {
        mode = mode_; nM = nM_; nN = nN_; nZ = nZ_; total = nM_ * nN_ * nZ_; G = G_; c = c_; A = (const char*)A_; B = (const char*)B_; tA = tA_; tB = tB_; zA = zA_; zB = zB_; zdiv = 1 << 30; zA2 = 0; zB2 = 0; }
    __device__ __forceinline__ void split_z(int zdiv_, long zA2_, long zB2_) { zdiv = zdiv_; zA2 = zA2_; zB2 = zB2_; }
    __device__ __forceinline__ bool next(int i, Unit& u) const {
        const long L = (long)i * G + c; if (L >= total) return false;
        if (mode == 0) {
            int wgid = (int)L; { const int q = total / NXCD, r = total % NXCD, xcd = wgid % NXCD, off = wgid / NXCD; wgid = (xcd < r ? xcd * (q + 1) : r * (q + 1) + (xcd - r) * q) + off; }
            const int nig = WGM * nN, gid = wgid / nig, fm = gid * WGM, gsz = (nM - fm) < WGM ? (nM - fm) : WGM;
            u.pm = fm + ((wgid % nig) % gsz); u.pn = (wgid % nig) / gsz; u.z = 0;
        } else { const int l = (int)L; u.pn = l % nN; u.pm = (l / nN) % nM; u.z = l / (nN * nM); }
        return true;
    }
    __device__ __forceinline__ void ptrs(const Unit& u, const char*& a, const char*& b) const { const int z1 = (zdiv == (1 << 30)) ? u.z : u.z / zdiv, z2 = (zdiv == (1 << 30)) ? 0 : u.z % zdiv;
        a = A + (long)z1 * zA + (long)z2 * zA2 + (long)u.pm * tA; b = B + (long)z1 * zB + (long)z2 * zB2 + (long)u.pn * tB; }
    static constexpr bool GATHER = false;
    __device__ __forceinline__ bool half1(const Unit&) const { return true; }
    __device__ __forceinline__ unsigned row_off(int, int) const { return 0u; }
    __device__ __forceinline__ void a_ready(const Unit&) const {}
    __device__ __forceinline__ void done(const Unit&) const {}
};
template <class E, class = void> struct epi_fp8 { static constexpr bool v = false; };
template <class E> struct epi_fp8<E, decltype((void)E::FP8)> { static constexpr bool v = E::FP8; };
typedef int i32x4 __attribute__((ext_vector_type(4)));
typedef int i32x8 __attribute__((ext_vector_type(8)));
__device__ __forceinline__ unsigned cvt_pk_bf16(float lo, float hi) { unsigned r; asm volatile("v_cvt_pk_bf16_f32 %0, %1, %2" : "=v"(r) : "v"(lo), "v"(hi)); return r; }

template <class Epi, class Sched, bool ALIGN_EPI = false, bool SP2 = false>
__device__ __forceinline__ void gemm_phase(PG8_LAS unsigned char* lds, const Geo geo, const Sched& S, const Epi& E, const int wave_) {
    int tid_ = wave_ * 64 + lane_id_now(); asm volatile("" : "+v"(tid_));
    const int tid = tid_, wid = __builtin_amdgcn_readfirstlane(tid >> 6), lane = tid & 63, wr = wid >> 2, wc = wid & 3, fr = lane & 15, fq = lane >> 4;
    const int nt = geo.nt;
    unsigned voffA[2], voffB[2];
#pragma unroll
    for (int i = 0; i < 2; ++i) { int R, C; stage_rc(tid * 16 + i * 8192, R, C); const int Rb = Epi::PERM ? ((R & ~31) + perm32(R & 31)) : R;
        voffA[i] = (unsigned)(R * geo.lda + C * 2); voffB[i] = (unsigned)(Rb * geo.ldb + C * 2); }
    unsigned c0[2], c1[2], n0[2], n1[2];
#pragma unroll
    for (int i = 0; i < 2; ++i) { c0[i] = voffA[i]; c1[i] = voffA[i]; n0[i] = voffA[i]; n1[i] = voffA[i]; }
    const size_t kstep = (size_t)(BK * 2);
    const size_t hstepA = (size_t)geo.hstepA, hstepB = (size_t)geo.hstepB;
    const unsigned ldsw = (unsigned)wid * 1024u;
    const int aoff = lds_byte(wr * 64 + fr, fq * 8), boff = lds_byte(wc * 32 + fr, fq * 8);
#define PG8_SA(b, h) (((b) * 2 + (h)) * HTB)
#define PG8_SB(b, h) ((4 + (b) * 2 + (h)) * HTB)
#define PG8_STAGE(bufoff, gbase, voff) do { _Pragma("unroll") for (int _i = 0; _i < 2; ++_i) \
        __builtin_amdgcn_global_load_lds((const unsigned*)((const char*)(gbase) + (voff)[_i]), (PG8_LAS unsigned*)(lds + (bufoff) + ldsw + _i * 8192), 16, 0, 0); } while (0)
#define PG8_LD16(off) __builtin_bit_cast(i32x4, *(const PG8_LAS bf16x8*)(lds + (off)))
#define PG8_LDA(dst, b, h) do { _Pragma("unroll") for (int m = 0; m < 4; ++m) { if constexpr (epi_fp8<Epi>::v) dst##8[m] = __builtin_shufflevector(PG8_LD16(PG8_SA(b, h) + aoff + m * 2048), PG8_LD16(PG8_SA(b, h) + aoff + m * 2048 + 1024), 0, 1, 2, 3, 4, 5, 6, 7); \
        else { _Pragma("unroll") for (int k = 0; k < 2; ++k) dst[m][k] = *(const PG8_LAS bf16x8*)(lds + PG8_SA(b, h) + aoff + m * 2048 + k * 1024); } } } while (0)
#define PG8_LDB(dst, b, h) do { _Pragma("unroll") for (int n = 0; n < 2; ++n) { if constexpr (epi_fp8<Epi>::v) dst##8[n] = __builtin_shufflevector(PG8_LD16(PG8_SB(b, h) + boff + n * 2048), PG8_LD16(PG8_SB(b, h) + boff + n * 2048 + 1024), 0, 1, 2, 3, 4, 5, 6, 7); \
        else { _Pragma("unroll") for (int k = 0; k < 2; ++k) dst[n][k] = *(const PG8_LAS bf16x8*)(lds + PG8_SB(b, h) + boff + n * 2048 + k * 1024); } } } while (0)
#define PG8_MMA(ai, bj, At, Bt) do { __builtin_amdgcn_s_setprio(1); \
        if constexpr (epi_fp8<Epi>::v) { _Pragma("unroll") for (int m = 0; m < 4; ++m) _Pragma("unroll") for (int n = 0; n < 2; ++n) \
            asm volatile("v_mfma_f32_16x16x128_f8f6f4 %0, %1, %2, %0" : "+v"(acc[ai][bj][m][n]) : "v"(Bt##8[n]), "v"(At##8[m])); }     \
        else { _Pragma("unroll") for (int m = 0; m < 4; ++m) _Pragma("unroll") for (int n = 0; n < 2; ++n) _Pragma("unroll") for (int k = 0; k < 2; ++k) \
            acc[ai][bj][m][n] = __builtin_amdgcn_mfma_f32_16x16x32_bf16(Bt[n][k], At[m][k], acc[ai][bj][m][n], 0, 0, 0); } \
        __builtin_amdgcn_s_setprio(0); } while (0)
#define PG8_WAIT_V(n) asm volatile("s_waitcnt vmcnt(" #n ")" ::: "memory")
#define PG8_WAIT_L(n) asm volatile("s_waitcnt lgkmcnt(" #n ")" ::: "memory")
#define PG8_BAR __builtin_amdgcn_s_barrier()
#define PG8_SCHED __builtin_amdgcn_sched_barrier(0)
    Unit cur, nxt; int ui = 0;
    if (!S.next(0, cur)) return;
    f32x4 acc[2][2][4][2];
#pragma unroll
    for (int a = 0; a < 2; ++a)
#pragma unroll
        for (int b = 0; b < 2; ++b)
#pragma unroll
            for (int m = 0; m < 4; ++m)
#pragma unroll
                for (int n = 0; n < 2; ++n) acc[a][b][m][n] = (f32x4){0.f, 0.f, 0.f, 0.f};
    bf16x8 At[4][2], B0[2][2], B1[2][2];
    i32x8 At8[4], B08[2], B18[2];
    const char* cA; const char* cB; S.ptrs(cur, cA, cB);
    S.a_ready(cur);
    if constexpr (Sched::GATHER) {
#pragma unroll
        for (int i = 0; i < 2; ++i) { int R, C; stage_rc(tid * 16 + i * 8192, R, C); c0[i] = S.row_off(0, R) + (unsigned)(C * 2); c1[i] = S.row_off(0, 128 + R) + (unsigned)(C * 2); n0[i] = c0[i]; n1[i] = c1[i]; } }
    static_assert(SP2, "only the two-super-phase loop is kept in this file");
    PG8_STAGE(PG8_SB(0, 0), cB, voffB); PG8_STAGE(PG8_SB(0, 1), cB + hstepB, voffB); PG8_STAGE(PG8_SA(0, 0), cA, c0); PG8_STAGE(PG8_SA(0, 1), cA + hstepA, c1);
    if (wr == 1) PG8_BAR;
    PG8_WAIT_V(2); PG8_BAR;
    PG8_STAGE(PG8_SB(1, 0), cB + kstep, voffB); PG8_STAGE(PG8_SA(1, 0), cA + kstep, c0); PG8_STAGE(PG8_SB(1, 1), cB + hstepB + kstep, voffB);
    PG8_WAIT_V(6); PG8_BAR;
    for (;;) {
        const bool has_next = S.next(ui + 1, nxt);
        const char* nA = cA; const char* nB = cB; if (has_next) S.ptrs(nxt, nA, nB);
        const bool h1 = S.half1(cur);
        for (int t = 0; t < nt; t += 2) {
            const bool last = (t == nt - 2);
            const char* a1 = cA + (size_t)(t + 1) * kstep;
            const char* a2 = last ? nA : cA + (size_t)(t + 2) * kstep; const char* b2 = last ? nB : cB + (size_t)(t + 2) * kstep;
            const char* a3 = a2 + kstep; const char* b3 = b2 + kstep;
            if (last && has_next) { S.a_ready(nxt);
                if constexpr (Sched::GATHER) {
#pragma unroll
                    for (int i = 0; i < 2; ++i) { int R, C; stage_rc(tid * 16 + i * 8192, R, C); n0[i] = S.row_off(ui + 1, R) + (unsigned)(C * 2); n1[i] = S.row_off(ui + 1, 128 + R) + (unsigned)(C * 2); } } }
            const unsigned s0[2] = {last ? n0[0] : c0[0], last ? n0[1] : c0[1]}, s1[2] = {last ? n1[0] : c1[0], last ? n1[1] : c1[1]};
            PG8_LDB(B0, 0, 0); PG8_LDB(B1, 0, 1); PG8_SCHED; PG8_LDA(At, 0, 0); PG8_STAGE(PG8_SA(1, 1), a1 + hstepA, c1);
            PG8_WAIT_V(8); PG8_WAIT_L(0); PG8_BAR; PG8_MMA(0, 0, At, B0); PG8_MMA(0, 1, At, B1); PG8_BAR; PG8_SCHED;
            PG8_LDA(At, 0, 1); PG8_STAGE(PG8_SB(0, 0), b2, voffB); PG8_STAGE(PG8_SB(0, 1), b2 + hstepB, voffB); PG8_STAGE(PG8_SA(0, 0), a2, s0);
            PG8_WAIT_V(8); PG8_WAIT_L(0); PG8_BAR; if (h1) { PG8_MMA(1, 0, At, B0); PG8_MMA(1, 1, At, B1); } PG8_BAR; PG8_SCHED;
            PG8_LDB(B0, 1, 0); PG8_LDB(B1, 1, 1); PG8_SCHED; PG8_LDA(At, 1, 0); PG8_STAGE(PG8_SA(0, 1), a2 + hstepA, s1);
            PG8_WAIT_V(8); PG8_WAIT_L(0); PG8_BAR; PG8_MMA(0, 0, At, B0); PG8_MMA(0, 1, At, B1); PG8_BAR; PG8_SCHED;
            PG8_LDA(At, 1, 1); PG8_STAGE(PG8_SB(1, 0), b3, voffB); PG8_STAGE(PG8_SB(1, 1), b3 + hstepB, voffB); PG8_STAGE(PG8_SA(1, 0), a3, s0);
            PG8_WAIT_V(8); PG8_WAIT_L(0); PG8_BAR; if (h1) { PG8_MMA(1, 0, At, B0); PG8_MMA(1, 1, At, B1); } PG8_BAR; PG8_SCHED;
        }
        if constexpr (epi_fp8<Epi>::v) { asm volatile("s_nop 7\n\ts_nop 7\n\ts_nop 7" ::: "memory"); }
        if constexpr (ALIGN_EPI) { if (wr == 0) PG8_BAR; }
        if constexpr (!Epi::AFTER_DRAIN) { E(acc, cur, wr, wc, fr, fq); S.done(cur); }
        if (!has_next) break;
#pragma unroll
        for (int a = 0; a < 2; ++a)
#pragma unroll
            for (int b = 0; b < 2; ++b)
#pragma unroll
                for (int m = 0; m < 4; ++m)
#pragma unroll
                    for (int n = 0; n < 2; ++n) acc[a][b][m][n] = (f32x4){0.f, 0.f, 0.f, 0.f};
        cur = nxt; cA = nA; cB = nB; ++ui;
#pragma unroll
        for (int i = 0; i < 2; ++i) { c0[i] = n0[i]; c1[i] = n1[i]; }
        if constexpr (ALIGN_EPI) { if (wr == 1) PG8_BAR; }
    }
    PG8_WAIT_V(0);
    if constexpr (!ALIGN_EPI) { if (wr == 0) PG8_BAR; }
    PG8_BAR;
    if constexpr (Epi::AFTER_DRAIN) { E.fused(acc, cur, wr, wc, fr, fq, lds, wid, lane); S.done(cur); }
#undef PG8_SA
#undef PG8_SB
#undef PG8_STAGE
#undef PG8_LDA
#undef PG8_LD16
#undef PG8_LDB
#undef PG8_MMA
#undef PG8_WAIT_V
#undef PG8_WAIT_L
#undef PG8_BAR
#undef PG8_SCHED
}
}

constexpr size_t MiB = 1u << 20;
constexpr size_t al256(size_t x) { return (x + 255) & ~(size_t)255; }
constexpr size_t WS_CTL = 0, CTL_ZERO_BYTES = 1 * MiB;
constexpr int CW_BAR = 4096;
constexpr int CW_CNT = 49152, CNT_STRIDE = 64;
constexpr int CW_CVQ = 16384;
constexpr int CW_SSQ2 = 32768;
constexpr size_t WS_WIN = 1 * MiB;
constexpr size_t WS_WQB = WS_WIN + al256((size_t)INCP * D * 2);
constexpr size_t WS_WKVB = WS_WQB + al256((size_t)1536 * QL * 2);
constexpr size_t WS_WGLU = WS_WKVB + al256((size_t)2048 * KVL * 2);
constexpr size_t WS_WOUT = WS_WGLU + al256((size_t)SSMW * SSMW * 2);
constexpr size_t WS_WXQ = WS_WOUT + al256((size_t)D * D * 2);
constexpr size_t WS_WXK = WS_WXQ + al256((size_t)D * D * 2);
constexpr size_t WS_WXV = WS_WXK + al256((size_t)D * D * 2);
constexpr size_t WS_WXO = WS_WXV + al256((size_t)D * D * 2);
constexpr size_t WS_BTY = WS_WXO + al256((size_t)D * D * 2);
constexpr size_t WS_BTS = WS_BTY + al256((size_t)G * 512 * AGW * 2);
constexpr size_t WS_AP32 = WS_BTS + al256((size_t)G * 128 * 512 * 2);
constexpr size_t WS_HB = WS_AP32 + al256((size_t)G * P * 2 * 4);
constexpr size_t WS_MEMN = WS_HB + al256((size_t)T * D * 2);
constexpr size_t WS_PROJB = WS_MEMN + al256((size_t)TM * D * 2);
constexpr size_t WS_AG = WS_PROJB + al256((size_t)T * PJW * 2);
constexpr size_t WS_SC = WS_AG + al256((size_t)G * 256 * AGW * 2);
constexpr size_t WS_CQN = WS_SC + al256((size_t)G * 256 * 128 * 4);
constexpr size_t WS_CKVN = WS_CQN + al256((size_t)T * QL * 2);
constexpr size_t WS_KPE = WS_CKVN + al256((size_t)T * KVL * 2);
constexpr size_t WS_ROPE = WS_KPE + al256((size_t)T * DR * 2);
constexpr size_t WS_Q = WS_ROPE + al256((size_t)T * 64 * 4);
constexpr size_t WS_KV = WS_Q + al256((size_t)T * 1536 * 2);
constexpr size_t WS_XK = WS_KV + al256((size_t)T * 2048 * 2);
constexpr size_t WS_XVT = WS_XK + al256((size_t)TM * D * 2);
constexpr size_t WS_Y = WS_XVT + al256((size_t)D * TM * 2);
constexpr size_t WS_ATTO = WS_Y + al256((size_t)T * SSMW * 2);
constexpr size_t WS_SSMO = WS_ATTO + al256((size_t)T * 1024 * 2);
constexpr size_t WS_X1 = WS_SSMO + al256((size_t)T * 1024 * 2);
constexpr size_t WS_X1B = WS_X1 + al256((size_t)T * D * 4);
constexpr size_t WS_XQ = WS_X1B + al256((size_t)T * D * 2);
constexpr size_t WS_PX = WS_XQ + al256((size_t)T * D * 2);
constexpr size_t WS_WXQN = WS_XQ;
constexpr size_t WS_WKT8 = WS_XQ + (size_t)D * D * 2;
constexpr size_t WS_XO = WS_PX + al256((size_t)BATCH * XH * SEQ * MEM * 2);
constexpr size_t WS_X2 = WS_XO + al256((size_t)T * D * 2);
constexpr size_t WS_X2B = WS_X2 + al256((size_t)T * D * 4);
constexpr size_t WS_WRH = WS_X2B + al256((size_t)T * D * 2);
constexpr size_t WS_WRL = WS_WRH + al256((size_t)E * D * 2);
constexpr size_t WS_SELE = WS_WRL + al256((size_t)E * D * 2);
constexpr size_t WS_SELP = WS_SELE + al256((size_t)T * TOPK * 4);
constexpr size_t WS_SELG = WS_SELP + al256((size_t)T * TOPK * 4);
constexpr size_t WS_LIST = WS_SELG + al256((size_t)T * TOPK * 4);
constexpr int NSLOT = (T * TOPK / 256 + E) * 256;
constexpr size_t WS_ACT = WS_LIST + al256((size_t)E * T * 4);
constexpr size_t WS_YK = WS_ACT + al256((size_t)NSLOT * FF * 2);
constexpr size_t WS_WUP = WS_YK + al256((size_t)NSLOT * D * 2);
constexpr size_t WS_WDN = WS_WUP + al256((size_t)E * 2 * FF * D * 2);
constexpr size_t WS_X2F8 = WS_WDN + al256((size_t)E * D * FF * 2);
constexpr size_t WS_X1F8 = WS_X2F8 + al256((size_t)T * D);
constexpr size_t WS_XO8 = WS_X1F8 + al256((size_t)T * D);
constexpr size_t WS_WXQ8 = WS_XO8 + al256((size_t)T * D);
constexpr size_t WS_WXO8 = WS_WXQ8 + al256((size_t)D * D);
constexpr size_t WS_MIXED = WS_WXO8 + al256((size_t)D * D);
constexpr size_t WS_SSQP1 = WS_MIXED + al256((size_t)T * D * 2);
constexpr size_t WS_SSQP2 = WS_SSQP1 + al256((size_t)T * 32 * 4);
constexpr size_t WS_RSTD2 = WS_SSQP2 + al256((size_t)T * 32 * 4);
constexpr size_t WS_XV8 = WS_XVT;
constexpr size_t WS_VWT = WS_XO8;
constexpr size_t WS_END1 = WS_RSTD2 + al256((size_t)T * 4);

constexpr int NWAVES = 8, NTHR = 512;
constexpr int RING_OFF = 0, RING_BYTES = 131072;
constexpr int LDSCTL_OFF = RING_BYTES, MISC_OFF = LDSCTL_OFF + 320;
constexpr int TOK_OFF = LDSCTL_OFF + 1024, MAXU = 10;
constexpr int BLK_OFF = TOK_OFF + MAXU * 1024;
constexpr int LDS_BYTES = 147456;
static_assert(BLK_OFF + 480 * 4 <= LDS_BYTES, "LDS map");

#define GAS __attribute__((address_space(1)))
#define LAS __attribute__((address_space(3)))
typedef unsigned short bf16;
typedef unsigned v4u __attribute__((ext_vector_type(4)));
typedef unsigned v2u __attribute__((ext_vector_type(2)));
typedef float v2f __attribute__((ext_vector_type(2)));
typedef float f32x4 __attribute__((ext_vector_type(4)));
typedef short bf16x8 __attribute__((ext_vector_type(8)));
#define LDS_WAIT() asm volatile("s_waitcnt lgkmcnt(0)" ::: "memory")
#define VM_WAIT() asm volatile("s_waitcnt vmcnt(0)" ::: "memory")
__device__ __forceinline__ unsigned f2bf(float f) { unsigned u = __builtin_bit_cast(unsigned, f); return (u + 0x7fffu + ((u >> 16) & 1u)) >> 16; }
__device__ __forceinline__ unsigned pk2(float lo, float hi) { return f2bf(lo) | (f2bf(hi) << 16); }
__device__ __forceinline__ float bf2f(unsigned short h) { return __builtin_bit_cast(float, (unsigned)h << 16); }
__device__ __forceinline__ float bflo(unsigned w) { return __builtin_bit_cast(float, w << 16); }
__device__ __forceinline__ float bfhi(unsigned w) { return __builtin_bit_cast(float, w & 0xffff0000u); }

__device__ __forceinline__ float clamp448(float v) { return fminf(fmaxf(v, -448.0f), 448.0f); }
__device__ __forceinline__ float clamp448m(float v) { return __builtin_amdgcn_fmed3f(v, -448.0f, 448.0f); }
__device__ __forceinline__ unsigned pk4_fp8w(float a, float b, float c, float d) {
    int p = __builtin_amdgcn_cvt_pk_fp8_f32(clamp448m(a), clamp448m(b), 0, false); p = __builtin_amdgcn_cvt_pk_fp8_f32(clamp448m(c), clamp448m(d), p, true); return (unsigned)p; }
__device__ __forceinline__ unsigned pk4_fp8(float a, float b, float c, float d) {
    int p = __builtin_amdgcn_cvt_pk_fp8_f32(clamp448(a), clamp448(b), 0, false); p = __builtin_amdgcn_cvt_pk_fp8_f32(clamp448(c), clamp448(d), p, true); return (unsigned)p; }
constexpr float W8_SCALE = 256.0f, W8_INV = 1.0f / 256.0f;

#define XB_TMO      128
#define XB_XCNT(j)  (256  + 64 * (j))
#define XB_XSUB(j)  (1280 + 64 * (j))
#define XB_XGEN(j)  (2304 + 64 * (j))
#define XB_TOP      3328
#define XB_TOPGEN   3392
#define XB_FLAG(j)  (3456 + (j))
#define XCD_BAR_WORDS 3520
#define XB_SPIN_CAP (1u << 18)

__device__ __forceinline__ unsigned xb_ld(unsigned* p)              { return __hip_atomic_load(p, __ATOMIC_RELAXED, __HIP_MEMORY_SCOPE_AGENT); }
__device__ __forceinline__ unsigned xb_add(unsigned* p, unsigned v) { return __hip_atomic_fetch_add(p, v, __ATOMIC_RELAXED, __HIP_MEMORY_SCOPE_AGENT); }
__device__ __forceinline__ unsigned xb_xcc_id() { return (unsigned)__builtin_amdgcn_s_getreg((3 << 11) | 20) & 0xFu; }
#define XB_SPIN(cond, bar) do { unsigned _sp = 0; while (cond) { __builtin_amdgcn_s_sleep(1); \
    if ((++_sp & 255u) == 0u) { if (xb_ld(&(bar)[XB_TMO])) break; if (_sp > XB_SPIN_CAP) { atomicAdd(&(bar)[XB_TMO], 1u); break; } } } } while (0)

struct XcdBarrier {
    unsigned* bar; unsigned x; int wave;
    volatile LAS unsigned* st;
};
__device__ __forceinline__ bool xb_thread0(int wave) { return wave == 0 && lane_id_now() == 0; }
__device__ __forceinline__ XcdBarrier xcd_barrier_post(unsigned* bar, volatile LAS unsigned* st, int wave) {
    XcdBarrier b; b.bar = bar; b.x = xb_xcc_id(); b.st = st; b.wave = wave;
    if (xb_thread0(wave)) (void)xb_add(&bar[XB_XCNT(b.x)], 1u);
    return b;
}
__device__ __forceinline__ void xcd_barrier_complete(unsigned* bar, unsigned x, unsigned& nloc, unsigned& nx, unsigned& mask) {
    const unsigned G_ = gridDim.x * gridDim.y * gridDim.z;
    unsigned sum, cnt, mine, msk, sp = 0u;
    for (;;) {
        sum = 0u; cnt = 0u; mine = 0u; msk = 0u;
#pragma unroll
        for (unsigned j = 0; j < 16; ++j) { const unsigned c = xb_ld(&bar[XB_XCNT(j)]); sum += c; cnt += (c > 0u) ? 1u : 0u; msk |= (c > 0u) ? (1u << j) : 0u; mine = (j == x) ? c : mine; }
        if (sum == G_) break;
        __builtin_amdgcn_s_sleep(1);
        if ((++sp & 255u) == 0u) { if (xb_ld(&bar[XB_TMO])) break; if (sp > XB_SPIN_CAP) { atomicAdd(&bar[XB_TMO], 1u); break; } }
    }
    nloc = mine > 0u ? mine : 1u; nx = cnt > 0u ? cnt : 1u; mask = msk;
}
__device__ __forceinline__ void xb_wave0(const XcdBarrier& b, volatile LAS unsigned* stopw = nullptr, unsigned stopv = 0u) {
    unsigned* bar = b.bar;
    const int lane = lane_id_now();
    __builtin_amdgcn_s_waitcnt(0);
    unsigned gen = 0u;
    if (lane == 0) {
        unsigned nloc = b.st[0], nx = b.st[1], mask = b.st[2];
        if (nloc == 0u) { xcd_barrier_complete(bar, b.x, nloc, nx, mask); b.st[0] = nloc; b.st[1] = nx; b.st[2] = mask; }
        const unsigned old = xb_add(&bar[XB_XSUB(b.x)], 1u);
        gen = old / nloc;
        if (old + 1u == (gen + 1u) * nloc) {
            __builtin_amdgcn_fence(__ATOMIC_RELEASE, "agent");
            asm volatile("s_waitcnt vmcnt(0)" ::: "memory");
            xb_add(&bar[XB_FLAG(b.x)], 1u);
        }
    }
    gen = (unsigned)__builtin_amdgcn_readfirstlane((int)gen);
    asm volatile("s_waitcnt lgkmcnt(0)" ::: "memory");
    const unsigned mask = b.st[2];
    unsigned sp = 0u;
    for (;;) {
        unsigned f = 0u; if (lane < 16) f = xb_ld(&bar[XB_FLAG(lane)]);
        const bool waiting = (lane < 16) && ((mask >> lane) & 1u) && ((int)(f - gen) <= 0);
        const unsigned long long wm = __builtin_amdgcn_ballot_w64(waiting);
        if (wm == 0ull) break;
        if (stopw && 2 * __builtin_popcountll(wm) <= __builtin_popcount(mask)) { *stopw = stopv; stopw = nullptr; }
        __builtin_amdgcn_s_sleep(1);
        if ((++sp & 255u) == 0u) { if (xb_ld(&bar[XB_TMO])) break; if (sp > XB_SPIN_CAP) { if (lane == 0) atomicAdd(&bar[XB_TMO], 1u); break; } }
    }
    __builtin_amdgcn_fence(__ATOMIC_ACQUIRE, "agent");
    asm volatile("s_waitcnt vmcnt(0)" ::: "memory");
}
__device__ __forceinline__ void xcd_barrier(const XcdBarrier& b) {
    asm volatile("s_waitcnt vmcnt(0)" ::: "memory");
    __syncthreads();
    if (b.wave == 0) xb_wave0(b);
    __syncthreads();
}

__device__ __forceinline__ float wave_sum(float v) {
#pragma unroll
    for (int o = 1; o < 64; o <<= 1) v += __shfl_xor(v, o);
    return v;
}
__device__ __forceinline__ void transpose_item(const float* W, int N, bf16* WT, int ldk, const float* gain, LAS float* scr, int item, int nblk, int lane) {
    const int kb = item / nblk, nb = item % nblk, k0 = 64 * kb, n0 = 32 * nb;
#pragma unroll 8
    for (int i = 0; i < 32; ++i) { const int kk = 2 * i + (lane >> 5); const float g = gain ? gain[k0 + kk] : 1.0f;
        scr[kk * 33 + (lane & 31)] = W[(size_t)(k0 + kk) * N + n0 + (lane & 31)] * g; }
    LDS_WAIT(); asm volatile("" ::: "memory");
    const int c = lane & 7;
#pragma unroll
    for (int j = 0; j < 4; ++j) { const int n = (lane >> 3) + 8 * j; const LAS float* s = scr + (8 * c) * 33 + n;
        v4u o; o.x = pk2(s[0 * 33], s[1 * 33]); o.y = pk2(s[2 * 33], s[3 * 33]); o.z = pk2(s[4 * 33], s[5 * 33]); o.w = pk2(s[6 * 33], s[7 * 33]);
        *(GAS v4u*)(WT + (size_t)(n0 + n) * ldk + k0 + 8 * c) = o; }
    LDS_WAIT(); asm volatile("" ::: "memory");
}
__device__ __forceinline__ void rms_row_to_bf16(const float* xrow, const float* g, bf16* orow, int lane) {
    const GAS f32x4* xr = (const GAS f32x4*)xrow + lane;
    f32x4 v[8], gv[8]; float s = 0.f;
#pragma unroll
    for (int j = 0; j < 8; ++j) { v[j] = xr[64 * j]; gv[j] = ((const GAS f32x4*)g)[lane + 64 * j]; }
#pragma unroll
    for (int j = 0; j < 8; ++j) s += (v[j].x * v[j].x + v[j].y * v[j].y) + (v[j].z * v[j].z + v[j].w * v[j].w);
    const float r = rsqrtf(wave_sum(s) * (1.f / D) + EPS);
    GAS v2u* o8 = (GAS v2u*)orow + lane;
#pragma unroll
    for (int j = 0; j < 8; ++j) { const f32x4 gg = gv[j];
        v2u o; o.x = pk2(v[j].x * r * gg.x, v[j].y * r * gg.y); o.y = pk2(v[j].z * r * gg.z, v[j].w * r * gg.w); o8[64 * j] = o; }
}

__device__ __forceinline__ void s5_setup(int g, LAS unsigned char* lds, const float* lam_re, const float* lam_im, const float* log_dt, const float* b_re, const float* b_im,
                                         const float* c_re, const float* c_im, bf16* BTY, bf16* BTS, float* AP32, int tid) {
    LAS float* apr = (LAS float*)lds;
    LAS float* api = apr + 33 * 64;
    LAS float* bbr = api + 33 * 64;
    LAS float* bbi = bbr + 1024;
    LAS float* ccr = bbi + 1024;
    LAS float* cci = ccr + 1024;
    LAS float* Kd = cci + 1024;
    const float dt = expf(log_dt[g]);
    for (int idx = tid; idx < 33 * 64; idx += NTHR) { const int d = idx >> 6, p = idx & 63; const float lr = lam_re[g * 64 + p], li = lam_im[g * 64 + p];
        const float mag = expf((float)d * (lr * dt)), ang = (float)d * (li * dt); apr[idx] = mag * cosf(ang); api[idx] = mag * sinf(ang); }
    for (int idx = tid; idx < 1024; idx += NTHR) { ccr[idx] = c_re[g * 1024 + idx]; cci[idx] = c_im[g * 1024 + idx]; }
    __syncthreads();
    for (int idx = tid; idx < 1024; idx += NTHR) { const int p = idx >> 4; const float lr = lam_re[g * 64 + p], li = lam_im[g * 64 + p];
        const float nr = apr[64 + p] - 1.0f, ni = api[64 + p], den = lr * lr + li * li; const float cre = (nr * lr + ni * li) / den, cim = (ni * lr - nr * li) / den;
        const float br = b_re[g * 1024 + idx], bi = b_im[g * 1024 + idx]; bbr[idx] = cre * br - cim * bi; bbi[idx] = cre * bi + cim * br; }
    __syncthreads();
    for (int idx = tid; idx < 32 * 256; idx += NTHR) { const int d = idx >> 8, co = (idx >> 4) & 15, ci = idx & 15; float a = 0.f;
        for (int p = 0; p < 64; ++p) { const float cr = ccr[co * 64 + p], cm = cci[co * 64 + p], ar = apr[d * 64 + p], ai = api[d * 64 + p];
            const float car = cr * ar - cm * ai, cai = cr * ai + cm * ar; a += car * bbr[p * 16 + ci] - cai * bbi[p * 16 + ci]; }
        Kd[idx] = a; }
    __syncthreads();
    for (int idx = tid; idx < 512 * 80; idx += NTHR) { const int row = idx / 80, q = idx % 80, i = row >> 4, co = row & 15; float v[8];
        if (q < 64) { const int j = q >> 1, ci0 = (q & 1) * 8;
#pragma unroll
            for (int e = 0; e < 8; ++e) v[e] = (j <= i) ? Kd[(i - j) * 256 + co * 16 + ci0 + e] : 0.f; }
        else if (q < 72) { const int p0 = (q - 64) * 8;
#pragma unroll
            for (int e = 0; e < 8; ++e) { const int p = p0 + e; v[e] = ccr[co * 64 + p] * apr[(i + 1) * 64 + p] - cci[co * 64 + p] * api[(i + 1) * 64 + p]; } }
        else { const int p0 = (q - 72) * 8;
#pragma unroll
            for (int e = 0; e < 8; ++e) { const int p = p0 + e; v[e] = -(ccr[co * 64 + p] * api[(i + 1) * 64 + p] + cci[co * 64 + p] * apr[(i + 1) * 64 + p]); } }
        v4u o; o.x = pk2(v[0], v[1]); o.y = pk2(v[2], v[3]); o.z = pk2(v[4], v[5]); o.w = pk2(v[6], v[7]);
        *(GAS v4u*)(BTY + ((size_t)g * 512 + row) * AGW + q * 8) = o; }
    for (int idx = tid; idx < 128 * 64; idx += NTHR) { const int row = idx >> 6, q = idx & 63, p = row & 63, part = row >> 6, j = q >> 1, ci0 = (q & 1) * 8; float v[8];
        const float ar = apr[(31 - j) * 64 + p], ai = api[(31 - j) * 64 + p];
#pragma unroll
        for (int e = 0; e < 8; ++e) { const float br = bbr[p * 16 + ci0 + e], bi = bbi[p * 16 + ci0 + e]; v[e] = part ? (ar * bi + ai * br) : (ar * br - ai * bi); }
        v4u o; o.x = pk2(v[0], v[1]); o.y = pk2(v[2], v[3]); o.z = pk2(v[4], v[5]); o.w = pk2(v[6], v[7]);
        *(GAS v4u*)(BTS + ((size_t)g * 128 + row) * 512 + q * 8) = o; }
    if (tid < 64) { AP32[(g * 64 + tid) * 2] = apr[32 * 64 + tid]; AP32[(g * 64 + tid) * 2 + 1] = api[32 * 64 + tid]; }
    __syncthreads();
}

using pg8::Unit;
template <bool RS, bool F8 = false, bool O8 = false> struct EpiPlain {
    static constexpr bool PERM = true, AFTER_DRAIN = false, FP8 = F8;
    bf16* O; int ldc; int zdiv; long zC1, zC2; const LAS float* rstd;
    __device__ __forceinline__ void operator()(const f32x4 (&acc)[2][2][4][2], const Unit& u, int wr, int wc, int fr, int fq) const {
        const long zoff = (long)(u.z / zdiv) * zC1 + (long)(u.z % zdiv) * zC2;
        const int row0 = u.pm * 256 + wr * 64 + fr, col0 = u.pn * 256 + wc * 32 + 8 * fq;
#pragma unroll
        for (int ai = 0; ai < 2; ++ai)
#pragma unroll
            for (int m = 0; m < 4; ++m) { const int row = row0 + ai * 128 + m * 16; const size_t eo = (size_t)zoff + (size_t)row * ldc + col0;
                float sc = F8 ? W8_INV : 1.f; if (RS) sc *= rstd[row - u.pm * 256];
#pragma unroll
                for (int bj = 0; bj < 2; ++bj) { const f32x4 v0 = acc[ai][bj][m][0] * sc, v1 = acc[ai][bj][m][1] * sc;
                    if constexpr (O8) { v2u w; w.x = pk4_fp8(v0[0], v0[1], v0[2], v0[3]); w.y = pk4_fp8(v1[0], v1[1], v1[2], v1[3]); *(v2u*)((unsigned char*)O + eo + bj * 128) = w; }
                    else { v4u w; w.x = pg8::cvt_pk_bf16(v0[0], v0[1]); w.y = pg8::cvt_pk_bf16(v0[2], v0[3]); w.z = pg8::cvt_pk_bf16(v1[0], v1[1]); w.w = pg8::cvt_pk_bf16(v1[2], v1[3]);
                        *(v4u*)(O + eo + bj * 128) = w; } } }
    }
};
struct EpiProj {
    static constexpr bool PERM = true, AFTER_DRAIN = false;
    bf16* projb; bf16* Ag;
    __device__ __forceinline__ void operator()(const f32x4 (&acc)[2][2][4][2], const Unit& u, int wr, int wc, int fr, int fq) const {
        const int row0 = u.pm * 256 + wr * 64 + fr;
#pragma unroll
        for (int bj = 0; bj < 2; ++bj) { const int colg = u.pn * 256 + bj * 128 + wc * 32, c0 = colg + 8 * fq;
            if (colg >= INC) continue;
#pragma unroll
            for (int ai = 0; ai < 2; ++ai)
#pragma unroll
                for (int m = 0; m < 4; ++m) { const int row = row0 + ai * 128 + m * 16; const f32x4 v0 = acc[ai][bj][m][0], v1 = acc[ai][bj][m][1]; v4u w;
                    w.x = pg8::cvt_pk_bf16(v0[0], v0[1]); w.y = pg8::cvt_pk_bf16(v0[2], v0[3]); w.z = pg8::cvt_pk_bf16(v1[0], v1[1]); w.w = pg8::cvt_pk_bf16(v1[2], v1[3]);
                    if (colg < PJW) *(v4u*)(projb + (size_t)row * PJW + c0) = w;
                    else { const int ch = c0 - PJW, g = ch >> 4, c = ch & 15; *(v4u*)(Ag + ((size_t)g * 256 + (row >> 5)) * AGW + (row & 31) * 16 + c) = w; } } }
    }
};
struct EpiS5State {
    static constexpr bool PERM = false, AFTER_DRAIN = false;
    float* Sc;
    __device__ __forceinline__ void operator()(const f32x4 (&acc)[2][2][4][2], const Unit& u, int wr, int wc, int fr, int fq) const {
        const int row0 = wr * 64 + fr, col0 = wc * 32 + 4 * fq;
#pragma unroll
        for (int ai = 0; ai < 2; ++ai)
#pragma unroll
            for (int m = 0; m < 4; ++m) { float* rowp = Sc + ((size_t)u.z * 256 + row0 + ai * 128 + m * 16) * 128 + col0;
#pragma unroll
                for (int n = 0; n < 2; ++n) *(f32x4*)(rowp + n * 16) = acc[ai][0][m][n]; }
    }
};
__device__ __forceinline__ float gelu_tanh(float v) {
    const float t = v * (0.7978845608028654f + 0.7978845608028654f * 0.044715f * v * v);
    return v * __builtin_amdgcn_rcpf(1.0f + __builtin_amdgcn_exp2f(-2.885390081777927f * t));
}
struct EpiS5Y {
    static constexpr bool PERM = true, AFTER_DRAIN = false;
    const bf16* Ag; const float* dsk; bf16* Y;
    __device__ __forceinline__ void operator()(const f32x4 (&acc)[2][2][4][2], const Unit& u, int wr, int wc, int fr, int fq) const {
        const int g = u.z, row0 = wr * 64 + fr;
        v4u ub2[2][8]; f32x4 dd[2][2];
#pragma unroll
        for (int bj = 0; bj < 2; ++bj) { const int c0 = u.pn * 256 + bj * 128 + wc * 32 + 8 * fq, co = c0 & 15;
            dd[bj][0] = *(const f32x4*)(dsk + g * 16 + co); dd[bj][1] = *(const f32x4*)(dsk + g * 16 + co + 4);
#pragma unroll
            for (int q = 0; q < 8; ++q) ub2[bj][q] = *(const v4u*)(Ag + ((size_t)g * 256 + row0 + (q >> 2) * 128 + (q & 3) * 16) * AGW + c0); }
#pragma unroll
        for (int bj = 0; bj < 2; ++bj) { const int c0 = u.pn * 256 + bj * 128 + wc * 32 + 8 * fq, i = c0 >> 4, co = c0 & 15;
            const f32x4 d0 = dd[bj][0], d1 = dd[bj][1];
#pragma unroll
            for (int ai = 0; ai < 2; ++ai)
#pragma unroll
                for (int m = 0; m < 4; ++m) { const int r = row0 + ai * 128 + m * 16;
                    const v4u uu = ub2[bj][ai * 4 + m];
                    f32x4 v0 = acc[ai][bj][m][0], v1 = acc[ai][bj][m][1];
                    v0[0] += d0[0] * bflo(uu.x); v0[1] += d0[1] * bfhi(uu.x); v0[2] += d0[2] * bflo(uu.y); v0[3] += d0[3] * bfhi(uu.y);
                    v1[0] += d1[0] * bflo(uu.z); v1[1] += d1[1] * bfhi(uu.z); v1[2] += d1[2] * bflo(uu.w); v1[3] += d1[3] * bfhi(uu.w);
                    v4u w; w.x = pg8::cvt_pk_bf16(gelu_tanh(v0[0]), gelu_tanh(v0[1])); w.y = pg8::cvt_pk_bf16(gelu_tanh(v0[2]), gelu_tanh(v0[3]));
                    w.z = pg8::cvt_pk_bf16(gelu_tanh(v1[0]), gelu_tanh(v1[1])); w.w = pg8::cvt_pk_bf16(gelu_tanh(v1[2]), gelu_tanh(v1[3]));
                    *(v4u*)(Y + ((size_t)(r * 32 + i)) * SSMW + g * 16 + co) = w; } }
    }
};

struct EpiGlu {
    static constexpr bool PERM = true, AFTER_DRAIN = false;
    const bf16* Y; const float* bias; bf16* O;
    __device__ __forceinline__ void operator()(const f32x4 (&acc)[2][2][4][2], const Unit& u, int wr, int wc, int fr, int fq) const {
        const int row0 = u.pm * 256 + wr * 64 + fr;
        v4u yb2[2][8]; f32x4 bb[2][2];
#pragma unroll
        for (int bj = 0; bj < 2; ++bj) { const int c0 = u.pn * 256 + bj * 128 + wc * 32 + 8 * fq;
            bb[bj][0] = *(const f32x4*)(bias + c0); bb[bj][1] = *(const f32x4*)(bias + c0 + 4);
#pragma unroll
            for (int q = 0; q < 8; ++q) yb2[bj][q] = *(const v4u*)(Y + (size_t)(row0 + (q >> 2) * 128 + (q & 3) * 16) * SSMW + c0); }
#pragma unroll
        for (int bj = 0; bj < 2; ++bj) { const int c0 = u.pn * 256 + bj * 128 + wc * 32 + 8 * fq;
            const f32x4 b0 = bb[bj][0], b1 = bb[bj][1];
#pragma unroll
            for (int ai = 0; ai < 2; ++ai)
#pragma unroll
                for (int m = 0; m < 4; ++m) { const size_t off = (size_t)(row0 + ai * 128 + m * 16) * SSMW + c0;
                    const v4u yy = yb2[bj][ai * 4 + m]; const f32x4 z0 = acc[ai][bj][m][0] + b0, z1 = acc[ai][bj][m][1] + b1;
#define SG(z) __builtin_amdgcn_rcpf(1.0f + __builtin_amdgcn_exp2f(-1.4426950408889634f * (z)))
                    v4u w; w.x = pg8::cvt_pk_bf16(bflo(yy.x) * SG(z0[0]), bfhi(yy.x) * SG(z0[1])); w.y = pg8::cvt_pk_bf16(bflo(yy.y) * SG(z0[2]), bfhi(yy.y) * SG(z0[3]));
                    w.z = pg8::cvt_pk_bf16(bflo(yy.z) * SG(z1[0]), bfhi(yy.z) * SG(z1[1])); w.w = pg8::cvt_pk_bf16(bflo(yy.w) * SG(z1[2]), bfhi(yy.w) * SG(z1[3]));
#undef SG
                    *(v4u*)(O + off) = w; } }
    }
};
template <bool F8 = false> struct EpiResid {
    static constexpr bool PERM = false, AFTER_DRAIN = false, FP8 = F8;
    const float* res; float* Xo; bf16* Xb; float* ssq; unsigned char* X8; int zrows;
    __device__ __forceinline__ void operator()(const f32x4 (&acc)[2][2][4][2], const Unit& u, int wr, int wc, int fr, int fq) const {
        const int row0 = (u.z * zrows + u.pm) * 256 + wr * 64 + fr, col0 = u.pn * 256 + wc * 32 + 4 * fq;
        constexpr int RB = 4;
        f32x4 rb[RB][4];
#define ER_LOAD(idx) do { const size_t off_ = (size_t)(row0 + ((idx) >> 2) * 128 + ((idx) & 3) * 16) * D + col0; _Pragma("unroll") for (int q = 0; q < 4; ++q) rb[(idx) % RB][q] = *(const f32x4*)(res + off_ + (q >> 1) * 128 + (q & 1) * 16); } while (0)
#pragma unroll
        for (int i = 0; i < RB - 1; ++i) ER_LOAD(i);
#pragma unroll
        for (int idx = 0; idx < 8; ++idx) { const int ai = idx >> 2, m = idx & 3, row = row0 + ai * 128 + m * 16; const size_t off = (size_t)row * D + col0; float s = 0.f;
            if (idx + RB - 1 < 8) ER_LOAD(idx + RB - 1);
#pragma unroll
            for (int bj = 0; bj < 2; ++bj)
#pragma unroll
                for (int n = 0; n < 2; ++n) { const size_t o2 = off + bj * 128 + n * 16; const f32x4 v = rb[idx % RB][bj * 2 + n] + acc[ai][bj][m][n] * (F8 ? W8_INV : 1.0f);
                    *(f32x4*)(Xo + o2) = v; if (Xb) { v2u w; w.x = pg8::cvt_pk_bf16(v[0], v[1]); w.y = pg8::cvt_pk_bf16(v[2], v[3]); *(v2u*)(Xb + o2) = w; }
                    if (X8) *(unsigned*)(X8 + o2) = pk4_fp8(v[0], v[1], v[2], v[3]);
                    s += (v[0] * v[0] + v[1] * v[1]) + (v[2] * v[2] + v[3] * v[3]); }
            s += __shfl_xor(s, 16); s += __shfl_xor(s, 32);
            if (fq == 0) ssq[(size_t)row * 32 + u.pn * 4 + wc] = s; }
#undef ER_LOAD
    }
};

template <bool FOLD = false> struct EpiSoftmax {
    static constexpr bool PERM = true, AFTER_DRAIN = true, FP8 = FOLD;
    bf16* Pm; const LAS float* rstd;
    __device__ __forceinline__ void fused(f32x4 (&acc)[2][2][4][2], const Unit& u, int wr, int wc, int fr, int fq, PG8_LAS unsigned char* lds, int wid, int lane) const {
        PG8_LAS float* Rm = (PG8_LAS float*)lds;
        PG8_LAS float* Rs = Rm + 1024;
        constexpr float CS = 1.4426950408889634f * 0.04419417382415922f;
        float mx[2][4];
        if constexpr (FOLD) {
#pragma unroll
            for (int ai = 0; ai < 2; ++ai)
#pragma unroll
                for (int m = 0; m < 4; ++m) { const float rs = rstd[ai * 128 + wr * 64 + m * 16 + fr];
#pragma unroll
                    for (int bj = 0; bj < 2; ++bj)
#pragma unroll
                        for (int n = 0; n < 2; ++n) acc[ai][bj][m][n] *= rs; } }
#pragma unroll
        for (int ai = 0; ai < 2; ++ai)
#pragma unroll
            for (int m = 0; m < 4; ++m) { float v = -3.0e38f;
#pragma unroll
                for (int bj = 0; bj < 2; ++bj)
#pragma unroll
                    for (int n = 0; n < 2; ++n) { const f32x4 a = acc[ai][bj][m][n]; v = fmaxf(v, fmaxf(fmaxf(a[0], a[1]), fmaxf(a[2], a[3]))); }
                v = fmaxf(v, __shfl_xor(v, 16)); v = fmaxf(v, __shfl_xor(v, 32));
                if (fq == 0) Rm[(ai * 128 + wr * 64 + m * 16 + fr) * 4 + wc] = v; }
        asm volatile("s_waitcnt lgkmcnt(0)" ::: "memory"); __builtin_amdgcn_s_barrier(); asm volatile("" ::: "memory");
#pragma unroll
        for (int ai = 0; ai < 2; ++ai)
#pragma unroll
            for (int m = 0; m < 4; ++m) { const int r = ai * 128 + wr * 64 + m * 16 + fr; const f32x4 q = *(const PG8_LAS f32x4*)(Rm + r * 4);
                const float rm = fmaxf(fmaxf(q[0], q[1]), fmaxf(q[2], q[3])) * CS; mx[ai][m] = rm; float s = 0.f;
#pragma unroll
                for (int bj = 0; bj < 2; ++bj)
#pragma unroll
                    for (int n = 0; n < 2; ++n) { f32x4 a = acc[ai][bj][m][n];
#pragma unroll
                        for (int e = 0; e < 4; ++e) { a[e] = __builtin_amdgcn_exp2f(fmaf(a[e], CS, -rm)); s += a[e]; }
                        acc[ai][bj][m][n] = a; }
                s += __shfl_xor(s, 16); s += __shfl_xor(s, 32);
                if (fq == 0) Rs[r * 4 + wc] = s; }
        asm volatile("s_waitcnt lgkmcnt(0)" ::: "memory"); __builtin_amdgcn_s_barrier(); asm volatile("" ::: "memory");
        bf16* base = FOLD ? Pm + (size_t)u.z * SEQ * (XH * MEM) + u.pn * MEM : Pm + (size_t)u.z * SEQ * MEM;
        constexpr int PLD = FOLD ? XH * MEM : MEM;
#pragma unroll
        for (int ai = 0; ai < 2; ++ai)
#pragma unroll
            for (int m = 0; m < 4; ++m) { const int r = ai * 128 + wr * 64 + m * 16 + fr; const f32x4 q = *(const PG8_LAS f32x4*)(Rs + r * 4);
                const float inv = __builtin_amdgcn_rcpf((q[0] + q[1]) + (q[2] + q[3])) * (FOLD ? W8_SCALE : 1.0f);
                if constexpr (FOLD) {
                    unsigned char* rowp8 = (unsigned char*)Pm + (size_t)u.z * SEQ * PLD + (size_t)(u.pm * 256 + r) * PLD + u.pn * MEM + wc * 32 + 8 * fq;
#pragma unroll
                    for (int bj = 0; bj < 2; ++bj) { const f32x4 v0 = acc[ai][bj][m][0] * inv, v1 = acc[ai][bj][m][1] * inv; v2u w;
                        w.x = pk4_fp8(v0[0], v0[1], v0[2], v0[3]); w.y = pk4_fp8(v1[0], v1[1], v1[2], v1[3]); *(v2u*)(rowp8 + bj * 128) = w; }
                } else {
                bf16* rowp = base + (size_t)(u.pm * 256 + r) * PLD + wc * 32 + 8 * fq;
#pragma unroll
                for (int bj = 0; bj < 2; ++bj) { const f32x4 v0 = acc[ai][bj][m][0] * inv, v1 = acc[ai][bj][m][1] * inv; v4u w;
                    w.x = pg8::cvt_pk_bf16(v0[0], v0[1]); w.y = pg8::cvt_pk_bf16(v0[2], v0[3]); w.z = pg8::cvt_pk_bf16(v1[0], v1[1]); w.w = pg8::cvt_pk_bf16(v1[2], v1[3]);
                    *(v4u*)(rowp + bj * 128) = w; } } }
        (void)mx;
    }
};

struct EpiVW {
    static constexpr bool PERM = true, AFTER_DRAIN = false, FP8 = true;
    bf16* O;
    __device__ __forceinline__ void operator()(const f32x4 (&acc)[2][2][4][2], const Unit& u, int wr, int wc, int fr, int fq) const {
        const int row0 = u.pm * 256 + wr * 64 + fr;
#pragma unroll
        for (int ai = 0; ai < 2; ++ai)
#pragma unroll
            for (int m = 0; m < 4; ++m) { unsigned char* rowp = (unsigned char*)O + ((size_t)u.pn * D + row0 + ai * 128 + m * 16) * (XH * MEM) + u.z * MEM + wc * 32 + 8 * fq;
#pragma unroll
                for (int bj = 0; bj < 2; ++bj) { const f32x4 v0 = acc[ai][bj][m][0] * W8_INV, v1 = acc[ai][bj][m][1] * W8_INV; v2u w;
                    w.x = pk4_fp8(v0[0], v0[1], v0[2], v0[3]); w.y = pk4_fp8(v1[0], v1[1], v1[2], v1[3]); *(v2u*)(rowp + bj * 128) = w; } }
    }
};
template <bool GATHER_> struct MoeSched {
    static constexpr bool GATHER = GATHER_;
    int NB, nN, G, c, lda; const char* A; const char* B; long tA, eB, tB;
    const LAS int* blkE; const LAS int* tokTab;
    __device__ __forceinline__ bool next(int i, Unit& u) const { const int L = i * G + c; if (L >= NB * nN) return false; u.z = L / nN; u.pn = L % nN; u.pm = i; return true; }
    __device__ __forceinline__ void ptrs(const Unit& u, const char*& a, const char*& b_) const { const int e = blkE[u.z]; a = GATHER_ ? A : A + (long)u.z * tA; b_ = B + (long)e * eB + (long)u.pn * tB; }
    __device__ __forceinline__ unsigned row_off(int ui, int row) const { return (unsigned)tokTab[ui * 256 + row] * (unsigned)lda; }
    __device__ __forceinline__ bool half1(const Unit& u) const { return blkE[320 + u.z] > 128; }
    __device__ __forceinline__ void a_ready(const Unit&) const {}
    __device__ __forceinline__ void done(const Unit&) const {}
};
struct EpiMoeUp {
    static constexpr bool PERM = true, AFTER_DRAIN = false, FP8 = true;
    const LAS int* blkE; const LAS int* tokTab; const float* ssq; const float* bup; unsigned char* ACT;
    __device__ __forceinline__ void operator()(const f32x4 (&acc)[2][2][4][2], const Unit& u, int wr, int wc, int fr, int fq) const {
        asm volatile("" : "+v"(fr), "+v"(fq));
        const int e = blkE[u.z], c0 = u.pn * 128 + wc * 32 + 8 * fq, row0 = wr * 64 + fr;
        const float* bg = bup + (size_t)e * 2 * FF + c0; const f32x4 g0 = *(const f32x4*)bg, g1 = *(const f32x4*)(bg + 4), l0 = *(const f32x4*)(bg + FF), l1 = *(const f32x4*)(bg + FF + 4);
        float rsb[8];
#pragma unroll
        for (int q = 0; q < 8; ++q) rsb[q] = ssq[tokTab[u.pm * 256 + row0 + (q >> 2) * 128 + (q & 3) * 16]] * W8_INV;
#pragma unroll
        for (int ai = 0; ai < 2; ++ai)
#pragma unroll
            for (int m = 0; m < 4; ++m) { const int r = row0 + ai * 128 + m * 16; const float rs = rsb[ai * 4 + m];
                float a[8];
#pragma unroll
                for (int j = 0; j < 8; ++j) { const float gb = j < 4 ? g0[j & 3] : g1[j & 3], lb = j < 4 ? l0[j & 3] : l1[j & 3];
                    const float gl = fminf(acc[ai][0][m][j >> 2][j & 3] * rs + gb, 7.0f), ln = fminf(fmaxf(acc[ai][1][m][j >> 2][j & 3] * rs + lb, -7.0f), 7.0f);
                    a[j] = gl * __builtin_amdgcn_rcpf(1.0f + __builtin_amdgcn_exp2f(-1.702f * 1.4426950408889634f * gl)) * (ln + 1.0f); }
                v2u w; w.x = pk4_fp8(a[0], a[1], a[2], a[3]); w.y = pk4_fp8(a[4], a[5], a[6], a[7]);
                *(v2u*)(ACT + ((size_t)u.z * 256 + r) * FF + c0) = w; }
    }
};
constexpr float Y8_SCALE = 32.0f, Y8_INV = 1.0f / 32.0f;
struct EpiMoeDown {
    static constexpr bool PERM = true, AFTER_DRAIN = false, FP8 = true;
    const LAS int* blkE; const float* bdn; unsigned char* YK;
    __device__ __forceinline__ void operator()(const f32x4 (&acc)[2][2][4][2], const Unit& u, int wr, int wc, int fr, int fq) const {
        const int e = blkE[u.z], row0 = wr * 64 + fr;
        f32x4 bq[2][2];
#pragma unroll
        for (int bj = 0; bj < 2; ++bj) { const int c0 = u.pn * 256 + bj * 128 + wc * 32 + 8 * fq; bq[bj][0] = *(const f32x4*)(bdn + (size_t)e * D + c0); bq[bj][1] = *(const f32x4*)(bdn + (size_t)e * D + c0 + 4); }
#pragma unroll
        for (int bj = 0; bj < 2; ++bj) { const int c0 = u.pn * 256 + bj * 128 + wc * 32 + 8 * fq; const f32x4 b0 = bq[bj][0] * Y8_SCALE, b1 = bq[bj][1] * Y8_SCALE;
#pragma unroll
            for (int ai = 0; ai < 2; ++ai)
#pragma unroll
                for (int m = 0; m < 4; ++m) { const int r = row0 + ai * 128 + m * 16; const f32x4 v0 = acc[ai][bj][m][0] * (W8_INV * Y8_SCALE) + b0, v1 = acc[ai][bj][m][1] * (W8_INV * Y8_SCALE) + b1; v2u w;
                    w.x = pk4_fp8(v0[0], v0[1], v0[2], v0[3]); w.y = pk4_fp8(v1[0], v1[1], v1[2], v1[3]);
                    *(v2u*)(YK + ((size_t)u.z * 256 + r) * D + c0) = w; } }
    }
};
__device__ __forceinline__ int moe_block_table(const unsigned* counts, LAS int* blkE, int tid) {
    if (tid < 64) {
        const int cnt = tid < E ? (int)counts[tid * CNT_STRIDE] : 0, nb = (cnt + 255) >> 8;
        int inc = nb;
#pragma unroll
        for (int o = 1; o < 64; o <<= 1) { const int v = __shfl_up(inc, o); if (tid >= o) inc += v; }
        const int base = inc - nb;
        for (int j = 0; j < nb; ++j) { blkE[base + j] = tid; blkE[160 + base + j] = j; const int left = cnt - j * 256; blkE[320 + base + j] = left < 256 ? left : 256; }
        if (tid == 63) blkE[480] = inc;
    }
    __syncthreads();
    return blkE[480];
}

struct TItem { const float* src; bf16* dst; const float* gain; int N, ldk; };
template <bool GAIN> __device__ __forceinline__ void titem_load(const TItem& d, int lane, f32x4 (&r)[16], f32x4 (&g)[4]) {
    const int q = lane & 15, kg = lane >> 4; const float* p = d.src + (size_t)(8 * kg) * d.N + 4 * q;
#pragma unroll
    for (int j = 0; j < 16; ++j) r[j] = *(const GAS f32x4*)(p + (size_t)(32 * (j >> 3) + (j & 7)) * d.N);
    if constexpr (GAIN) {
#pragma unroll
        for (int j4 = 0; j4 < 4; ++j4) g[j4] = *(const GAS f32x4*)(d.gain + 32 * (j4 >> 1) + 8 * kg + 4 * (j4 & 1)); }
    asm volatile("" ::: "memory"); __builtin_amdgcn_sched_barrier(0);
}
template <bool GAIN> __device__ __forceinline__ void titem_store(const TItem& d, int lane, const f32x4 (&r)[16], const f32x4 (&g)[4]) {
    const int q = lane & 15, kg = lane >> 4;
    bf16* o = d.dst + (size_t)(4 * q) * d.ldk + 8 * kg;
#define TG(j) (GAIN ? g[(j) >> 2][(j) & 3] : 1.0f)
#pragma unroll
    for (int i = 0; i < 4; ++i)
#pragma unroll
        for (int h = 0; h < 2; ++h) { v4u w;
            w.x = pg8::cvt_pk_bf16(r[8 * h + 0][i] * TG(8 * h + 0), r[8 * h + 1][i] * TG(8 * h + 1)); w.y = pg8::cvt_pk_bf16(r[8 * h + 2][i] * TG(8 * h + 2), r[8 * h + 3][i] * TG(8 * h + 3));
            w.z = pg8::cvt_pk_bf16(r[8 * h + 4][i] * TG(8 * h + 4), r[8 * h + 5][i] * TG(8 * h + 5)); w.w = pg8::cvt_pk_bf16(r[8 * h + 6][i] * TG(8 * h + 6), r[8 * h + 7][i] * TG(8 * h + 7));
            *(GAS v4u*)(o + (size_t)i * d.ldk + 32 * h) = w; }
#undef TG
}
template <bool GAIN, bool NT = false> __device__ __forceinline__ void titem8_load(const TItem& d, int lane, f32x4 (&r)[16], f32x4 (&g)[4]) {
    const int q = lane & 7, kg = lane >> 3; const unsigned lo = (unsigned)((16 * kg) * d.N + 4 * q) * 4u;
    const GAS char* base = (const GAS char*)d.src;
#pragma unroll
    for (int j = 0; j < 16; ++j) { const GAS f32x4* p = (const GAS f32x4*)(base + (size_t)j * (size_t)d.N * 4 + lo); r[j] = NT ? __builtin_nontemporal_load(p) : *p; }
    if constexpr (GAIN) { const GAS char* gb = (const GAS char*)d.gain; const unsigned go = (unsigned)(16 * kg) * 4u;
#pragma unroll
        for (int j4 = 0; j4 < 4; ++j4) g[j4] = *(const GAS f32x4*)(gb + 16 * j4 + go); }
    asm volatile("" ::: "memory"); __builtin_amdgcn_sched_barrier(0);
}
template <bool GAIN, bool NT = false> __device__ __forceinline__ void titem8_store(const TItem& d, int lane, const f32x4 (&r)[16], const f32x4 (&g)[4]) {
    const int q = lane & 7, kg = lane >> 3; const unsigned lo = (unsigned)((4 * q) * d.ldk + 16 * kg);
    GAS char* base = (GAS char*)d.dst;
    f32x4 s[16];
#pragma unroll
    for (int j = 0; j < 16; ++j) s[j] = r[j] * ((GAIN ? g[j >> 2][j & 3] : 1.0f) * W8_SCALE);
#pragma unroll
    for (int i = 0; i < 4; ++i) { v4u w;
        w.x = pk4_fp8w(s[0][i], s[1][i], s[2][i], s[3][i]); w.y = pk4_fp8w(s[4][i], s[5][i], s[6][i], s[7][i]);
        w.z = pk4_fp8w(s[8][i], s[9][i], s[10][i], s[11][i]); w.w = pk4_fp8w(s[12][i], s[13][i], s[14][i], s[15][i]);
        GAS v4u* p = (GAS v4u*)(base + (size_t)i * (size_t)d.ldk + lo);
        if (NT) __builtin_nontemporal_store(w, p); else *p = w; }
}
#define TSTREAM(n_, DEC, LOAD, STORE) do { f32x4 ra[16], rb[16], ga[4], gb[4]; int it0 = gw; \
        if (it0 < (n_)) { TItem d0 = DEC(it0); LOAD(d0, lane, ra, ga); \
            for (;;) { const int it1 = it0 + NGW; \
                if (!(it1 < (n_))) { STORE(d0, lane, ra, ga); break; } \
                TItem d1 = DEC(it1); LOAD(d1, lane, rb, gb); STORE(d0, lane, ra, ga);            \
                it0 = it1 + NGW; \
                if (!(it0 < (n_))) { STORE(d1, lane, rb, gb); break; } \
                d0 = DEC(it0); LOAD(d0, lane, ra, ga); STORE(d1, lane, rb, gb); } } } while (0)

#define TI8S_NT titem8_store<false, true>
#define TI8L_NT titem8_load<false, true>
struct MoeSchedUpCv : MoeSched<true> {
    const float* wdn; unsigned char* wdn8; int wave;
    __device__ __forceinline__ TItem dec_dn(int it) const { constexpr int I_DN = (FF / 128) * (D / 32); TItem d; int r = it; const int e = r / I_DN; r -= e * I_DN;
        const int nb_ = D / 32, kb = r / nb_, nbi = r % nb_; d.src = wdn + (size_t)e * FF * D + (size_t)(128 * kb) * D + 32 * nbi; d.dst = (bf16*)(wdn8 + (size_t)e * D * FF + (size_t)(32 * nbi) * FF + 128 * kb);
        d.gain = wdn; d.N = D; d.ldk = FF; return d; }
    __device__ __forceinline__ void convert_share() const {
        const int lane = lane_id_now(), gw = c * NWAVES + wave, NGW = G * NWAVES;
        constexpr int NIT = E * (FF / 128) * (D / 32);
        TSTREAM(NIT, dec_dn, TI8L_NT, TI8S_NT);
    }
    __device__ __forceinline__ void done(const Unit& u) const { if (u.pm == (c & 7)) convert_share(); }
};

constexpr int CV_I_UP = (D / 128) * (2 * FF / 32), CV_ITEMS = E * CV_I_UP;
constexpr int CV_BATCH = 4;
struct CvWork { const float* wup; const float* gain; unsigned char* wup8; volatile LAS int* cur; volatile LAS unsigned* rel; unsigned* q; int wave; };
__device__ __forceinline__ bool cv_one(const CvWork& w) {
    if (w.wave == 0) return false;
    int it = __builtin_amdgcn_readfirstlane(w.cur[2 * w.wave]); const int end = __builtin_amdgcn_readfirstlane(w.cur[2 * w.wave + 1]);
    if (it >= end) {
        if (it > CV_ITEMS) return false;
        unsigned base = 0u; if (lane_id_now() == 0) base = __hip_atomic_fetch_add(w.q, (unsigned)CV_BATCH, __ATOMIC_RELAXED, __HIP_MEMORY_SCOPE_AGENT);
        base = __builtin_amdgcn_readfirstlane(base);
        if (base >= (unsigned)CV_ITEMS) { w.cur[2 * w.wave] = CV_ITEMS + 1; w.cur[2 * w.wave + 1] = 0; return false; }
        it = (int)base; w.cur[2 * w.wave + 1] = (int)base + CV_BATCH;
    }
    TItem d; { int r = it; const int e = r / CV_I_UP; r -= e * CV_I_UP; const int nb_ = 2 * FF / 32, kb = r / nb_, nbi = r % nb_;
        d.src = w.wup + (size_t)e * D * 2 * FF + (size_t)(128 * kb) * (2 * FF) + 32 * nbi; d.dst = (bf16*)(w.wup8 + (size_t)e * 2 * FF * D + (size_t)(32 * nbi) * D + 128 * kb);
        d.gain = w.gain + 128 * kb; d.N = 2 * FF; d.ldk = D; }
    const int lane = lane_id_now();
    f32x4 r[16], g[4]; titem8_load<true, true>(d, lane, r, g); titem8_store<true, true>(d, lane, r, g);
    w.cur[2 * w.wave] = it + 1;
    return true;
}
__device__ __forceinline__ void cv_flush(const CvWork& w) { while (cv_one(w)) {} }
__device__ __forceinline__ void xcd_barrier_cv(const XcdBarrier& b, const CvWork& w) {
    asm volatile("s_waitcnt vmcnt(0)" ::: "memory");
    const unsigned g0 = w.rel[0];
    __syncthreads();
    if (b.wave == 0) {
        xb_wave0(b, w.rel + 1, g0 + 1u);
        w.rel[0] = g0 + 1u;
    } else if (b.wave != 0) {
        unsigned guard = 0;
        while (w.rel[0] == g0) { if (w.rel[1] == g0 + 1u) { __builtin_amdgcn_s_sleep(1); continue; }
            if (!cv_one(w)) __builtin_amdgcn_s_sleep(4); if (++guard > (1u << 22)) break; }
    }
    asm volatile("s_waitcnt lgkmcnt(0)" ::: "memory"); __builtin_amdgcn_s_barrier(); asm volatile("" ::: "memory");
}

namespace mla {
typedef short s16x4 __attribute__((ext_vector_type(4)));
typedef float f32x16 __attribute__((ext_vector_type(16)));
constexpr int KVBLK = 64, QB = 256;
constexpr int SHM_V = KVBLK * 128 * 2, SHM_K = KVBLK * 128 * 2, SHM_P = KVBLK * 64 * 2;
constexpr int BUFB = SHM_V + SHM_K + SHM_P, V_OFF = 0, K_OFF = SHM_V, P_OFF = SHM_V + SHM_K, NBUF = 3, W_OFF = NBUF * BUFB;
constexpr float C2 = 1.4426950408889634f * 0.07216878364870322f;
#define KSWZ(row, colB) ((row) * 256 + ((colB) ^ (((row) & 7) << 4)))
#define KPSWZ(row, colB) ((row) * 128 + ((colB) ^ ((((row) >> 1) & 7) << 4)))
#define SBAR() __builtin_amdgcn_sched_barrier(0)
__device__ __forceinline__ int v_st(int k, int c) { const int kk = (k & ~0xC) | ((k & 4) << 1) | ((k & 8) >> 1); return ((kk >> 3) * 4 + (c >> 5)) * 512 + ((kk & 7) * 32 + (c & 31)) * 2; }
__device__ __forceinline__ int v_rd_base(int lane) { return ((lane & 3) << 3) | (((lane >> 2) & 3) << 6) | (((lane >> 4) & 1) << 5) | (((lane >> 5) & 1) << 8); }
constexpr int v_rd_off(int d0, int ks, int half) { return d0 * 512 + ks * 4096 + half * 2048; }
__device__ __forceinline__ int crow(int r, int hi) { return (r & 3) + 8 * (r >> 2) + 4 * hi; }
__device__ __forceinline__ unsigned cvtpk(float lo, float hi) { unsigned r; asm volatile("v_cvt_pk_bf16_f32 %0, %1, %2" : "=v"(r) : "v"(lo), "v"(hi)); return r; }

__device__ __forceinline__ void mask_tile(f32x16& p0, f32x16& p1, int dq) {
    const float NEG = -__builtin_inff();
#pragma unroll
    for (int r = 0; r < 16; ++r) { const int c = (r & 3) + 8 * (r >> 2);
        if (dq - c < 0) p0[r] = NEG;
        if (dq - c - 32 < 0) p1[r] = NEG; }
}
__device__ __forceinline__ void partialSM(f32x16& p0, f32x16& p1, float& m_reg, float& mn, float& alpha) {
    float pmax = p0[0];
#pragma unroll
    for (int r = 1; r < 16; ++r) pmax = fmaxf(pmax, p0[r]);
#pragma unroll
    for (int r = 0; r < 16; ++r) pmax = fmaxf(pmax, p1[r]);
    { auto rr = __builtin_amdgcn_permlane32_swap(__float_as_uint(pmax), __float_as_uint(pmax), false, false);
      pmax = fmaxf(__uint_as_float(rr[0]), __uint_as_float(rr[1])); }
    mn = fmaxf(m_reg, pmax); alpha = __builtin_amdgcn_exp2f((m_reg - mn) * C2); m_reg = mn;
    const float mnL = -mn * C2;
#pragma unroll
    for (int r = 0; r < 16; ++r) p0[r] = __builtin_amdgcn_exp2f(fmaf(p0[r], C2, mnL));
#pragma unroll
    for (int r = 0; r < 16; ++r) p1[r] = __builtin_amdgcn_exp2f(fmaf(p1[r], C2, mnL));
}
__device__ __forceinline__ void finishSM(f32x16& p0, f32x16& p1, float alpha, float& l_reg, bf16x8& pa0, bf16x8& pa1, bf16x8& pa2, bf16x8& pa3) {
    float ps = 0;
#pragma unroll
    for (int r = 0; r < 16; ++r) ps += p0[r];
#pragma unroll
    for (int r = 0; r < 16; ++r) ps += p1[r];
    { auto rr = __builtin_amdgcn_permlane32_swap(__float_as_uint(ps), __float_as_uint(ps), false, false);
      ps = __uint_as_float(rr[0]) + __uint_as_float(rr[1]); }
    l_reg = l_reg * alpha + ps;
#define PK4(P, B_, OUT) do { unsigned a0 = cvtpk(P[B_+0], P[B_+1]), a1 = cvtpk(P[B_+2], P[B_+3]);                          \
        unsigned b0 = cvtpk(P[B_+4], P[B_+5]), b1 = cvtpk(P[B_+6], P[B_+7]);                                             \
        auto r0 = __builtin_amdgcn_permlane32_swap(a0, b0, false, false); auto r1 = __builtin_amdgcn_permlane32_swap(a1, b1, false, false); \
        v4u w = {r0[0], r1[0], r0[1], r1[1]}; OUT = *reinterpret_cast<bf16x8*>(&w); } while (0)
    PK4(p0, 0, pa0); PK4(p0, 8, pa1); PK4(p1, 0, pa2); PK4(p1, 8, pa3);
#undef PK4
}
__device__ __forceinline__ void qkt(f32x16& p0, f32x16& p1, LAS unsigned char* lds  , int r32, int hi, const bf16x8* qr) {
    p0 = f32x16{}; p1 = f32x16{};
    const LAS unsigned char* kb[4];
#pragma unroll
    for (int dd = 0; dd < 4; ++dd) kb[dd] = lds + K_OFF + KSWZ(r32, (dd * 16 + hi * 8) * 2);
#pragma unroll
    for (int d0 = 0; d0 < 8; ++d0) { const LAS unsigned char* a = kb[d0 & 3] + (d0 >> 2) * 128;
        const bf16x8 b0 = *(const LAS bf16x8*)(a);
        const bf16x8 b1 = *(const LAS bf16x8*)(a + 32 * 256);
        p0 = __builtin_amdgcn_mfma_f32_32x32x16_bf16(b0, qr[d0], p0, 0, 0, 0);
        p1 = __builtin_amdgcn_mfma_f32_32x32x16_bf16(b1, qr[d0], p1, 0, 0, 0); }
#pragma unroll
    for (int e = 0; e < 4; ++e) { const LAS unsigned char* a = lds + P_OFF + KPSWZ(r32, (e * 2 + hi) * 16);
        const bf16x8 b0 = *(const LAS bf16x8*)(a);
        const bf16x8 b1 = *(const LAS bf16x8*)(a + 32 * 128);
        p0 = __builtin_amdgcn_mfma_f32_32x32x16_bf16(b0, qr[8 + e], p0, 0, 0, 0);
        p1 = __builtin_amdgcn_mfma_f32_32x32x16_bf16(b1, qr[8 + e], p1, 0, 0, 0); }
}
__device__ __forceinline__ void pv_tile(f32x16* o, int vb0  , bf16x8 pa0, bf16x8 pa1, bf16x8 pa2, bf16x8 pa3) {
#define TRRD(dst, off) asm volatile("ds_read_b64_tr_b16 %0, %1 offset:%2" : "=&v"(dst) : "v"(vb0), "i"(off) : "memory")
#define PV_D0(d0) do { s16x4 l0, l1, l2, l3, h0, h1, h2, h3; constexpr int b_ = V_OFF + v_rd_off(d0, 0, 0); \
        TRRD(l0, b_); TRRD(h0, b_ + 2048); TRRD(l1, b_ + 4096); TRRD(h1, b_ + 6144); TRRD(l2, b_ + 8192); TRRD(h2, b_ + 10240); TRRD(l3, b_ + 12288); TRRD(h3, b_ + 14336); \
        asm volatile("s_waitcnt lgkmcnt(0)" ::: "memory"); SBAR();   \
        o[d0] = __builtin_amdgcn_mfma_f32_32x32x16_bf16(pa0, (bf16x8){l0[0], l0[1], l0[2], l0[3], h0[0], h0[1], h0[2], h0[3]}, o[d0], 0, 0, 0);   \
        o[d0] = __builtin_amdgcn_mfma_f32_32x32x16_bf16(pa1, (bf16x8){l1[0], l1[1], l1[2], l1[3], h1[0], h1[1], h1[2], h1[3]}, o[d0], 0, 0, 0);   \
        o[d0] = __builtin_amdgcn_mfma_f32_32x32x16_bf16(pa2, (bf16x8){l2[0], l2[1], l2[2], l2[3], h2[0], h2[1], h2[2], h2[3]}, o[d0], 0, 0, 0);   \
        o[d0] = __builtin_amdgcn_mfma_f32_32x32x16_bf16(pa3, (bf16x8){l3[0], l3[1], l3[2], l3[3], h3[0], h3[1], h3[2], h3[3]}, o[d0], 0, 0, 0); } while (0)
    PV_D0(0); PV_D0(1); PV_D0(2); PV_D0(3);
#undef PV_D0
#undef TRRD
}

__device__ __forceinline__ void attn_unit(LAS unsigned char* lds, int b, int h, int qb, const bf16* Q  , const bf16* KV  , const bf16* KPE  ,
                                          const float* ROPE  , bf16* O  , const int wave_) {
    int tid_ = wave_ * 64 + lane_id_now(); asm volatile("" : "+v"(tid_));
    const int tid = tid_, wid = __builtin_amdgcn_readfirstlane(tid >> 6), lane = tid & 63, r32 = lane & 31, hi = lane >> 5;
    const int NT = ((15 - qb) * 128 + 128) / KVBLK;
    const int qlo = (wid < 4 ? qb * 128 + wid * 32 : (15 - qb) * 128 + (wid - 4) * 32), qm = qlo + r32 - 4 * hi;
    const size_t tok0 = (size_t)b * SEQ;
    bf16x8 qr[12];
    { const size_t t = tok0 + qlo + r32; const bf16* qp = Q + t * 1536 + h * 192 + hi * 8;
#pragma unroll
      for (int d0 = 0; d0 < 12; ++d0) qr[d0] = *(const bf16x8*)(qp + d0 * 16);
      const float* rp = ROPE + t * 64 + hi * 8;
#pragma unroll
      for (int e = 0; e < 2; ++e) {
          const f32x4 c0 = *(const f32x4*)(rp + 16 * e), c1 = *(const f32x4*)(rp + 16 * e + 4), s0 = *(const f32x4*)(rp + 32 + 16 * e), s1 = *(const f32x4*)(rp + 32 + 16 * e + 4);
          const v4u xa = *reinterpret_cast<v4u*>(&qr[8 + e]), xb = *reinterpret_cast<v4u*>(&qr[10 + e]); v4u ya, yb;
#define ROPE2(W, CL, CH, SL, SH) { const float a0 = bflo(xa.W), a1 = bfhi(xa.W), b0 = bflo(xb.W), b1 = bfhi(xb.W); \
          ya.W = cvtpk(a0 * CL - b0 * SL, a1 * CH - b1 * SH); yb.W = cvtpk(b0 * CL + a0 * SL, b1 * CH + a1 * SH); }
          ROPE2(x, c0[0], c0[1], s0[0], s0[1]); ROPE2(y, c0[2], c0[3], s0[2], s0[3]); ROPE2(z, c1[0], c1[1], s1[0], s1[1]); ROPE2(w, c1[2], c1[3], s1[2], s1[3]);
#undef ROPE2
          qr[8 + e] = *reinterpret_cast<bf16x8*>(&ya); qr[10 + e] = *reinterpret_cast<bf16x8*>(&yb); } }
    const int vb0 = (int)(uintptr_t)(lds) + v_rd_base(lane);
    LAS float* wsf = (LAS float*)(lds + W_OFF) + wid * 64; LAS float* li_l = wsf; LAS float* al_l = wsf + 32;
    unsigned so[5];
#pragma unroll
    for (int p = 0; p < 2; ++p) { const int s = p * 512 + tid;
        { const int sub = s >> 5, within = s & 31, kk = (sub >> 2) * 8 + (within >> 2), k = (kk & ~0xC) | ((kk & 4) << 1) | ((kk & 8) >> 1), c = (sub & 3) * 32 + (within & 3) * 8;
          so[p] = (unsigned)(k * 2048 + h * 256 + 128 + c); }
        { const int row = s >> 4, chunk = (s & 15) ^ (row & 7); so[2 + p] = (unsigned)(row * 2048 + h * 256 + chunk * 8); } }
    { const int row = tid >> 3, chunk = (tid & 7) ^ ((row >> 1) & 7); so[4] = (unsigned)(row * 64 + chunk * 8); }
    const bf16* KVt = KV + tok0 * 2048; const bf16* KPt = KPE + tok0 * 64;
#define AISSUE(tile, bufoff) do { const bf16* kv_ = KVt + (size_t)(tile) * (KVBLK * 2048); const bf16* kp_ = KPt + (size_t)(tile) * (KVBLK * 64); \
        __builtin_amdgcn_global_load_lds((const unsigned*)(kv_ + so[0]), (LAS unsigned*)(lds + (bufoff) + V_OFF + wid * 1024), 16, 0, 0); \
        __builtin_amdgcn_global_load_lds((const unsigned*)(kv_ + so[1]), (LAS unsigned*)(lds + (bufoff) + V_OFF + 8192 + wid * 1024), 16, 0, 0); \
        __builtin_amdgcn_global_load_lds((const unsigned*)(kv_ + so[2]), (LAS unsigned*)(lds + (bufoff) + K_OFF + wid * 1024), 16, 0, 0); \
        __builtin_amdgcn_global_load_lds((const unsigned*)(kv_ + so[3]), (LAS unsigned*)(lds + (bufoff) + K_OFF + 8192 + wid * 1024), 16, 0, 0); \
        __builtin_amdgcn_global_load_lds((const unsigned*)(kp_ + so[4]), (LAS unsigned*)(lds + (bufoff) + P_OFF + wid * 1024), 16, 0, 0); } while (0)
    float m_reg = -1e30f, l_reg = 0.f; f32x16 o[4] = {};
    f32x16 p0, p1; float mn, alpha; bf16x8 pa0, pa1, pa2, pa3;
    asm volatile("s_waitcnt vmcnt(0)" ::: "memory");
    AISSUE(0, 0); AISSUE(1, BUFB);
    int bc = 0, bl = 2 * BUFB;
    for (int t = 0; t < NT; ++t) {
        asm volatile("s_waitcnt vmcnt(5)" ::: "memory"); __builtin_amdgcn_s_barrier();
        { const int tn = (t + 2 < NT) ? t + 2 : NT - 1; AISSUE(tn, bl); }
        const int kb_ = t * KVBLK;
        if (kb_ <= qlo + 31) {
            SBAR(); qkt(p0, p1, lds + bc, r32, hi, qr);
            if (kb_ + KVBLK - 1 > qlo) mask_tile(p0, p1, qm - kb_);
            partialSM(p0, p1, m_reg, mn, alpha);
            if (__any(alpha < 1.f)) { if (hi == 0) al_l[r32] = alpha; LDS_WAIT();
#pragma unroll
                for (int d_ = 0; d_ < 4; ++d_)
#pragma unroll
                    for (int r = 0; r < 16; ++r) o[d_][r] *= al_l[crow(r, hi)]; }
            finishSM(p0, p1, alpha, l_reg, pa0, pa1, pa2, pa3); SBAR();
            pv_tile(o, vb0 + bc, pa0, pa1, pa2, pa3); }
        bc = (bc == 2 * BUFB) ? 0 : bc + BUFB; bl = (bl == 2 * BUFB) ? 0 : bl + BUFB;
    }
#undef AISSUE
    asm volatile("s_waitcnt vmcnt(0)" ::: "memory");
    if (hi == 0) li_l[r32] = l_reg; LDS_WAIT();
    bf16* Ow = O + (tok0 + qlo) * 1024 + h * 128;
#pragma unroll
    for (int r = 0; r < 16; ++r) { const int orow = crow(r, hi); const float rl = __builtin_amdgcn_rcpf(li_l[orow]);
#pragma unroll
        for (int d0 = 0; d0 < 4; ++d0) { const float v = o[d0][r] * rl; const float vn = __shfl_xor(v, 1);
            if ((r32 & 1) == 0) *(unsigned*)(Ow + (size_t)orow * 1024 + d0 * 32 + r32) = cvtpk(v, vn); } }
    __syncthreads();
}
#undef KSWZ
#undef KPSWZ
#undef SBAR
}

struct Args { const void* in[36]; float* out; unsigned char* ws; int ph_lo, ph_hi, li, pad; };
constexpr int N_PHASES = 15;

__device__ __forceinline__ void mla_thin_token(int t, int lane, const bf16* projb, const float* qg, const float* kvg, const int* pos, bf16* cqn, bf16* ckvn, bf16* kpe, float* rope) {
    const unsigned* pr = (const unsigned*)(projb + (size_t)t * PJW);
    unsigned wq[3], wk[2]; float sq = 0.f, sk = 0.f;
    v2f gq[3], gk[2];
#pragma unroll
    for (int j = 0; j < 3; ++j) { wq[j] = pr[lane + 64 * j]; gq[j] = *(const v2f*)(qg + 2 * (lane + 64 * j)); }
#pragma unroll
    for (int j = 0; j < 2; ++j) { wk[j] = pr[192 + lane + 64 * j]; gk[j] = *(const v2f*)(kvg + 2 * (lane + 64 * j)); }
    const int pos_t = pos[t]; const bf16* kp = projb + (size_t)t * PJW + 640; const float x1 = bf2f(kp[lane & 31]), x2 = bf2f(kp[(lane & 31) + 32]);
#pragma unroll
    for (int j = 0; j < 3; ++j) { const float a = bflo(wq[j]), b = bfhi(wq[j]); sq += a * a + b * b; }
#pragma unroll
    for (int j = 0; j < 2; ++j) { const float a = bflo(wk[j]), b = bfhi(wk[j]); sk += a * a + b * b; }
    const float rq = rsqrtf(wave_sum(sq) * (1.f / QL) + EPS), rk = rsqrtf(wave_sum(sk) * (1.f / KVL) + EPS);
#pragma unroll
    for (int j = 0; j < 3; ++j) ((unsigned*)(cqn + (size_t)t * QL))[lane + 64 * j] = pk2(bflo(wq[j]) * rq * gq[j][0], bfhi(wq[j]) * rq * gq[j][1]);
#pragma unroll
    for (int j = 0; j < 2; ++j) ((unsigned*)(ckvn + (size_t)t * KVL))[lane + 64 * j] = pk2(bflo(wk[j]) * rk * gk[j][0], bfhi(wk[j]) * rk * gk[j][1]);
    if (lane < 32) {
        const float inv = 1.0f / powf(10000.0f, (float)(2 * lane) / 64.0f), ang = (float)pos_t * inv, c = cosf(ang), s = sinf(ang);
        rope[(size_t)t * 64 + lane] = c; rope[(size_t)t * 64 + 32 + lane] = s;
        kpe[(size_t)t * 64 + lane] = (bf16)f2bf(x1 * c - x2 * s); kpe[(size_t)t * 64 + 32 + lane] = (bf16)f2bf(x2 * c + x1 * s);
    }
}
__device__ __forceinline__ void s5_scan_group(int g, LAS unsigned char* lds, const float* Sc, const float* AP32, bf16* Ag, int tid) {
    LAS f32x4* S4 = (LAS f32x4*)lds;
    const GAS f32x4* src = (const GAS f32x4*)(Sc + (size_t)g * 256 * 128);
#pragma unroll 16
    for (int i = tid; i < 256 * 32; i += NTHR) S4[i] = src[i];
    __syncthreads();
    if (tid < 256) { const int b = tid >> 6, p = tid & 63; const float ar = AP32[(g * 64 + p) * 2], ai = AP32[(g * 64 + p) * 2 + 1]; float xr = 0.f, xi = 0.f;
        const LAS float* S = (const LAS float*)lds;
        for (int ch = 0; ch < NCH; ++ch) { const int row = b * NCH + ch; bf16* o = Ag + ((size_t)g * 256 + row) * AGW + 512;
            o[p] = (bf16)f2bf(xr); o[64 + p] = (bf16)f2bf(xi);
            const float sr = S[row * 128 + p], si = S[row * 128 + 64 + p];
            const float nr = ar * xr - ai * xi + sr, ni = ar * xi + ai * xr + si; xr = nr; xi = ni; } }
    VM_WAIT(); __syncthreads();
}

__device__ __forceinline__ void route_tile(int tile, LAS unsigned char* lds, const float* X2, const float* ssq2, float* rstd2, const bf16* WRH, const bf16* WRL, const float* brt,
                                           unsigned* counts, int* SELE, int* SELP, float* SELG, int* LIST, int tid) {
    typedef float f32x16 __attribute__((ext_vector_type(16)));
    const int wid = tid >> 6, lane = tid & 63, r32 = lane & 31, hi = lane >> 5, t0 = tile * 32;
    f32x16 acc = {};
    const float* xp = X2 + (size_t)(t0 + r32) * D + wid * 256 + hi * 8;
    const bf16* wh = WRH + (size_t)r32 * D + wid * 256 + hi * 8; const bf16* wl = WRL + (size_t)r32 * D + wid * 256 + hi * 8;
#pragma unroll 4
    for (int s = 0; s < 16; ++s) {
        const f32x4 a = *(const f32x4*)(xp + 16 * s), b = *(const f32x4*)(xp + 16 * s + 4);
        float xv[8] = {a[0], a[1], a[2], a[3], b[0], b[1], b[2], b[3]}; unsigned hh[8], ll[8];
#pragma unroll
        for (int j = 0; j < 8; ++j) { hh[j] = f2bf(xv[j]); ll[j] = f2bf(xv[j] - __builtin_bit_cast(float, hh[j] << 16)); }
        v4u ph = {hh[0] | (hh[1] << 16), hh[2] | (hh[3] << 16), hh[4] | (hh[5] << 16), hh[6] | (hh[7] << 16)}, pl = {ll[0] | (ll[1] << 16), ll[2] | (ll[3] << 16), ll[4] | (ll[5] << 16), ll[6] | (ll[7] << 16)};
        const bf16x8 xh = *reinterpret_cast<bf16x8*>(&ph), xl = *reinterpret_cast<bf16x8*>(&pl);
        const bf16x8 bh = *(const bf16x8*)(wh + 16 * s), bl = *(const bf16x8*)(wl + 16 * s);
        acc = __builtin_amdgcn_mfma_f32_32x32x16_bf16(xh, bh, acc, 0, 0, 0);
        acc = __builtin_amdgcn_mfma_f32_32x32x16_bf16(xl, bh, acc, 0, 0, 0);
        acc = __builtin_amdgcn_mfma_f32_32x32x16_bf16(xh, bl, acc, 0, 0, 0);
    }
    LAS float* red = (LAS float*)lds;
    LAS float* lg = red + 8 * 32 * 33;
#pragma unroll
    for (int r = 0; r < 16; ++r) red[(wid * 32 + ((r & 3) + 8 * (r >> 2) + 4 * hi)) * 33 + r32] = acc[r];
    __syncthreads();
    for (int idx = tid; idx < 1024; idx += NTHR) { const int tk = idx >> 5, e = idx & 31; float s = 0.f;
#pragma unroll
        for (int w = 0; w < 8; ++w) s += red[(w * 32 + tk) * 33 + e];
        lg[tk * 33 + e] = s; }
    __syncthreads();
    if (tid < 32) { const int t = t0 + tid; float sq = 0.f;
#pragma unroll
        for (int k = 0; k < 8; ++k) { const f32x4 v = *(const f32x4*)(ssq2 + (size_t)t * 32 + 4 * k); sq += v[0]; sq += v[1]; sq += v[2]; sq += v[3]; }
        const float rs = rsqrtf(sq * (1.f / D) + EPS); rstd2[t] = rs;
        float l[E];
#pragma unroll
        for (int e = 0; e < E; ++e) l[e] = lg[tid * 33 + e] * rs + brt[e];
        float tv[TOPK]; int ti[TOPK];
#pragma unroll
        for (int k = 0; k < TOPK; ++k) { float best = -INFINITY; int bi = 0;
#pragma unroll
            for (int e = 0; e < E; ++e) if (l[e] > best) { best = l[e]; bi = e; }
            tv[k] = best; ti[k] = bi;
#pragma unroll
            for (int e = 0; e < E; ++e) if (e == bi) l[e] = -INFINITY; }
        float sum = 0.f, ex[TOPK];
#pragma unroll
        for (int k = 0; k < TOPK; ++k) { ex[k] = expf(tv[k] - tv[0]); sum += ex[k]; }
        LAS unsigned* lcnt = (LAS unsigned*)(lg + 32 * 33); LAS unsigned* lbase = lcnt + 32;
        lcnt[tid] = 0u; LDS_WAIT();
        int lp[TOPK];
#pragma unroll
        for (int k = 0; k < TOPK; ++k) lp[k] = (int)__hip_atomic_fetch_add(&lcnt[ti[k]], 1u, __ATOMIC_RELAXED, __HIP_MEMORY_SCOPE_WORKGROUP);
        LDS_WAIT();
        { const unsigned n = lcnt[tid]; lbase[tid] = n ? atomicAdd(&counts[tid * CNT_STRIDE], n) : 0u; }
        LDS_WAIT();
#pragma unroll
        for (int k = 0; k < TOPK; ++k) { const int pos = (int)lbase[ti[k]] + lp[k];
            SELE[t * TOPK + k] = ti[k]; SELP[t * TOPK + k] = pos; SELG[t * TOPK + k] = ex[k] / sum; LIST[(size_t)ti[k] * T + pos] = t; } }
    __syncthreads();
}

__global__ void __launch_bounds__(NTHR, 2) fwd(Args args) {
    extern __shared__ __attribute__((aligned(16))) unsigned char lds_raw[];
    LAS unsigned char* lds = (LAS unsigned char*)lds_raw;
    volatile LAS unsigned* MISC = (volatile LAS unsigned*)(lds + MISC_OFF);
    int wave_ = __builtin_amdgcn_readfirstlane((int)threadIdx.x >> 6); asm volatile("" : "+s"(wave_));
    const int wave = wave_;
#define LANE_NOW() ({ int l_ = lane_id_now(); asm volatile("" : "+v"(l_)); l_; })
    const int NG = gridDim.x, bx = blockIdx.x;
    unsigned char* ws = args.ws;
    unsigned* ctl = (unsigned*)(ws + WS_CTL);
    { const int tid = wave * 64 + LANE_NOW();
      for (int u = tid; u < (LDS_BYTES - LDSCTL_OFF) / 4; u += NTHR) ((LAS unsigned*)(lds + LDSCTL_OFF))[u] = 0u; }
    __syncthreads();
    const int lo = args.ph_lo, hi = args.ph_hi;
    const bool multi = (hi - lo) > 1;
    XcdBarrier bar; bar.bar = ctl + CW_BAR + args.li * XCD_BAR_WORDS; bar.x = 0; bar.st = nullptr; bar.wave = wave;
    if (multi) bar = xcd_barrier_post(ctl + CW_BAR + args.li * XCD_BAR_WORDS, MISC + 8, wave);
#define IN(k) (lo <= (k) && (k) < hi)
#define BOTH(k) (IN(k) && IN((k) + 1))
#define GRID_BAR() xcd_barrier(bar)
#define GRID_BAR_CV() xcd_barrier_cv(bar, cvw)
#if defined(PROBE_PHASE) || defined(PROBE_RANGE)
#define PRB(p, T_) ((args.li == 1) ? (T_)(ws + WS_END1 + (8u << 20)) : (T_)(p))
#else
#define PRB(p, T_) ((T_)(p))
#endif
#define INP(i) ((const float*)args.in[i])
#define WSP(T_, off) ((T_*)(ws + (off)))
    const CvWork cvw{INP(31), INP(28), WSP(unsigned char, WS_WUP), (volatile LAS int*)(MISC + 16), MISC + 12, ctl + CW_CVQ, wave};
    if (IN(0)) {
        const int lane = LANE_NOW(), tid = wave * 64 + lane; (void)tid; (void)lane;
        const int gw = bx * NWAVES + wave, NGW = NG * NWAVES;
        constexpr int I_IN = (D / 64) * (INC / 64), I_QB = (QL / 64) * (1536 / 64), I_KVB = (KVL / 64) * (2048 / 64), I_GLU = (SSMW / 64) * (SSMW / 64), I_SQ = (D / 64) * (D / 64);
        constexpr int I_UP = (D / 64) * (2 * FF / 64), I_DN = (FF / 64) * (D / 64);
#define TI_MAT(W_, K_, N_, WT_, G_) { const int nb_ = (N_) / 64, kb = r / nb_, nbi = r % nb_; d.src = (W_) + (size_t)(64 * kb) * (N_) + 64 * nbi; d.dst = (WT_) + (size_t)(64 * nbi) * (K_) + 64 * kb; \
            d.gain = (G_) + 64 * kb; d.N = (N_); d.ldk = (K_); }
#define TI_MAT8(W_, K_, N_, WT_, G_) { const int nb_ = (N_) / 32, kb = r / nb_, nbi = r % nb_; d.src = (W_) + (size_t)(128 * kb) * (N_) + 32 * nbi; d.dst = (bf16*)((unsigned char*)(WT_) + (size_t)(32 * nbi) * (K_) + 128 * kb); \
            d.gain = (G_) + 128 * kb; d.N = (N_); d.ldk = (K_); }
        auto dec_up = [&](int it) { TItem d; int r = it; const int e = r / I_UP; r -= e * I_UP; TI_MAT8(INP(31) + (size_t)e * D * 2 * FF, D, 2 * FF, WSP(unsigned char, WS_WUP) + (size_t)e * 2 * FF * D, INP(28)); return d; };
        auto dec_dn = [&](int it) { TItem d; int r = it; const int e = r / I_DN; r -= e * I_DN; TI_MAT8(INP(33) + (size_t)e * FF * D, FF, D, WSP(unsigned char, WS_WDN) + (size_t)e * D * FF, INP(28)); return d; };
        auto dec_xq = [&](int it) { TItem d; int r = it; TI_MAT8(INP(24), D, D, WSP(unsigned char, WS_WXQ8), INP(22)); return d; };
        auto dec_xo = [&](int it) { TItem d; int r = it; TI_MAT8(INP(27), D, D, WSP(unsigned char, WS_WXO8), INP(22)); return d; };
        auto dec_16 = [&](int it) { TItem d; int r = it;
            if (r < I_IN) { TI_MAT(INP(4), D, INC, WSP(bf16, WS_WIN), INP(22)); return d; } r -= I_IN;
            if (r < I_QB) { TI_MAT(INP(6), QL, 1536, WSP(bf16, WS_WQB), INP(22)); return d; } r -= I_QB;
            if (r < I_KVB) { TI_MAT(INP(8), KVL, 2048, WSP(bf16, WS_WKVB), INP(22)); return d; } r -= I_KVB;
            if (r < I_GLU) { TI_MAT(INP(17), SSMW, SSMW, WSP(bf16, WS_WGLU), INP(22)); return d; } r -= I_GLU;
            if (r < I_SQ) { TI_MAT(INP(25), D, D, WSP(bf16, WS_WXK), INP(22)); return d; } r -= I_SQ;
            if (r < I_SQ) { TI_MAT(INP(26), D, D, WSP(bf16, WS_WXV), INP(22)); return d; } r -= I_SQ;
            TI_MAT(INP(21), D, D, WSP(bf16, WS_WOUT), INP(22)); return d; };
#undef TI_MAT
#undef TI_MAT8
        if (bx < G) { s5_setup(bx, lds, INP(9), INP(10), INP(11), INP(12), INP(13), INP(14), INP(15), WSP(bf16, WS_BTY), WSP(bf16, WS_BTS), WSP(float, WS_AP32), tid); }
        else {
            const int gw = (bx - G) * NWAVES + wave, NGW = (NG - G) * NWAVES, gt = (bx - G) * NTHR + tid, NGT = (NG - G) * NTHR;
            for (int i = gt; i < D * D / 4; i += NGT) { const int row = (i * 4) / D; const f32x4 w = ((const GAS f32x4*)INP(24))[i]; const float g = INP(22)[row]; v2u o; o.x = pk2(w.x * g, w.y * g); o.y = pk2(w.z * g, w.w * g);
                ((GAS v2u*)WSP(bf16, WS_WXQN))[i] = o; }
            TSTREAM(I_SQ, dec_xo, titem8_load<false>, titem8_store<false>);
            TSTREAM(I_IN + I_QB + I_KVB + I_GLU + 3 * I_SQ, dec_16, titem_load<false>, titem_store<false>);
            for (int i = gt; i < E * D; i += NGT) { const int e = i / D, k = i % D; const float w = INP(29)[(size_t)k * E + e] * INP(28)[k]; const unsigned h = f2bf(w);
                WSP(bf16, WS_WRH)[i] = (bf16)h; WSP(bf16, WS_WRL)[i] = (bf16)f2bf(w - __builtin_bit_cast(float, h << 16)); }
            for (int i = gt; i < (INCP - INC) * D / 8; i += NGT) ((GAS v4u*)(WSP(bf16, WS_WIN) + (size_t)INC * D))[i] = (v4u){0u, 0u, 0u, 0u};
            for (int m = gw; m < T; m += NGW) rms_row_to_bf16(INP(0) + (size_t)m * D, INP(3), WSP(bf16, WS_HB) + (size_t)m * D, lane);
            for (int m = gw; m < TM; m += NGW) rms_row_to_bf16(INP(1) + (size_t)m * D, INP(23), WSP(bf16, WS_MEMN) + (size_t)m * D, lane);
        }
        if (BOTH(0)) GRID_BAR_CV();
    }
    if (IN(1)) {
        const int lane = LANE_NOW(), tid = wave * 64 + lane; (void)tid; (void)lane;
        { pg8::Geo geo{D * 2, D * 2, 128L * D * 2, 128L * D * 2, D / 64};
          pg8::Sched S; S.init(0, T / 256, INCP / 256, 1, NG, bx, WSP(bf16, WS_HB), 256L * D * 2, 0, WSP(bf16, WS_WIN), 256L * D * 2, 0);
          EpiProj Ep{WSP(bf16, WS_PROJB), WSP(bf16, WS_AG)};
          pg8::gemm_phase<EpiProj, pg8::Sched, true, true>(lds + RING_OFF, geo, S, Ep, wave); }
        { pg8::Geo geo{D * 2, D * 2, 128L * D * 2, 128L * D * 2, D / 64};
          const int c = (bx >= 224) ? bx - 224 : (1 << 30);
          pg8::Sched S; S.init(1, TM / 256, D / 256, 1, 32, c, WSP(bf16, WS_MEMN), 256L * D * 2, 0, WSP(bf16, WS_WXK), 256L * D * 2, 0);
          EpiPlain<false> Ep{WSP(bf16, WS_XK), D, 1, 0, 0, nullptr};
          pg8::gemm_phase<EpiPlain<false>, pg8::Sched, true, true>(lds + RING_OFF, geo, S, Ep, wave); }
        if (BOTH(1)) GRID_BAR_CV();
    }
    if (IN(2)) {
        const int lane = LANE_NOW(), tid = wave * 64 + lane; (void)tid; (void)lane;
        { const int gw = bx * NWAVES + wave, NGW = NG * NWAVES;
          for (int t = gw; t < T; t += NGW) mla_thin_token(t, lane, WSP(bf16, WS_PROJB), INP(5), INP(7), ((const int*)args.in[2]), WSP(bf16, WS_CQN), WSP(bf16, WS_CKVN), WSP(bf16, WS_KPE), WSP(float, WS_ROPE)); }
        __syncthreads();
        { pg8::Geo geo{AGW * 2, 512 * 2, 128L * AGW * 2, 0, 512 / 64};
          pg8::Sched S; S.init(1, 1, 1, G, NG, bx, WSP(bf16, WS_AG), 0, 256L * AGW * 2, WSP(bf16, WS_BTS), 0, 128L * 512 * 2);
          EpiS5State Ep{WSP(float, WS_SC)};
          pg8::gemm_phase<EpiS5State, pg8::Sched, true, true>(lds + RING_OFF, geo, S, Ep, wave); }
        { pg8::Geo geo{D * 2, D * 2, 128L * D * 2, 128L * D * 2, D / 64};
          const int c = (bx >= 64 && bx < 96) ? bx - 64 : (1 << 30);
          pg8::Sched S; S.init(1, TM / 256, D / 256, 1, 32, c, WSP(bf16, WS_MEMN), 256L * D * 2, 0, WSP(bf16, WS_WXV), 256L * D * 2, 0);
          EpiPlain<false, false, true> Ep{(bf16*)WSP(unsigned char, WS_XV8), D, 1, 0, 0, nullptr};
          pg8::gemm_phase<EpiPlain<false, false, true>, pg8::Sched, true, true>(lds + RING_OFF, geo, S, Ep, wave); }
        if (BOTH(2)) GRID_BAR_CV();
    }
    if (IN(3)) {
        const int lane = LANE_NOW(), tid = wave * 64 + lane; (void)tid; (void)lane;
        if (bx < 128) {
            s5_scan_group(bx >> 1, lds, WSP(float, WS_SC), WSP(float, WS_AP32), WSP(bf16, WS_AG), tid);
            pg8::Geo geo{AGW * 2, AGW * 2, 128L * AGW * 2, 128L * AGW * 2, AGW / 64};
            pg8::Sched S; S.init(1, 1, 2, G, 128, bx, WSP(bf16, WS_AG), 0, 256L * AGW * 2, WSP(bf16, WS_BTY), 256L * AGW * 2, 512L * AGW * 2);
            EpiS5Y Ep{WSP(bf16, WS_AG), INP(16), WSP(bf16, WS_Y)};
            pg8::gemm_phase<EpiS5Y, pg8::Sched, true, true>(lds + RING_OFF, geo, S, Ep, wave);
        }
        { pg8::Geo geo{KVL * 2, KVL * 2, 128L * KVL * 2, 128L * KVL * 2, KVL / 64};
          pg8::Sched S; S.init(0, T / 256, 2048 / 256, 1, NG, bx, WSP(bf16, WS_CKVN), 256L * KVL * 2, 0, WSP(bf16, WS_WKVB), 256L * KVL * 2, 0);
          EpiPlain<false> Ep{WSP(bf16, WS_KV), 2048, 1, 0, 0, nullptr};
          pg8::gemm_phase<EpiPlain<false>, pg8::Sched, true, true>(lds + RING_OFF, geo, S, Ep, wave); }
        { pg8::Geo geo{QL * 2, QL * 2, 128L * QL * 2, 128L * QL * 2, QL / 64};
          const int c = (bx >= 128) ? bx - 128 : (1 << 30);
          pg8::Sched S; S.init(0, T / 256, 1536 / 256, 1, 128, c, WSP(bf16, WS_CQN), 256L * QL * 2, 0, WSP(bf16, WS_WQB), 256L * QL * 2, 0);
          EpiPlain<false> Ep{WSP(bf16, WS_Q), 1536, 1, 0, 0, nullptr};
          pg8::gemm_phase<EpiPlain<false>, pg8::Sched, true, true>(lds + RING_OFF, geo, S, Ep, wave); }
        { pg8::Geo geo{D * 2, D * 2, 128L * D * 2, 128L * D * 2, XD / 64};
          const int c = (bx >= 128) ? bx - 128 : (1 << 30);
          pg8::Sched S; S.init(1, 1, D / 256, BATCH * XH, 128, c, WSP(bf16, WS_XK), 0, (long)MEM * D * 2, WSP(bf16, WS_WXQN), 256L * D * 2, 0);
          S.split_z(XH, XD * 2, XD * 2);
          EpiPlain<false, false, true> Ep{(bf16*)WSP(unsigned char, WS_WKT8), D, 1, 256L * D, 0, nullptr};
          pg8::gemm_phase<EpiPlain<false, false, true>, pg8::Sched, true, true>(lds + RING_OFF, geo, S, Ep, wave); }
        if (BOTH(3)) GRID_BAR_CV();
    }
    if (IN(4)) {
        const int lane = LANE_NOW(), tid = wave * 64 + lane; (void)tid; (void)lane;
        const int vcu = (NG % 8 == 0) ? (bx % 8) * (NG / 8) + bx / 8 : bx;
        if (vcu < BATCH * H * 8) { const int L = vcu, bh = L >> 3, qb = L & 7;
            mla::attn_unit(lds + RING_OFF, bh >> 3, bh & 7, qb, WSP(bf16, WS_Q), WSP(bf16, WS_KV), WSP(bf16, WS_KPE), WSP(float, WS_ROPE), WSP(bf16, WS_ATTO), wave); }
        { const int qb = vcu & 7, c = (vcu < 256 && qb >= 4) ? (vcu >> 3) * 4 + (qb - 4) : (1 << 30);
          pg8::Geo geo{SSMW * 2, SSMW * 2, 128L * SSMW * 2, 128L * SSMW * 2, SSMW / 64};
          pg8::Sched S; S.init(1, T / 256, SSMW / 256, 1, 128, c, WSP(bf16, WS_Y), 256L * SSMW * 2, 0, WSP(bf16, WS_WGLU), 256L * SSMW * 2, 0);
          EpiGlu Ep{WSP(bf16, WS_Y), INP(18), WSP(bf16, WS_SSMO)};
          pg8::gemm_phase<EpiGlu, pg8::Sched, true, true>(lds + RING_OFF, geo, S, Ep, wave); }
        { const int qb = vcu & 7, c = (vcu < 256 && qb < 4) ? (vcu >> 3) * 4 + qb : (1 << 30);
          pg8::Geo geo{D, D, 128L * D, 128L * D, XD / 128};
          pg8::Sched S; S.init(1, D / 256, TM / 256, XH, 128, c, WSP(unsigned char, WS_WXO8), 256L * D, (long)XD, WSP(unsigned char, WS_XV8), 256L * D, (long)XD);
          EpiVW Ep{WSP(bf16, WS_VWT)};
          pg8::gemm_phase<EpiVW, pg8::Sched, true, true>(lds + RING_OFF, geo, S, Ep, wave); }
        if (BOTH(4)) GRID_BAR_CV();
    }
    if (IN(5)) {
        const int lane = LANE_NOW(), tid = wave * 64 + lane; (void)tid; (void)lane;
        const int gw = bx * NWAVES + wave, NGW = NG * NWAVES;
        for (int t = gw; t < T; t += NGW) {
#pragma unroll
            for (int half = 0; half < 2; ++half) { const bf16* src = (half ? WSP(bf16, WS_SSMO) : WSP(bf16, WS_ATTO)) + (size_t)t * 1024; const float* gn = half ? INP(20) : INP(19);
                const v4u a = ((const v4u*)src)[lane], b = ((const v4u*)src)[64 + lane];
                f32x4 gpre[4];
#pragma unroll
                for (int jj = 0; jj < 2; ++jj) { const int k0 = (jj * 64 + lane) * 8; gpre[2 * jj] = *(const f32x4*)(gn + k0); gpre[2 * jj + 1] = *(const f32x4*)(gn + k0 + 4); }
                float v[16] = {bflo(a.x), bfhi(a.x), bflo(a.y), bfhi(a.y), bflo(a.z), bfhi(a.z), bflo(a.w), bfhi(a.w), bflo(b.x), bfhi(b.x), bflo(b.y), bfhi(b.y), bflo(b.z), bfhi(b.z), bflo(b.w), bfhi(b.w)};
                float s = 0.f;
#pragma unroll
                for (int e = 0; e < 16; ++e) s += v[e] * v[e];
                const float r = rsqrtf(wave_sum(s) * (1.f / 1024) + EPS);
#pragma unroll
                for (int jj = 0; jj < 2; ++jj) { const int k0 = (jj * 64 + lane) * 8; const f32x4 g0 = gpre[2 * jj], g1 = gpre[2 * jj + 1]; v4u w;
                    w.x = pk2(v[8 * jj + 0] * r * g0[0], v[8 * jj + 1] * r * g0[1]); w.y = pk2(v[8 * jj + 2] * r * g0[2], v[8 * jj + 3] * r * g0[3]);
                    w.z = pk2(v[8 * jj + 4] * r * g1[0], v[8 * jj + 5] * r * g1[1]); w.w = pk2(v[8 * jj + 6] * r * g1[2], v[8 * jj + 7] * r * g1[3]);
                    *(v4u*)(WSP(bf16, WS_MIXED) + (size_t)t * D + half * 1024 + k0) = w; } } }
        if (BOTH(5)) GRID_BAR_CV();
#if defined(PROBE_BAR)
        if (BOTH(5)) { for (int i_ = 0; i_ < 10; ++i_) GRID_BAR(); }
#endif
    }
    if (IN(6)) {
        const int lane = LANE_NOW(), tid = wave * 64 + lane; (void)tid; (void)lane;
        pg8::Geo geo{D * 2, D * 2, 128L * D * 2, 128L * D * 2, D / 64};
        pg8::Sched S; S.init(0, T / 256, D / 256, 1, NG, bx, WSP(bf16, WS_MIXED), 256L * D * 2, 0, WSP(bf16, WS_WOUT), 256L * D * 2, 0);
        EpiResid<> Ep{INP(0), WSP(float, WS_X1), nullptr, WSP(float, WS_SSQP1), WSP(unsigned char, WS_X1F8)};
        pg8::gemm_phase<EpiResid<>, pg8::Sched, true, true>(lds + RING_OFF, geo, S, Ep, wave);
        if (BOTH(6)) GRID_BAR_CV();
    }
    if (IN(7)) {
        const int lane = LANE_NOW(), tid = wave * 64 + lane; (void)tid; (void)lane;
        pg8::Geo geo{D, D, 128L * D, 128L * D, D / 128};
        pg8::Sched S; S.init(1, SEQ / 256, XH, BATCH, NG, bx, WSP(unsigned char, WS_X1F8), 256L * D, (long)SEQ * D, WSP(unsigned char, WS_WKT8), 256L * D, (long)XH * MEM * D);
        LAS float* rt = (LAS float*)(lds + TOK_OFF);
        { pg8::Unit u0; if (S.next(0, u0) && tid < 256) { const float* pp = WSP(float, WS_SSQP1) + (size_t)((u0.z * (SEQ / 256) + u0.pm) * 256 + tid) * 32; float sq = 0.f;
#pragma unroll
                for (int k = 0; k < 8; ++k) { const f32x4 v = *(const f32x4*)(pp + 4 * k); sq += v[0]; sq += v[1]; sq += v[2]; sq += v[3]; }
                rt[tid] = rsqrtf(sq * (1.f / D) + EPS); }
            __syncthreads(); }
        EpiSoftmax<true> Ep{WSP(bf16, WS_PX), rt};
        pg8::gemm_phase<EpiSoftmax<true>, pg8::Sched, false, true>(lds + RING_OFF, geo, S, Ep, wave);
        if (BOTH(7)) GRID_BAR_CV();
    }
    if (IN(10)) {
        const int lane = LANE_NOW(), tid = wave * 64 + lane; (void)tid; (void)lane;
        constexpr int PK = XH * MEM;
        pg8::Geo geo{PK, PK, 128L * PK, 128L * PK, PK / 128};
        pg8::Sched S; S.init(1, SEQ / 256, D / 256, BATCH, NG, bx, WSP(unsigned char, WS_PX), 256L * PK, (long)SEQ * PK, WSP(unsigned char, WS_VWT), 256L * PK, (long)D * PK);
        EpiResid<true> Ep{WSP(float, WS_X1), WSP(float, WS_X2), nullptr, WSP(float, WS_SSQP2), WSP(unsigned char, WS_X2F8), SEQ / 256};
        pg8::gemm_phase<EpiResid<true>, pg8::Sched, true, true>(lds + RING_OFF, geo, S, Ep, wave);
        if (BOTH(10)) GRID_BAR_CV();
    }
    if (IN(11)) {
        const int lane = LANE_NOW(), tid = wave * 64 + lane; (void)tid; (void)lane;
        for (int tile = bx; tile < T / 32; tile += NG)
            route_tile(tile, lds, WSP(float, WS_X2), WSP(float, WS_SSQP2), WSP(float, WS_RSTD2), WSP(bf16, WS_WRH), WSP(bf16, WS_WRL), INP(30), PRB(ctl + CW_CNT, unsigned*), PRB(WSP(int, WS_SELE), int*), PRB(WSP(int, WS_SELP), int*), PRB(WSP(float, WS_SELG), float*), PRB(WSP(int, WS_LIST), int*) + (args.li == 1 ? (1 << 20) : 0), tid);
        cv_flush(cvw);
        if (BOTH(11)) GRID_BAR();
    }
    if (IN(12)) {
        const int lane = LANE_NOW(), tid = wave * 64 + lane; (void)tid; (void)lane;
        LAS int* blkE = (LAS int*)(lds + BLK_OFF); LAS int* tokTab = (LAS int*)(lds + TOK_OFF);
        const unsigned* counts = ctl + CW_CNT;
        const int NBt = moe_block_table(counts, blkE, tid);
        { int tokv[MAXU / 2];
#pragma unroll
          for (int k = 0; k < MAXU / 2; ++k) { const int i = 2 * k + (tid >> 8), L = i * NG + bx, r = tid & 255; int v = 0;
              if (L < NBt * 16) { const int blk = L >> 4, e = blkE[blk], j = blkE[160 + blk]; if (r < blkE[320 + blk]) v = WSP(int, WS_LIST)[(size_t)e * T + j * 256 + r]; }
              tokv[k] = v; }
#pragma unroll
          for (int k = 0; k < MAXU / 2; ++k) tokTab[(2 * k + (tid >> 8)) * 256 + (tid & 255)] = tokv[k]; }
        __syncthreads();
        pg8::Geo geo{D, D, 0, (long)FF * D, D / 128};
        MoeSchedUpCv S{{NBt, 16, NG, bx, D, (const char*)WSP(unsigned char, WS_X2F8), (const char*)WSP(unsigned char, WS_WUP), 0, (long)2 * FF * D, 128L * D, blkE, tokTab}, INP(33), WSP(unsigned char, WS_WDN), wave};
        EpiMoeUp Ep{blkE, tokTab, WSP(float, WS_RSTD2), INP(32), WSP(unsigned char, WS_ACT)};
        pg8::gemm_phase<EpiMoeUp, MoeSchedUpCv, true, true>(lds + RING_OFF, geo, S, Ep, wave);
        if (BOTH(12)) GRID_BAR();
    }
    if (IN(13)) {
        const int lane = LANE_NOW(), tid = wave * 64 + lane; (void)tid; (void)lane;
        LAS int* blkE = (LAS int*)(lds + BLK_OFF);
        __syncthreads();
        const int NBt = moe_block_table(ctl + CW_CNT, blkE, tid);
        pg8::Geo geo{FF, FF, 128L * FF, 128L * FF, FF / 128};
        MoeSched<false> S{NBt, 8, NG, bx, FF, (const char*)WSP(unsigned char, WS_ACT), (const char*)WSP(unsigned char, WS_WDN), 256L * FF, (long)D * FF, 256L * FF, blkE, nullptr};
        EpiMoeDown Ep{blkE, INP(34), WSP(unsigned char, WS_YK)};
        pg8::gemm_phase<EpiMoeDown, MoeSched<false>, true, true>(lds + RING_OFF, geo, S, Ep, wave);
        if (BOTH(13)) GRID_BAR();
    }
    if (IN(14)) {
        const int lane = LANE_NOW(), tid = wave * 64 + lane; (void)tid; (void)lane;
        const int gw = bx * NWAVES + wave, NGW = NG * NWAVES;
        const unsigned* counts = ctl + CW_CNT;
        int pb = 0;
        { const int nb = (lane < E) ? (((int)counts[(lane & 31) * CNT_STRIDE] + 255) >> 8) : 0; int inc = nb;
#pragma unroll
          for (int o = 1; o < 32; o <<= 1) { const int v = __shfl_up(inc, o); if ((lane & 31) >= o) inc += v; }
          pb = inc - nb; }
        const float* X2 = WSP(float, WS_X2); const unsigned char* YK = WSP(unsigned char, WS_YK); const float* fn = INP(35); float* out = args.out;
        f32x4 fg[8];
#pragma unroll
        for (int j = 0; j < 8; ++j) fg[j] = *(const f32x4*)(fn + (j * 64 + lane) * 4);
        for (int t = gw; t < T; t += NGW) {
            size_t so[TOPK]; float gk[TOPK];
#pragma unroll
            for (int k = 0; k < TOPK; ++k) { const int e = WSP(int, WS_SELE)[t * TOPK + k], p = WSP(int, WS_SELP)[t * TOPK + k]; gk[k] = WSP(float, WS_SELG)[t * TOPK + k] * Y8_INV;
                so[k] = ((size_t)__shfl(pb, e) * 256 + p) * D; }
            f32x4 v[8]; float s = 0.f;
#pragma unroll
            for (int j = 0; j < 8; ++j) { const int cidx = (j * 64 + lane) * 4; f32x4 a = *(const f32x4*)(X2 + (size_t)t * D + cidx);
#pragma unroll
                for (int k = 0; k < TOPK; ++k) { const unsigned y = *(const unsigned*)(YK + so[k] + cidx); const v2f lo = __builtin_amdgcn_cvt_pk_f32_fp8(y, false), hi = __builtin_amdgcn_cvt_pk_f32_fp8(y, true);
                    a[0] += gk[k] * lo[0]; a[1] += gk[k] * lo[1]; a[2] += gk[k] * hi[0]; a[3] += gk[k] * hi[1]; }
                v[j] = a; s += (a[0] * a[0] + a[1] * a[1]) + (a[2] * a[2] + a[3] * a[3]); }
            const float r = rsqrtf(wave_sum(s) * (1.f / D) + EPS);
#pragma unroll
            for (int j = 0; j < 8; ++j) { const int cidx = (j * 64 + lane) * 4; *(f32x4*)(out + (size_t)t * D + cidx) = v[j] * r * fg[j]; }
        }
    }
#if defined(PROBE_READ)
    if (IN(15)) {
        const int lane = LANE_NOW(), tid = wave * 64 + lane; (void)tid; (void)lane;
        const int gw = bx * NWAVES + wave, NGW = NG * NWAVES;
        constexpr int I_UP = (D / 64) * (2 * FF / 64), I_DN = (FF / 64) * (D / 64);
        f32x4 sum = {0.f, 0.f, 0.f, 0.f};
#define TI_MAT8(W_, K_, N_, WT_, G_) { const int nb_ = (N_) / 64, kb = r / nb_, nbi = r % nb_; d.src = (W_) + (size_t)(64 * kb) * (N_) + 64 * nbi; d.dst = (bf16*)((unsigned char*)(WT_) + (size_t)(64 * nbi) * (K_) + 64 * kb); \
            d.gain = (G_) + 64 * kb; d.N = (N_); d.ldk = (K_); }
        auto dec_up = [&](int it) { TItem d; int r = it; const int e = r / I_UP; r -= e * I_UP; TI_MAT8(INP(31) + (size_t)e * D * 2 * FF, D, 2 * FF, WSP(unsigned char, WS_WUP) + (size_t)e * 2 * FF * D, INP(28)); return d; };
        auto dec_dn = [&](int it) { TItem d; int r = it; const int e = r / I_DN; r -= e * I_DN; TI_MAT8(INP(33) + (size_t)e * FF * D, FF, D, WSP(unsigned char, WS_WDN) + (size_t)e * D * FF, INP(28)); return d; };
#undef TI_MAT8
#define PR_STORE(d_, lane_, r_, g_) do { _Pragma("unroll") for (int j_ = 0; j_ < 16; ++j_) sum += r_[j_]; } while (0)
        TSTREAM(E * I_UP, dec_up, titem8_load<false>, PR_STORE);
        TSTREAM(E * I_DN, dec_dn, titem8_load<false>, PR_STORE);
#undef PR_STORE
        *(f32x4*)(ws + WS_END1 + (16u << 20) + ((size_t)gw * 64 + lane) * 16) = sum;
    }
#endif
#undef IN
#undef BOTH
#undef GRID_BAR
}

extern "C" void kernel_launch(void* const* d_in, const int* in_sizes, int n_in, void* d_out, int out_size, void* d_ws, size_t ws_size, hipStream_t stream) {
    static int grid = 0;
    if (grid == 0) {
        if (n_in != 36 || out_size != T * D || ws_size < WS_END1) { fprintf(stderr, "kernel_launch: built for 36 inputs, %d outputs, >= %zu bytes of workspace; got %d, %d, %zu; nothing launched\n", T * D, (size_t)WS_END1, n_in, out_size, ws_size); grid = -1; return; }
        int dev = 0, cus = 0, per_cu = 0;
        if (hipGetDevice(&dev) != hipSuccess || hipDeviceGetAttribute(&cus, hipDeviceAttributeMultiprocessorCount, dev) != hipSuccess) { fprintf(stderr, "kernel_launch: device query failed\n"); grid = -1; return; }
        if (hipFuncSetAttribute((const void*)fwd, hipFuncAttributeMaxDynamicSharedMemorySize, LDS_BYTES) != hipSuccess) { fprintf(stderr, "kernel_launch: hipFuncSetAttribute failed\n"); grid = -1; return; }
        if (hipOccupancyMaxActiveBlocksPerMultiprocessor(&per_cu, (const void*)fwd, NTHR, LDS_BYTES) != hipSuccess || per_cu < 1) fprintf(stderr, "kernel_launch: occupancy query reports %d\n", per_cu);
        (void)hipGetLastError();
        grid = 256;
        if (cus < 256) { fprintf(stderr, "kernel_launch: %d CUs < 256: the grid would not be resident; nothing launched\n", cus); grid = -1; return; }
    }
    if (grid < 0) return;
    (void)hipMemsetAsync((char*)d_ws + WS_CTL, 0, CTL_ZERO_BYTES, stream);
    Args a{};
    for (int i = 0; i < 36; ++i) a.in[i] = d_in[i];
    a.out = (float*)d_out; a.ws = (unsigned char*)d_ws;
#if defined(PROBE_RANGE)
    a.ph_lo = 0; a.ph_hi = PROBE_RANGE_HI; a.li = 0; hipLaunchKernelGGL(fwd, dim3(grid), dim3(NTHR), LDS_BYTES, stream, a);
    a.ph_lo = PROBE_RANGE_LO; a.ph_hi = PROBE_RANGE_HI; a.li = 1; hipLaunchKernelGGL(fwd, dim3(grid), dim3(NTHR), LDS_BYTES, stream, a);
    a.ph_lo = PROBE_RANGE_HI; a.ph_hi = N_PHASES; a.li = 2; hipLaunchKernelGGL(fwd, dim3(grid), dim3(NTHR), LDS_BYTES, stream, a);
#elif defined(PROBE_READ)
    a.ph_lo = 0; a.ph_hi = N_PHASES; a.li = 0; hipLaunchKernelGGL(fwd, dim3(grid), dim3(NTHR), LDS_BYTES, stream, a);
    a.ph_lo = 15; a.ph_hi = 16; a.li = 1; hipLaunchKernelGGL(fwd, dim3(grid), dim3(NTHR), LDS_BYTES, stream, a);
#elif defined(PROBE_PHASE)
    a.ph_lo = 0; a.ph_hi = PROBE_PHASE + 1; a.li = 0; hipLaunchKernelGGL(fwd, dim3(grid), dim3(NTHR), LDS_BYTES, stream, a);
    a.ph_lo = PROBE_PHASE; a.ph_hi = PROBE_PHASE + 1; a.li = 1; hipLaunchKernelGGL(fwd, dim3(grid), dim3(NTHR), LDS_BYTES, stream, a);
    if (PROBE_PHASE + 1 < N_PHASES) { a.ph_lo = PROBE_PHASE + 1; a.ph_hi = N_PHASES; a.li = 2; hipLaunchKernelGGL(fwd, dim3(grid), dim3(NTHR), LDS_BYTES, stream, a); }
#else
    a.ph_lo = 0; a.ph_hi = N_PHASES;
    hipLaunchKernelGGL(fwd, dim3(grid), dim3(NTHR), LDS_BYTES, stream, a);
#endif
}
```

```cpp
#include <hip/hip_runtime.h>
#include <cstdio>
#include <cstdint>

constexpr int D = 2048, BATCH = 4, SEQ = 2048, T = BATCH * SEQ;
constexpr int MEM = 256, TM = BATCH * MEM;
constexpr int H = 8, DN = 128, DR = 64, DV = 128, QL = 384, KVL = 256;
constexpr int SSMW = 1024, G = 64, P = 64, C = 16;
constexpr int XH = 4, XD = 512;
constexpr int E = 32, TOPK = 4, FF = 2048;
constexpr int INC = 1728, INCP = 1792;
constexpr int PJW = 704;
constexpr int LCH = 32, NCH = SEQ / LCH;
constexpr int AGW = 640;
constexpr float EPS = 1e-6f;

__device__ __forceinline__ int lane_id_now() { unsigned z = 0u; asm volatile("" : "+v"(z)); return (int)__builtin_amdgcn_mbcnt_hi(~0u, __builtin_amdgcn_mbcnt_lo(~0u, z)); }
namespace pg8 {
#define PG8_LAS __attribute__((address_space(3)))
typedef unsigned short bf16_t;
typedef short bf16x8 __attribute__((ext_vector_type(8)));
typedef float f32x4 __attribute__((ext_vector_type(4)));
typedef float f32x2 __attribute__((ext_vector_type(2)));
typedef unsigned u32x4 __attribute__((ext_vector_type(4)));
typedef unsigned u32x2 __attribute__((ext_vector_type(2)));
constexpr int BM = 256, BK = 64, HALF = 128, HTB = HALF * BK * 2  , STAGE_BYTES = 8 * HTB, NXCD = 8, WGM = 8;

__host__ __device__ __forceinline__ int lds_byte(int r, int c) { const int st = (r >> 4) * 2 + (c >> 5), rr = r & 15, cc = c & 31, ob = rr * 64 + cc * 2; return st * 1024 + (ob ^ (((ob >> 9) & 1) << 5)); }
__host__ __device__ __forceinline__ void stage_rc(int b, int& R, int& C) { const int st = b / 1024, sb = b % 1024, swz = sb ^ (((sb >> 9) & 1) << 5); R = (st >> 1) * 16 + swz / 64; C = (st & 1) * 32 + (swz % 64) / 2; }
__host__ __device__ __forceinline__ int perm32(int rho) { const int n = rho >> 4, i = rho & 15; return 8 * (i >> 2) + 4 * n + (i & 3); }

struct Unit { int pm, pn, z; };
struct Geo { int lda, ldb; long hstepA, hstepB; int nt; };

struct Sched {
    int nM, nN, nZ, total, G, c, mode, zdiv;
    const char* A; const char* B; long tA, tB, zA, zB, zA2, zB2;
    __device__ __forceinline__ void init(int mode_, int nM_, int nN_, int nZ_, int G_, int c_, const void* A_, long tA_, long zA_, const void* B_, long tB_, long zB_) {
        mode = mode_; nM = nM_; nN = nN_; nZ = nZ_; total = nM_ * nN_ * nZ_; G = G_; c = c_; A = (const char*)A_; B = (const char*)B_; tA = tA_; tB = tB_; zA = zA_; zB = zB_; zdiv = 1 << 30; zA2 = 0; zB2 = 0; }
    __device__ __forceinline__ void split_z(int zdiv_, long zA2_, long zB2_) { zdiv = zdiv_; zA2 = zA2_; zB2 = zB2_; }
    __device__ __forceinline__ bool next(int i, Unit& u) const {
        const long L = (long)i * G + c; if (L >= total) return false;
        if (mode == 0) {
            int wgid = (int)L; { const int q = total / NXCD, r = total % NXCD, xcd = wgid % NXCD, off = wgid / NXCD; wgid = (xcd < r ? xcd * (q + 1) : r * (q + 1) + (xcd - r) * q) + off; }
            const int nig = WGM * nN, gid = wgid / nig, fm = gid * WGM, gsz = (nM - fm) < WGM ? (nM - fm) : WGM;
            u.pm = fm + ((wgid % nig) % gsz); u.pn = (wgid % nig) / gsz; u.z = 0;
        } else { const int l = (int)L; u.pn = l % nN; u.pm = (l / nN) % nM; u.z = l / (nN * nM); }
        return true;
    }
    __device__ __forceinline__ void ptrs(const Unit& u, const char*& a, const char*& b) const { const int z1 = (zdiv == (1 << 30)) ? u.z : u.z / zdiv, z2 = (zdiv == (1 << 30)) ? 0 : u.z % zdiv;
        a = A + (long)z1 * zA + (long)z2 * zA2 + (long)u.pm * tA; b = B + (long)z1 * zB + (long)z2 * zB2 + (long)u.pn * tB; }
    static constexpr bool GATHER = false;
    __device__ __forceinline__ bool half1(const Unit&) const { return true; }
    __device__ __forceinline__ unsigned row_off(int, int) const { return 0u; }
    __device__ __forceinline__ void a_ready(const Unit&) const {}
    __device__ __forceinline__ void done(const Unit&) const {}
};
template <class E, class = void> struct epi_fp8 { static constexpr bool v = false; };
template <class E> struct epi_fp8<E, decltype((void)E::FP8)> { static constexpr bool v = E::FP8; };
typedef int i32x4 __attribute__((ext_vector_type(4)));
typedef int i32x8 __attribute__((ext_vector_type(8)));
__device__ __forceinline__ unsigned cvt_pk_bf16(float lo, float hi) { unsigned r; asm volatile("v_cvt_pk_bf16_f32 %0, %1, %2" : "=v"(r) : "v"(lo), "v"(hi)); return r; }

template <class Epi, class Sched, bool ALIGN_EPI = false, bool SP2 = false>
__device__ __forceinline__ void gemm_phase(PG8_LAS unsigned char* lds, const Geo geo, const Sched& S, const Epi& E, const int wave_) {
    int tid_ = wave_ * 64 + lane_id_now(); asm volatile("" : "+v"(tid_));
    const int tid = tid_, wid = __builtin_amdgcn_readfirstlane(tid >> 6), lane = tid & 63, wr = wid >> 2, wc = wid & 3, fr = lane & 15, fq = lane >> 4;
    const int nt = geo.nt;
    unsigned voffA[2], voffB[2];
#pragma unroll
    for (int i = 0; i < 2; ++i) { int R, C; stage_rc(tid * 16 + i * 8192, R, C); const int Rb = Epi::PERM ? ((R & ~31) + perm32(R & 31)) : R;
        voffA[i] = (unsigned)(R * geo.lda + C * 2); voffB[i] = (unsigned)(Rb * geo.ldb + C * 2); }
    unsigned c0[2], c1[2], n0[2], n1[2];
#pragma unroll
    for (int i = 0; i < 2; ++i) { c0[i] = voffA[i]; c1[i] = voffA[i]; n0[i] = voffA[i]; n1[i] = voffA[i]; }
    const size_t kstep = (size_t)(BK * 2);
    const size_t hstepA = (size_t)geo.hstepA, hstepB = (size_t)geo.hstepB;
    const unsigned ldsw = (unsigned)wid * 1024u;
    const int aoff = lds_byte(wr * 64 + fr, fq * 8), boff = lds_byte(wc * 32 + fr, fq * 8);
#define PG8_SA(b, h) (((b) * 2 + (h)) * HTB)
#define PG8_SB(b, h) ((4 + (b) * 2 + (h)) * HTB)
#define PG8_STAGE(bufoff, gbase, voff) do { _Pragma("unroll") for (int _i = 0; _i < 2; ++_i) \
        __builtin_amdgcn_global_load_lds((const unsigned*)((const char*)(gbase) + (voff)[_i]), (PG8_LAS unsigned*)(lds + (bufoff) + ldsw + _i * 8192), 16, 0, 0); } while (0)
#define PG8_LD16(off) __builtin_bit_cast(i32x4, *(const PG8_LAS bf16x8*)(lds + (off)))
#define PG8_LDA(dst, b, h) do { _Pragma("unroll") for (int m = 0; m < 4; ++m) { if constexpr (epi_fp8<Epi>::v) dst##8[m] = __builtin_shufflevector(PG8_LD16(PG8_SA(b, h) + aoff + m * 2048), PG8_LD16(PG8_SA(b, h) + aoff + m * 2048 + 1024), 0, 1, 2, 3, 4, 5, 6, 7); \
        else { _Pragma("unroll") for (int k = 0; k < 2; ++k) dst[m][k] = *(const PG8_LAS bf16x8*)(lds + PG8_SA(b, h) + aoff + m * 2048 + k * 1024); } } } while (0)
#define PG8_LDB(dst, b, h) do { _Pragma("unroll") for (int n = 0; n < 2; ++n) { if constexpr (epi_fp8<Epi>::v) dst##8[n] = __builtin_shufflevector(PG8_LD16(PG8_SB(b, h) + boff + n * 2048), PG8_LD16(PG8_SB(b, h) + boff + n * 2048 + 1024), 0, 1, 2, 3, 4, 5, 6, 7); \
        else { _Pragma("unroll") for (int k = 0; k < 2; ++k) dst[n][k] = *(const PG8_LAS bf16x8*)(lds + PG8_SB(b, h) + boff + n * 2048 + k * 1024); } } } while (0)
#define PG8_MMA(ai, bj, At, Bt) do { __builtin_amdgcn_s_setprio(1); \
        if constexpr (epi_fp8<Epi>::v) { _Pragma("unroll") for (int m = 0; m < 4; ++m) _Pragma("unroll") for (int n = 0; n < 2; ++n) \
            asm volatile("v_mfma_f32_16x16x128_f8f6f4 %0, %1, %2, %0" : "+v"(acc[ai][bj][m][n]) : "v"(Bt##8[n]), "v"(At##8[m])); }     \
        else { _Pragma("unroll") for (int m = 0; m < 4; ++m) _Pragma("unroll") for (int n = 0; n < 2; ++n) _Pragma("unroll") for (int k = 0; k < 2; ++k) \
            acc[ai][bj][m][n] = __builtin_amdgcn_mfma_f32_16x16x32_bf16(Bt[n][k], At[m][k], acc[ai][bj][m][n], 0, 0, 0); } \
        __builtin_amdgcn_s_setprio(0); } while (0)
#define PG8_WAIT_V(n) asm volatile("s_waitcnt vmcnt(" #n ")" ::: "memory")
#define PG8_WAIT_L(n) asm volatile("s_waitcnt lgkmcnt(" #n ")" ::: "memory")
#define PG8_BAR __builtin_amdgcn_s_barrier()
#define PG8_SCHED __builtin_amdgcn_sched_barrier(0)
    Unit cur, nxt; int ui = 0;
    if (!S.next(0, cur)) return;
    f32x4 acc[2][2][4][2];
#pragma unroll
    for (int a = 0; a < 2; ++a)
#pragma unroll
        for (int b = 0; b < 2; ++b)
#pragma unroll
            for (int m = 0; m < 4; ++m)
#pragma unroll
                for (int n = 0; n < 2; ++n) acc[a][b][m][n] = (f32x4){0.f, 0.f, 0.f, 0.f};
    bf16x8 At[4][2], B0[2][2], B1[2][2];
    i32x8 At8[4], B08[2], B18[2];
    const char* cA; const char* cB; S.ptrs(cur, cA, cB);
    S.a_ready(cur);
    if constexpr (Sched::GATHER) {
#pragma unroll
        for (int i = 0; i < 2; ++i) { int R, C; stage_rc(tid * 16 + i * 8192, R, C); c0[i] = S.row_off(0, R) + (unsigned)(C * 2); c1[i] = S.row_off(0, 128 + R) + (unsigned)(C * 2); n0[i] = c0[i]; n1[i] = c1[i]; } }
    static_assert(SP2, "only the two-super-phase loop is kept in this file");
    PG8_STAGE(PG8_SB(0, 0), cB, voffB); PG8_STAGE(PG8_SB(0, 1), cB + hstepB, voffB); PG8_STAGE(PG8_SA(0, 0), cA, c0); PG8_STAGE(PG8_SA(0, 1), cA + hstepA, c1);
    if (wr == 1) PG8_BAR;
    PG8_WAIT_V(2); PG8_BAR;
    PG8_STAGE(PG8_SB(1, 0), cB + kstep, voffB); PG8_STAGE(PG8_SA(1, 0), cA + kstep, c0); PG8_STAGE(PG8_SB(1, 1), cB + hstepB + kstep, voffB);
    PG8_WAIT_V(6); PG8_BAR;
    for (;;) {
        const bool has_next = S.next(ui + 1, nxt);
        const char* nA = cA; const char* nB = cB; if (has_next) S.ptrs(nxt, nA, nB);
        const bool h1 = S.half1(cur);
        for (int t = 0; t < nt; t += 2) {
            const bool last = (t == nt - 2);
            const char* a1 = cA + (size_t)(t + 1) * kstep;
            const char* a2 = last ? nA : cA + (size_t)(t + 2) * kstep; const char* b2 = last ? nB : cB + (size_t)(t + 2) * kstep;
            const char* a3 = a2 + kstep; const char* b3 = b2 + kstep;
            if (last && has_next) { S.a_ready(nxt);
                if constexpr (Sched::GATHER) {
#pragma unroll
                    for (int i = 0; i < 2; ++i) { int R, C; stage_rc(tid * 16 + i * 8192, R, C); n0[i] = S.row_off(ui + 1, R) + (unsigned)(C * 2); n1[i] = S.row_off(ui + 1, 128 + R) + (unsigned)(C * 2); } } }
            const unsigned s0[2] = {last ? n0[0] : c0[0], last ? n0[1] : c0[1]}, s1[2] = {last ? n1[0] : c1[0], last ? n1[1] : c1[1]};
            PG8_LDB(B0, 0, 0); PG8_LDB(B1, 0, 1); PG8_SCHED; PG8_LDA(At, 0, 0); PG8_STAGE(PG8_SA(1, 1), a1 + hstepA, c1);
            PG8_WAIT_V(8); PG8_WAIT_L(0); PG8_BAR; PG8_MMA(0, 0, At, B0); PG8_MMA(0, 1, At, B1); PG8_BAR; PG8_SCHED;
            PG8_LDA(At, 0, 1); PG8_STAGE(PG8_SB(0, 0), b2, voffB); PG8_STAGE(PG8_SB(0, 1), b2 + hstepB, voffB); PG8_STAGE(PG8_SA(0, 0), a2, s0);
            PG8_WAIT_V(8); PG8_WAIT_L(0); PG8_BAR; if (h1) { PG8_MMA(1, 0, At, B0); PG8_MMA(1, 1, At, B1); } PG8_BAR; PG8_SCHED;
            PG8_LDB(B0, 1, 0); PG8_LDB(B1, 1, 1); PG8_SCHED; PG8_LDA(At, 1, 0); PG8_STAGE(PG8_SA(0, 1), a2 + hstepA, s1);
            PG8_WAIT_V(8); PG8_WAIT_L(0); PG8_BAR; PG8_MMA(0, 0, At, B0); PG8_MMA(0, 1, At, B1); PG8_BAR; PG8_SCHED;
            PG8_LDA(At, 1, 1); PG8_STAGE(PG8_SB(1, 0), b3, voffB); PG8_STAGE(PG8_SB(1, 1), b3 + hstepB, voffB); PG8_STAGE(PG8_SA(1, 0), a3, s0);
            PG8_WAIT_V(8); PG8_WAIT_L(0); PG8_BAR; if (h1) { PG8_MMA(1, 0, At, B0); PG8_MMA(1, 1, At, B1); } PG8_BAR; PG8_SCHED;
        }
        if constexpr (epi_fp8<Epi>::v) { asm volatile("s_nop 7\n\ts_nop 7\n\ts_nop 7" ::: "memory"); }
        if constexpr (ALIGN_EPI) { if (wr == 0) PG8_BAR; }
        if constexpr (!Epi::AFTER_DRAIN) { E(acc, cur, wr, wc, fr, fq); S.done(cur); }
        if (!has_next) break;
#pragma unroll
        for (int a = 0; a < 2; ++a)
#pragma unroll
            for (int b = 0; b < 2; ++b)
#pragma unroll
                for (int m = 0; m < 4; ++m)
#pragma unroll
                    for (int n = 0; n < 2; ++n) acc[a][b][m][n] = (f32x4){0.f, 0.f, 0.f, 0.f};
        cur = nxt; cA = nA; cB = nB; ++ui;
#pragma unroll
        for (int i = 0; i < 2; ++i) { c0[i] = n0[i]; c1[i] = n1[i]; }
        if constexpr (ALIGN_EPI) { if (wr == 1) PG8_BAR; }
    }
    PG8_WAIT_V(0);
    if constexpr (!ALIGN_EPI) { if (wr == 0) PG8_BAR; }
    PG8_BAR;
    if constexpr (Epi::AFTER_DRAIN) { E.fused(acc, cur, wr, wc, fr, fq, lds, wid, lane); S.done(cur); }
#undef PG8_SA
#undef PG8_SB
#undef PG8_STAGE
#undef PG8_LDA
#undef PG8_LD16
#undef PG8_LDB
#undef PG8_MMA
#undef PG8_WAIT_V
#undef PG8_WAIT_L
#undef PG8_BAR
#undef PG8_SCHED
}
}

constexpr size_t MiB = 1u << 20;
constexpr size_t al256(size_t x) { return (x + 255) & ~(size_t)255; }
constexpr size_t WS_CTL = 0, CTL_ZERO_BYTES = 1 * MiB;
constexpr int CW_BAR = 4096;
constexpr int CW_CNT = 49152, CNT_STRIDE = 64;
constexpr int CW_CVQ = 16384;
constexpr int CW_SSQ2 = 32768;
constexpr size_t WS_WIN = 1 * MiB;
constexpr size_t WS_WQB = WS_WIN + al256((size_t)INCP * D * 2);
constexpr size_t WS_WKVB = WS_WQB + al256((size_t)1536 * QL * 2);
constexpr size_t WS_WGLU = WS_WKVB + al256((size_t)2048 * KVL * 2);
constexpr size_t WS_WOUT = WS_WGLU + al256((size_t)SSMW * SSMW * 2);
constexpr size_t WS_WXQ = WS_WOUT + al256((size_t)D * D * 2);
constexpr size_t WS_WXK = WS_WXQ + al256((size_t)D * D * 2);
constexpr size_t WS_WXV = WS_WXK + al256((size_t)D * D * 2);
constexpr size_t WS_WXO = WS_WXV + al256((size_t)D * D * 2);
constexpr size_t WS_BTY = WS_WXO + al256((size_t)D * D * 2);
constexpr size_t WS_BTS = WS_BTY + al256((size_t)G * 512 * AGW * 2);
constexpr size_t WS_AP32 = WS_BTS + al256((size_t)G * 128 * 512 * 2);
constexpr size_t WS_HB = WS_AP32 + al256((size_t)G * P * 2 * 4);
constexpr size_t WS_MEMN = WS_HB + al256((size_t)T * D * 2);
constexpr size_t WS_PROJB = WS_MEMN + al256((size_t)TM * D * 2);
constexpr size_t WS_AG = WS_PROJB + al256((size_t)T * PJW * 2);
constexpr size_t WS_SC = WS_AG + al256((size_t)G * 256 * AGW * 2);
constexpr size_t WS_CQN = WS_SC + al256((size_t)G * 256 * 128 * 4);
constexpr size_t WS_CKVN = WS_CQN + al256((size_t)T * QL * 2);
constexpr size_t WS_KPE = WS_CKVN + al256((size_t)T * KVL * 2);
constexpr size_t WS_ROPE = WS_KPE + al256((size_t)T * DR * 2);
constexpr size_t WS_Q = WS_ROPE + al256((size_t)T * 64 * 4);
constexpr size_t WS_KV = WS_Q + al256((size_t)T * 1536 * 2);
constexpr size_t WS_XK = WS_KV + al256((size_t)T * 2048 * 2);
constexpr size_t WS_XVT = WS_XK + al256((size_t)TM * D * 2);
constexpr size_t WS_Y = WS_XVT + al256((size_t)D * TM * 2);
constexpr size_t WS_ATTO = WS_Y + al256((size_t)T * SSMW * 2);
constexpr size_t WS_SSMO = WS_ATTO + al256((size_t)T * 1024 * 2);
constexpr size_t WS_X1 = WS_SSMO + al256((size_t)T * 1024 * 2);
constexpr size_t WS_X1B = WS_X1 + al256((size_t)T * D * 4);
constexpr size_t WS_XQ = WS_X1B + al256((size_t)T * D * 2);
constexpr size_t WS_PX = WS_XQ + al256((size_t)T * D * 2);
constexpr size_t WS_WXQN = WS_XQ;
constexpr size_t WS_WKT8 = WS_XQ + (size_t)D * D * 2;
constexpr size_t WS_XO = WS_PX + al256((size_t)BATCH * XH * SEQ * MEM * 2);
constexpr size_t WS_X2 = WS_XO + al256((size_t)T * D * 2);
constexpr size_t WS_X2B = WS_X2 + al256((size_t)T * D * 4);
constexpr size_t WS_WRH = WS_X2B + al256((size_t)T * D * 2);
constexpr size_t WS_WRL = WS_WRH + al256((size_t)E * D * 2);
constexpr size_t WS_SELE = WS_WRL + al256((size_t)E * D * 2);
constexpr size_t WS_SELP = WS_SELE + al256((size_t)T * TOPK * 4);
constexpr size_t WS_SELG = WS_SELP + al256((size_t)T * TOPK * 4);
constexpr size_t WS_LIST = WS_SELG + al256((size_t)T * TOPK * 4);
constexpr int NSLOT = (T * TOPK / 256 + E) * 256;
constexpr size_t WS_ACT = WS_LIST + al256((size_t)E * T * 4);
constexpr size_t WS_YK = WS_ACT + al256((size_t)NSLOT * FF * 2);
constexpr size_t WS_WUP = WS_YK + al256((size_t)NSLOT * D * 2);
constexpr size_t WS_WDN = WS_WUP + al256((size_t)E * 2 * FF * D * 2);
constexpr size_t WS_X2F8 = WS_WDN + al256((size_t)E * D * FF * 2);
constexpr size_t WS_X1F8 = WS_X2F8 + al256((size_t)T * D);
constexpr size_t WS_XO8 = WS_X1F8 + al256((size_t)T * D);
constexpr size_t WS_WXQ8 = WS_XO8 + al256((size_t)T * D);
constexpr size_t WS_WXO8 = WS_WXQ8 + al256((size_t)D * D);
constexpr size_t WS_MIXED = WS_WXO8 + al256((size_t)D * D);
constexpr size_t WS_SSQP1 = WS_MIXED + al256((size_t)T * D * 2);
constexpr size_t WS_SSQP2 = WS_SSQP1 + al256((size_t)T * 32 * 4);
constexpr size_t WS_RSTD2 = WS_SSQP2 + al256((size_t)T * 32 * 4);
constexpr size_t WS_XV8 = WS_XVT;
constexpr size_t WS_VWT = WS_XO8;
constexpr size_t WS_END1 = WS_RSTD2 + al256((size_t)T * 4);

constexpr int NWAVES = 8, NTHR = 512;
constexpr int RING_OFF = 0, RING_BYTES = 131072;
constexpr int LDSCTL_OFF = RING_BYTES, MISC_OFF = LDSCTL_OFF + 320;
constexpr int TOK_OFF = LDSCTL_OFF + 1024, MAXU = 10;
constexpr int BLK_OFF = TOK_OFF + MAXU * 1024;
constexpr int LDS_BYTES = 147456;
static_assert(BLK_OFF + 480 * 4 <= LDS_BYTES, "LDS map");

#define GAS __attribute__((address_space(1)))
#define LAS __attribute__((address_space(3)))
typedef unsigned short bf16;
typedef unsigned v4u __attribute__((ext_vector_type(4)));
typedef unsigned v2u __attribute__((ext_vector_type(2)));
typedef float v2f __attribute__((ext_vector_type(2)));
typedef float f32x4 __attribute__((ext_vector_type(4)));
typedef short bf16x8 __attribute__((ext_vector_type(8)));
#define LDS_WAIT() asm volatile("s_waitcnt lgkmcnt(0)" ::: "memory")
#define VM_WAIT() asm volatile("s_waitcnt vmcnt(0)" ::: "memory")
__device__ __forceinline__ unsigned f2bf(float f) { unsigned u = __builtin_bit_cast(unsigned, f); return (u + 0x7fffu + ((u >> 16) & 1u)) >> 16; }
__device__ __forceinline__ unsigned pk2(float lo, float hi) { return f2bf(lo) | (f2bf(hi) << 16); }
__device__ __forceinline__ float bf2f(unsigned short h) { return __builtin_bit_cast(float, (unsigned)h << 16); }
__device__ __forceinline__ float bflo(unsigned w) { return __builtin_bit_cast(float, w << 16); }
__device__ __forceinline__ float bfhi(unsigned w) { return __builtin_bit_cast(float, w & 0xffff0000u); }

__device__ __forceinline__ float clamp448(float v) { return fminf(fmaxf(v, -448.0f), 448.0f); }
__device__ __forceinline__ float clamp448m(float v) { return __builtin_amdgcn_fmed3f(v, -448.0f, 448.0f); }
__device__ __forceinline__ unsigned pk4_fp8w(float a, float b, float c, float d) {
    int p = __builtin_amdgcn_cvt_pk_fp8_f32(clamp448m(a), clamp448m(b), 0, false); p = __builtin_amdgcn_cvt_pk_fp8_f32(clamp448m(c), clamp448m(d), p, true); return (unsigned)p; }
__device__ __forceinline__ unsigned pk4_fp8(float a, float b, float c, float d) {
    int p = __builtin_amdgcn_cvt_pk_fp8_f32(clamp448(a), clamp448(b), 0, false); p = __builtin_amdgcn_cvt_pk_fp8_f32(clamp448(c), clamp448(d), p, true); return (unsigned)p; }
constexpr float W8_SCALE = 256.0f, W8_INV = 1.0f / 256.0f;

#define XB_TMO      128
#define XB_XCNT(j)  (256  + 64 * (j))
#define XB_XSUB(j)  (1280 + 64 * (j))
#define XB_XGEN(j)  (2304 + 64 * (j))
#define XB_TOP      3328
#define XB_TOPGEN   3392
#define XB_FLAG(j)  (3456 + (j))
#define XCD_BAR_WORDS 3520
#define XB_SPIN_CAP (1u << 18)

__device__ __forceinline__ unsigned xb_ld(unsigned* p)              { return __hip_atomic_load(p, __ATOMIC_RELAXED, __HIP_MEMORY_SCOPE_AGENT); }
__device__ __forceinline__ unsigned xb_add(unsigned* p, unsigned v) { return __hip_atomic_fetch_add(p, v, __ATOMIC_RELAXED, __HIP_MEMORY_SCOPE_AGENT); }
__device__ __forceinline__ unsigned xb_xcc_id() { return (unsigned)__builtin_amdgcn_s_getreg((3 << 11) | 20) & 0xFu; }
#define XB_SPIN(cond, bar) do { unsigned _sp = 0; while (cond) { __builtin_amdgcn_s_sleep(1); \
    if ((++_sp & 255u) == 0u) { if (xb_ld(&(bar)[XB_TMO])) break; if (_sp > XB_SPIN_CAP) { atomicAdd(&(bar)[XB_TMO], 1u); break; } } } } while (0)

struct XcdBarrier {
    unsigned* bar; unsigned x; int wave;
    volatile LAS unsigned* st;
};
__device__ __forceinline__ bool xb_thread0(int wave) { return wave == 0 && lane_id_now() == 0; }
__device__ __forceinline__ XcdBarrier xcd_barrier_post(unsigned* bar, volatile LAS unsigned* st, int wave) {
    XcdBarrier b; b.bar = bar; b.x = xb_xcc_id(); b.st = st; b.wave = wave;
    if (xb_thread0(wave)) (void)xb_add(&bar[XB_XCNT(b.x)], 1u);
    return b;
}
__device__ __forceinline__ void xcd_barrier_complete(unsigned* bar, unsigned x, unsigned& nloc, unsigned& nx, unsigned& mask) {
    const unsigned G_ = gridDim.x * gridDim.y * gridDim.z;
    unsigned sum, cnt, mine, msk, sp = 0u;
    for (;;) {
        sum = 0u; cnt = 0u; mine = 0u; msk = 0u;
#pragma unroll
        for (unsigned j = 0; j < 16; ++j) { const unsigned c = xb_ld(&bar[XB_XCNT(j)]); sum += c; cnt += (c > 0u) ? 1u : 0u; msk |= (c > 0u) ? (1u << j) : 0u; mine = (j == x) ? c : mine; }
        if (sum == G_) break;
        __builtin_amdgcn_s_sleep(1);
        if ((++sp & 255u) == 0u) { if (xb_ld(&bar[XB_TMO])) break; if (sp > XB_SPIN_CAP) { atomicAdd(&bar[XB_TMO], 1u); break; } }
    }
    nloc = mine > 0u ? mine : 1u; nx = cnt > 0u ? cnt : 1u; mask = msk;
}
__device__ __forceinline__ void xb_wave0(const XcdBarrier& b, volatile LAS unsigned* stopw = nullptr, unsigned stopv = 0u) {
    unsigned* bar = b.bar;
    const int lane = lane_id_now();
    __builtin_amdgcn_s_waitcnt(0);
    unsigned gen = 0u;
    if (lane == 0) {
        unsigned nloc = b.st[0], nx = b.st[1], mask = b.st[2];
        if (nloc == 0u) { xcd_barrier_complete(bar, b.x, nloc, nx, mask); b.st[0] = nloc; b.st[1] = nx; b.st[2] = mask; }
        const unsigned old = xb_add(&bar[XB_XSUB(b.x)], 1u);
        gen = old / nloc;
        if (old + 1u == (gen + 1u) * nloc) {
            __builtin_amdgcn_fence(__ATOMIC_RELEASE, "agent");
            asm volatile("s_waitcnt vmcnt(0)" ::: "memory");
            xb_add(&bar[XB_FLAG(b.x)], 1u);
        }
    }
    gen = (unsigned)__builtin_amdgcn_readfirstlane((int)gen);
    asm volatile("s_waitcnt lgkmcnt(0)" ::: "memory");
    const unsigned mask = b.st[2];
    unsigned sp = 0u;
    for (;;) {
        unsigned f = 0u; if (lane < 16) f = xb_ld(&bar[XB_FLAG(lane)]);
        const bool waiting = (lane < 16) && ((mask >> lane) & 1u) && ((int)(f - gen) <= 0);
        const unsigned long long wm = __builtin_amdgcn_ballot_w64(waiting);
        if (wm == 0ull) break;
        if (stopw && 2 * __builtin_popcountll(wm) <= __builtin_popcount(mask)) { *stopw = stopv; stopw = nullptr; }
        __builtin_amdgcn_s_sleep(1);
        if ((++sp & 255u) == 0u) { if (xb_ld(&bar[XB_TMO])) break; if (sp > XB_SPIN_CAP) { if (lane == 0) atomicAdd(&bar[XB_TMO], 1u); break; } }
    }
    __builtin_amdgcn_fence(__ATOMIC_ACQUIRE, "agent");
    asm volatile("s_waitcnt vmcnt(0)" ::: "memory");
}
__device__ __forceinline__ void xcd_barrier(const XcdBarrier& b) {
    asm volatile("s_waitcnt vmcnt(0)" ::: "memory");
    __syncthreads();
    if (b.wave == 0) xb_wave0(b);
    __syncthreads();
}

__device__ __forceinline__ float wave_sum(float v) {
#pragma unroll
    for (int o = 1; o < 64; o <<= 1) v += __shfl_xor(v, o);
    return v;
}
__device__ __forceinline__ void transpose_item(const float* W, int N, bf16* WT, int ldk, const float* gain, LAS float* scr, int item, int nblk, int lane) {
    const int kb = item / nblk, nb = item % nblk, k0 = 64 * kb, n0 = 32 * nb;
#pragma unroll 8
    for (int i = 0; i < 32; ++i) { const int kk = 2 * i + (lane >> 5); const float g = gain ? gain[k0 + kk] : 1.0f;
        scr[kk * 33 + (lane & 31)] = W[(size_t)(k0 + kk) * N + n0 + (lane & 31)] * g; }
    LDS_WAIT(); asm volatile("" ::: "memory");
    const int c = lane & 7;
#pragma unroll
    for (int j = 0; j < 4; ++j) { const int n = (lane >> 3) + 8 * j; const LAS float* s = scr + (8 * c) * 33 + n;
        v4u o; o.x = pk2(s[0 * 33], s[1 * 33]); o.y = pk2(s[2 * 33], s[3 * 33]); o.z = pk2(s[4 * 33], s[5 * 33]); o.w = pk2(s[6 * 33], s[7 * 33]);
        *(GAS v4u*)(WT + (size_t)(n0 + n) * ldk + k0 + 8 * c) = o; }
    LDS_WAIT(); asm volatile("" ::: "memory");
}
__device__ __forceinline__ void rms_row_to_bf16(const float* xrow, const float* g, bf16* orow, int lane) {
    const GAS f32x4* xr = (const GAS f32x4*)xrow + lane;
    f32x4 v[8], gv[8]; float s = 0.f;
#pragma unroll
    for (int j = 0; j < 8; ++j) { v[j] = xr[64 * j]; gv[j] = ((const GAS f32x4*)g)[lane + 64 * j]; }
#pragma unroll
    for (int j = 0; j < 8; ++j) s += (v[j].x * v[j].x + v[j].y * v[j].y) + (v[j].z * v[j].z + v[j].w * v[j].w);
    const float r = rsqrtf(wave_sum(s) * (1.f / D) + EPS);
    GAS v2u* o8 = (GAS v2u*)orow + lane;
#pragma unroll
    for (int j = 0; j < 8; ++j) { const f32x4 gg = gv[j];
        v2u o; o.x = pk2(v[j].x * r * gg.x, v[j].y * r * gg.y); o.y = pk2(v[j].z * r * gg.z, v[j].w * r * gg.w); o8[64 * j] = o; }
}

__device__ __forceinline__ void s5_setup(int g, LAS unsigned char* lds, const float* lam_re, const float* lam_im, const float* log_dt, const float* b_re, const float* b_im,
                                         const float* c_re, const float* c_im, bf16* BTY, bf16* BTS, float* AP32, int tid) {
    LAS float* apr = (LAS float*)lds;
    LAS float* api = apr + 33 * 64;
    LAS float* bbr = api + 33 * 64;
    LAS float* bbi = bbr + 1024;
    LAS float* ccr = bbi + 1024;
    LAS float* cci = ccr + 1024;
    LAS float* Kd = cci + 1024;
    const float dt = expf(log_dt[g]);
    for (int idx = tid; idx < 33 * 64; idx += NTHR) { const int d = idx >> 6, p = idx & 63; const float lr = lam_re[g * 64 + p], li = lam_im[g * 64 + p];
        const float mag = expf((float)d * (lr * dt)), ang = (float)d * (li * dt); apr[idx] = mag * cosf(ang); api[idx] = mag * sinf(ang); }
    for (int idx = tid; idx < 1024; idx += NTHR) { ccr[idx] = c_re[g * 1024 + idx]; cci[idx] = c_im[g * 1024 + idx]; }
    __syncthreads();
    for (int idx = tid; idx < 1024; idx += NTHR) { const int p = idx >> 4; const float lr = lam_re[g * 64 + p], li = lam_im[g * 64 + p];
        const float nr = apr[64 + p] - 1.0f, ni = api[64 + p], den = lr * lr + li * li; const float cre = (nr * lr + ni * li) / den, cim = (ni * lr - nr * li) / den;
        const float br = b_re[g * 1024 + idx], bi = b_im[g * 1024 + idx]; bbr[idx] = cre * br - cim * bi; bbi[idx] = cre * bi + cim * br; }
    __syncthreads();
    for (int idx = tid; idx < 32 * 256; idx += NTHR) { const int d = idx >> 8, co = (idx >> 4) & 15, ci = idx & 15; float a = 0.f;
        for (int p = 0; p < 64; ++p) { const float cr = ccr[co * 64 + p], cm = cci[co * 64 + p], ar = apr[d * 64 + p], ai = api[d * 64 + p];
            const float car = cr * ar - cm * ai, cai = cr * ai + cm * ar; a += car * bbr[p * 16 + ci] - cai * bbi[p * 16 + ci]; }
        Kd[idx] = a; }
    __syncthreads();
    for (int idx = tid; idx < 512 * 80; idx += NTHR) { const int row = idx / 80, q = idx % 80, i = row >> 4, co = row & 15; float v[8];
        if (q < 64) { const int j = q >> 1, ci0 = (q & 1) * 8;
#pragma unroll
            for (int e = 0; e < 8; ++e) v[e] = (j <= i) ? Kd[(i - j) * 256 + co * 16 + ci0 + e] : 0.f; }
        else if (q < 72) { const int p0 = (q - 64) * 8;
#pragma unroll
            for (int e = 0; e < 8; ++e) { const int p = p0 + e; v[e] = ccr[co * 64 + p] * apr[(i + 1) * 64 + p] - cci[co * 64 + p] * api[(i + 1) * 64 + p]; } }
        else { const int p0 = (q - 72) * 8;
#pragma unroll
            for (int e = 0; e < 8; ++e) { const int p = p0 + e; v[e] = -(ccr[co * 64 + p] * api[(i + 1) * 64 + p] + cci[co * 64 + p] * apr[(i + 1) * 64 + p]); } }
        v4u o; o.x = pk2(v[0], v[1]); o.y = pk2(v[2], v[3]); o.z = pk2(v[4], v[5]); o.w = pk2(v[6], v[7]);
        *(GAS v4u*)(BTY + ((size_t)g * 512 + row) * AGW + q * 8) = o; }
    for (int idx = tid; idx < 128 * 64; idx += NTHR) { const int row = idx >> 6, q = idx & 63, p = row & 63, part = row >> 6, j = q >> 1, ci0 = (q & 1) * 8; float v[8];
        const float ar = apr[(31 - j) * 64 + p], ai = api[(31 - j) * 64 + p];
#pragma unroll
        for (int e = 0; e < 8; ++e) { const float br = bbr[p * 16 + ci0 + e], bi = bbi[p * 16 + ci0 + e]; v[e] = part ? (ar * bi + ai * br) : (ar * br - ai * bi); }
        v4u o; o.x = pk2(v[0], v[1]); o.y = pk2(v[2], v[3]); o.z = pk2(v[4], v[5]); o.w = pk2(v[6], v[7]);
        *(GAS v4u*)(BTS + ((size_t)g * 128 + row) * 512 + q * 8) = o; }
    if (tid < 64) { AP32[(g * 64 + tid) * 2] = apr[32 * 64 + tid]; AP32[(g * 64 + tid) * 2 + 1] = api[32 * 64 + tid]; }
    __syncthreads();
}

using pg8::Unit;
template <bool RS, bool F8 = false, bool O8 = false> struct EpiPlain {
    static constexpr bool PERM = true, AFTER_DRAIN = false, FP8 = F8;
    bf16* O; int ldc; int zdiv; long zC1, zC2; const LAS float* rstd;
    __device__ __forceinline__ void operator()(const f32x4 (&acc)[2][2][4][2], const Unit& u, int wr, int wc, int fr, int fq) const {
        const long zoff = (long)(u.z / zdiv) * zC1 + (long)(u.z % zdiv) * zC2;
        const int row0 = u.pm * 256 + wr * 64 + fr, col0 = u.pn * 256 + wc * 32 + 8 * fq;
#pragma unroll
        for (int ai = 0; ai < 2; ++ai)
#pragma unroll
            for (int m = 0; m < 4; ++m) { const int row = row0 + ai * 128 + m * 16; const size_t eo = (size_t)zoff + (size_t)row * ldc + col0;
                float sc = F8 ? W8_INV : 1.f; if (RS) sc *= rstd[row - u.pm * 256];
#pragma unroll
                for (int bj = 0; bj < 2; ++bj) { const f32x4 v0 = acc[ai][bj][m][0] * sc, v1 = acc[ai][bj][m][1] * sc;
                    if constexpr (O8) { v2u w; w.x = pk4_fp8(v0[0], v0[1], v0[2], v0[3]); w.y = pk4_fp8(v1[0], v1[1], v1[2], v1[3]); *(v2u*)((unsigned char*)O + eo + bj * 128) = w; }
                    else { v4u w; w.x = pg8::cvt_pk_bf16(v0[0], v0[1]); w.y = pg8::cvt_pk_bf16(v0[2], v0[3]); w.z = pg8::cvt_pk_bf16(v1[0], v1[1]); w.w = pg8::cvt_pk_bf16(v1[2], v1[3]);
                        *(v4u*)(O + eo + bj * 128) = w; } } }
    }
};
struct EpiProj {
    static constexpr bool PERM = true, AFTER_DRAIN = false;
    bf16* projb; bf16* Ag;
    __device__ __forceinline__ void operator()(const f32x4 (&acc)[2][2][4][2], const Unit& u, int wr, int wc, int fr, int fq) const {
        const int row0 = u.pm * 256 + wr * 64 + fr;
#pragma unroll
        for (int bj = 0; bj < 2; ++bj) { const int colg = u.pn * 256 + bj * 128 + wc * 32, c0 = colg + 8 * fq;
            if (colg >= INC) continue;
#pragma unroll
            for (int ai = 0; ai < 2; ++ai)
#pragma unroll
                for (int m = 0; m < 4; ++m) { const int row = row0 + ai * 128 + m * 16; const f32x4 v0 = acc[ai][bj][m][0], v1 = acc[ai][bj][m][1]; v4u w;
                    w.x = pg8::cvt_pk_bf16(v0[0], v0[1]); w.y = pg8::cvt_pk_bf16(v0[2], v0[3]); w.z = pg8::cvt_pk_bf16(v1[0], v1[1]); w.w = pg8::cvt_pk_bf16(v1[2], v1[3]);
                    if (colg < PJW) *(v4u*)(projb + (size_t)row * PJW + c0) = w;
                    else { const int ch = c0 - PJW, g = ch >> 4, c = ch & 15; *(v4u*)(Ag + ((size_t)g * 256 + (row >> 5)) * AGW + (row & 31) * 16 + c) = w; } } }
    }
};
struct EpiS5State {
    static constexpr bool PERM = false, AFTER_DRAIN = false;
    float* Sc;
    __device__ __forceinline__ void operator()(const f32x4 (&acc)[2][2][4][2], const Unit& u, int wr, int wc, int fr, int fq) const {
        const int row0 = wr * 64 + fr, col0 = wc * 32 + 4 * fq;
#pragma unroll
        for (int ai = 0; ai < 2; ++ai)
#pragma unroll
            for (int m = 0; m < 4; ++m) { float* rowp = Sc + ((size_t)u.z * 256 + row0 + ai * 128 + m * 16) * 128 + col0;
#pragma unroll
                for (int n = 0; n < 2; ++n) *(f32x4*)(rowp + n * 16) = acc[ai][0][m][n]; }
    }
};
__device__ __forceinline__ float gelu_tanh(float v) {
    const float t = v * (0.7978845608028654f + 0.7978845608028654f * 0.044715f * v * v);
    return v * __builtin_amdgcn_rcpf(1.0f + __builtin_amdgcn_exp2f(-2.885390081777927f * t));
}
struct EpiS5Y {
    static constexpr bool PERM = true, AFTER_DRAIN = false;
    const bf16* Ag; const float* dsk; bf16* Y;
    __device__ __forceinline__ void operator()(const f32x4 (&acc)[2][2][4][2], const Unit& u, int wr, int wc, int fr, int fq) const {
        const int g = u.z, row0 = wr * 64 + fr;
        v4u ub2[2][8]; f32x4 dd[2][2];
#pragma unroll
        for (int bj = 0; bj < 2; ++bj) { const int c0 = u.pn * 256 + bj * 128 + wc * 32 + 8 * fq, co = c0 & 15;
            dd[bj][0] = *(const f32x4*)(dsk + g * 16 + co); dd[bj][1] = *(const f32x4*)(dsk + g * 16 + co + 4);
#pragma unroll
            for (int q = 0; q < 8; ++q) ub2[bj][q] = *(const v4u*)(Ag + ((size_t)g * 256 + row0 + (q >> 2) * 128 + (q & 3) * 16) * AGW + c0); }
#pragma unroll
        for (int bj = 0; bj < 2; ++bj) { const int c0 = u.pn * 256 + bj * 128 + wc * 32 + 8 * fq, i = c0 >> 4, co = c0 & 15;
            const f32x4 d0 = dd[bj][0], d1 = dd[bj][1];
#pragma unroll
            for (int ai = 0; ai < 2; ++ai)
#pragma unroll
                for (int m = 0; m < 4; ++m) { const int r = row0 + ai * 128 + m * 16;
                    const v4u uu = ub2[bj][ai * 4 + m];
                    f32x4 v0 = acc[ai][bj][m][0], v1 = acc[ai][bj][m][1];
                    v0[0] += d0[0] * bflo(uu.x); v0[1] += d0[1] * bfhi(uu.x); v0[2] += d0[2] * bflo(uu.y); v0[3] += d0[3] * bfhi(uu.y);
                    v1[0] += d1[0] * bflo(uu.z); v1[1] += d1[1] * bfhi(uu.z); v1[2] += d1[2] * bflo(uu.w); v1[3] += d1[3] * bfhi(uu.w);
                    v4u w; w.x = pg8::cvt_pk_bf16(gelu_tanh(v0[0]), gelu_tanh(v0[1])); w.y = pg8::cvt_pk_bf16(gelu_tanh(v0[2]), gelu_tanh(v0[3]));
                    w.z = pg8::cvt_pk_bf16(gelu_tanh(v1[0]), gelu_tanh(v1[1])); w.w = pg8::cvt_pk_bf16(gelu_tanh(v1[2]), gelu_tanh(v1[3]));
                    *(v4u*)(Y + ((size_t)(r * 32 + i)) * SSMW + g * 16 + co) = w; } }
    }
};

struct EpiGlu {
    static constexpr bool PERM = true, AFTER_DRAIN = false;
    const bf16* Y; const float* bias; bf16* O;
    __device__ __forceinline__ void operator()(const f32x4 (&acc)[2][2][4][2], const Unit& u, int wr, int wc, int fr, int fq) const {
        const int row0 = u.pm * 256 + wr * 64 + fr;
        v4u yb2[2][8]; f32x4 bb[2][2];
#pragma unroll
        for (int bj = 0; bj < 2; ++bj) { const int c0 = u.pn * 256 + bj * 128 + wc * 32 + 8 * fq;
            bb[bj][0] = *(const f32x4*)(bias + c0); bb[bj][1] = *(const f32x4*)(bias + c0 + 4);
#pragma unroll
            for (int q = 0; q < 8; ++q) yb2[bj][q] = *(const v4u*)(Y + (size_t)(row0 + (q >> 2) * 128 + (q & 3) * 16) * SSMW + c0); }
#pragma unroll
        for (int bj = 0; bj < 2; ++bj) { const int c0 = u.pn * 256 + bj * 128 + wc * 32 + 8 * fq;
            const f32x4 b0 = bb[bj][0], b1 = bb[bj][1];
#pragma unroll
            for (int ai = 0; ai < 2; ++ai)
#pragma unroll
                for (int m = 0; m < 4; ++m) { const size_t off = (size_t)(row0 + ai * 128 + m * 16) * SSMW + c0;
                    const v4u yy = yb2[bj][ai * 4 + m]; const f32x4 z0 = acc[ai][bj][m][0] + b0, z1 = acc[ai][bj][m][1] + b1;
#define SG(z) __builtin_amdgcn_rcpf(1.0f + __builtin_amdgcn_exp2f(-1.4426950408889634f * (z)))
                    v4u w; w.x = pg8::cvt_pk_bf16(bflo(yy.x) * SG(z0[0]), bfhi(yy.x) * SG(z0[1])); w.y = pg8::cvt_pk_bf16(bflo(yy.y) * SG(z0[2]), bfhi(yy.y) * SG(z0[3]));
                    w.z = pg8::cvt_pk_bf16(bflo(yy.z) * SG(z1[0]), bfhi(yy.z) * SG(z1[1])); w.w = pg8::cvt_pk_bf16(bflo(yy.w) * SG(z1[2]), bfhi(yy.w) * SG(z1[3]));
#undef SG
                    *(v4u*)(O + off) = w; } }
    }
};
template <bool F8 = false> struct EpiResid {
    static constexpr bool PERM = false, AFTER_DRAIN = false, FP8 = F8;
    const float* res; float* Xo; bf16* Xb; float* ssq; unsigned char* X8; int zrows;
    __device__ __forceinline__ void operator()(const f32x4 (&acc)[2][2][4][2], const Unit& u, int wr, int wc, int fr, int fq) const {
        const int row0 = (u.z * zrows + u.pm) * 256 + wr * 64 + fr, col0 = u.pn * 256 + wc * 32 + 4 * fq;
        constexpr int RB = 4;
        f32x4 rb[RB][4];
#define ER_LOAD(idx) do { const size_t off_ = (size_t)(row0 + ((idx) >> 2) * 128 + ((idx) & 3) * 16) * D + col0; _Pragma("unroll") for (int q = 0; q < 4; ++q) rb[(idx) % RB][q] = *(const f32x4*)(res + off_ + (q >> 1) * 128 + (q & 1) * 16); } while (0)
#pragma unroll
        for (int i = 0; i < RB - 1; ++i) ER_LOAD(i);
#pragma unroll
        for (int idx = 0; idx < 8; ++idx) { const int ai = idx >> 2, m = idx & 3, row = row0 + ai * 128 + m * 16; const size_t off = (size_t)row * D + col0; float s = 0.f;
            if (idx + RB - 1 < 8) ER_LOAD(idx + RB - 1);
#pragma unroll
            for (int bj = 0; bj < 2; ++bj)
#pragma unroll
                for (int n = 0; n < 2; ++n) { const size_t o2 = off + bj * 128 + n * 16; const f32x4 v = rb[idx % RB][bj * 2 + n] + acc[ai][bj][m][n] * (F8 ? W8_INV : 1.0f);
                    *(f32x4*)(Xo + o2) = v; if (Xb) { v2u w; w.x = pg8::cvt_pk_bf16(v[0], v[1]); w.y = pg8::cvt_pk_bf16(v[2], v[3]); *(v2u*)(Xb + o2) = w; }
                    if (X8) *(unsigned*)(X8 + o2) = pk4_fp8(v[0], v[1], v[2], v[3]);
                    s += (v[0] * v[0] + v[1] * v[1]) + (v[2] * v[2] + v[3] * v[3]); }
            s += __shfl_xor(s, 16); s += __shfl_xor(s, 32);
            if (fq == 0) ssq[(size_t)row * 32 + u.pn * 4 + wc] = s; }
#undef ER_LOAD
    }
};

template <bool FOLD = false> struct EpiSoftmax {
    static constexpr bool PERM = true, AFTER_DRAIN = true, FP8 = FOLD;
    bf16* Pm; const LAS float* rstd;
    __device__ __forceinline__ void fused(f32x4 (&acc)[2][2][4][2], const Unit& u, int wr, int wc, int fr, int fq, PG8_LAS unsigned char* lds, int wid, int lane) const {
        PG8_LAS float* Rm = (PG8_LAS float*)lds;
        PG8_LAS float* Rs = Rm + 1024;
        constexpr float CS = 1.4426950408889634f * 0.04419417382415922f;
        float mx[2][4];
        if constexpr (FOLD) {
#pragma unroll
            for (int ai = 0; ai < 2; ++ai)
#pragma unroll
                for (int m = 0; m < 4; ++m) { const float rs = rstd[ai * 128 + wr * 64 + m * 16 + fr];
#pragma unroll
                    for (int bj = 0; bj < 2; ++bj)
#pragma unroll
                        for (int n = 0; n < 2; ++n) acc[ai][bj][m][n] *= rs; } }
#pragma unroll
        for (int ai = 0; ai < 2; ++ai)
#pragma unroll
            for (int m = 0; m < 4; ++m) { float v = -3.0e38f;
#pragma unroll
                for (int bj = 0; bj < 2; ++bj)
#pragma unroll
                    for (int n = 0; n < 2; ++n) { const f32x4 a = acc[ai][bj][m][n]; v = fmaxf(v, fmaxf(fmaxf(a[0], a[1]), fmaxf(a[2], a[3]))); }
                v = fmaxf(v, __shfl_xor(v, 16)); v = fmaxf(v, __shfl_xor(v, 32));
                if (fq == 0) Rm[(ai * 128 + wr * 64 + m * 16 + fr) * 4 + wc] = v; }
        asm volatile("s_waitcnt lgkmcnt(0)" ::: "memory"); __builtin_amdgcn_s_barrier(); asm volatile("" ::: "memory");
#pragma unroll
        for (int ai = 0; ai < 2; ++ai)
#pragma unroll
            for (int m = 0; m < 4; ++m) { const int r = ai * 128 + wr * 64 + m * 16 + fr; const f32x4 q = *(const PG8_LAS f32x4*)(Rm + r * 4);
                const float rm = fmaxf(fmaxf(q[0], q[1]), fmaxf(q[2], q[3])) * CS; mx[ai][m] = rm; float s = 0.f;
#pragma unroll
                for (int bj = 0; bj < 2; ++bj)
#pragma unroll
                    for (int n = 0; n < 2; ++n) { f32x4 a = acc[ai][bj][m][n];
#pragma unroll
                        for (int e = 0; e < 4; ++e) { a[e] = __builtin_amdgcn_exp2f(fmaf(a[e], CS, -rm)); s += a[e]; }
                        acc[ai][bj][m][n] = a; }
                s += __shfl_xor(s, 16); s += __shfl_xor(s, 32);
                if (fq == 0) Rs[r * 4 + wc] = s; }
        asm volatile("s_waitcnt lgkmcnt(0)" ::: "memory"); __builtin_amdgcn_s_barrier(); asm volatile("" ::: "memory");
        bf16* base = FOLD ? Pm + (size_t)u.z * SEQ * (XH * MEM) + u.pn * MEM : Pm + (size_t)u.z * SEQ * MEM;
        constexpr int PLD = FOLD ? XH * MEM : MEM;
#pragma unroll
        for (int ai = 0; ai < 2; ++ai)
#pragma unroll
            for (int m = 0; m < 4; ++m) { const int r = ai * 128 + wr * 64 + m * 16 + fr; const f32x4 q = *(const PG8_LAS f32x4*)(Rs + r * 4);
                const float inv = __builtin_amdgcn_rcpf((q[0] + q[1]) + (q[2] + q[3])) * (FOLD ? W8_SCALE : 1.0f);
                if constexpr (FOLD) {
                    unsigned char* rowp8 = (unsigned char*)Pm + (size_t)u.z * SEQ * PLD + (size_t)(u.pm * 256 + r) * PLD + u.pn * MEM + wc * 32 + 8 * fq;
#pragma unroll
                    for (int bj = 0; bj < 2; ++bj) { const f32x4 v0 = acc[ai][bj][m][0] * inv, v1 = acc[ai][bj][m][1] * inv; v2u w;
                        w.x = pk4_fp8(v0[0], v0[1], v0[2], v0[3]); w.y = pk4_fp8(v1[0], v1[1], v1[2], v1[3]); *(v2u*)(rowp8 + bj * 128) = w; }
                } else {
                bf16* rowp = base + (size_t)(u.pm * 256 + r) * PLD + wc * 32 + 8 * fq;
#pragma unroll
                for (int bj = 0; bj < 2; ++bj) { const f32x4 v0 = acc[ai][bj][m][0] * inv, v1 = acc[ai][bj][m][1] * inv; v4u w;
                    w.x = pg8::cvt_pk_bf16(v0[0], v0[1]); w.y = pg8::cvt_pk_bf16(v0[2], v0[3]); w.z = pg8::cvt_pk_bf16(v1[0], v1[1]); w.w = pg8::cvt_pk_bf16(v1[2], v1[3]);
                    *(v4u*)(rowp + bj * 128) = w; } } }
        (void)mx;
    }
};

struct EpiVW {
    static constexpr bool PERM = true, AFTER_DRAIN = false, FP8 = true;
    bf16* O;
    __device__ __forceinline__ void operator()(const f32x4 (&acc)[2][2][4][2], const Unit& u, int wr, int wc, int fr, int fq) const {
        const int row0 = u.pm * 256 + wr * 64 + fr;
#pragma unroll
        for (int ai = 0; ai < 2; ++ai)
#pragma unroll
            for (int m = 0; m < 4; ++m) { unsigned char* rowp = (unsigned char*)O + ((size_t)u.pn * D + row0 + ai * 128 + m * 16) * (XH * MEM) + u.z * MEM + wc * 32 + 8 * fq;
#pragma unroll
                for (int bj = 0; bj < 2; ++bj) { const f32x4 v0 = acc[ai][bj][m][0] * W8_INV, v1 = acc[ai][bj][m][1] * W8_INV; v2u w;
                    w.x = pk4_fp8(v0[0], v0[1], v0[2], v0[3]); w.y = pk4_fp8(v1[0], v1[1], v1[2], v1[3]); *(v2u*)(rowp + bj * 128) = w; } }
    }
};
template <bool GATHER_> struct MoeSched {
    static constexpr bool GATHER = GATHER_;
    int NB, nN, G, c, lda; const char* A; const char* B; long tA, eB, tB;
    const LAS int* blkE; const LAS int* tokTab;
    __device__ __forceinline__ bool next(int i, Unit& u) const { const int L = i * G + c; if (L >= NB * nN) return false; u.z = L / nN; u.pn = L % nN; u.pm = i; return true; }
    __device__ __forceinline__ void ptrs(const Unit& u, const char*& a, const char*& b_) const { const int e = blkE[u.z]; a = GATHER_ ? A : A + (long)u.z * tA; b_ = B + (long)e * eB + (long)u.pn * tB; }
    __device__ __forceinline__ unsigned row_off(int ui, int row) const { return (unsigned)tokTab[ui * 256 + row] * (unsigned)lda; }
    __device__ __forceinline__ bool half1(const Unit& u) const { return blkE[320 + u.z] > 128; }
    __device__ __forceinline__ void a_ready(const Unit&) const {}
    __device__ __forceinline__ void done(const Unit&) const {}
};
struct EpiMoeUp {
    static constexpr bool PERM = true, AFTER_DRAIN = false, FP8 = true;
    const LAS int* blkE; const LAS int* tokTab; const float* ssq; const float* bup; unsigned char* ACT;
    __device__ __forceinline__ void operator()(const f32x4 (&acc)[2][2][4][2], const Unit& u, int wr, int wc, int fr, int fq) const {
        asm volatile("" : "+v"(fr), "+v"(fq));
        const int e = blkE[u.z], c0 = u.pn * 128 + wc * 32 + 8 * fq, row0 = wr * 64 + fr;
        const float* bg = bup + (size_t)e * 2 * FF + c0; const f32x4 g0 = *(const f32x4*)bg, g1 = *(const f32x4*)(bg + 4), l0 = *(const f32x4*)(bg + FF), l1 = *(const f32x4*)(bg + FF + 4);
        float rsb[8];
#pragma unroll
        for (int q = 0; q < 8; ++q) rsb[q] = ssq[tokTab[u.pm * 256 + row0 + (q >> 2) * 128 + (q & 3) * 16]] * W8_INV;
#pragma unroll
        for (int ai = 0; ai < 2; ++ai)
#pragma unroll
            for (int m = 0; m < 4; ++m) { const int r = row0 + ai * 128 + m * 16; const float rs = rsb[ai * 4 + m];
                float a[8];
#pragma unroll
                for (int j = 0; j < 8; ++j) { const float gb = j < 4 ? g0[j & 3] : g1[j & 3], lb = j < 4 ? l0[j & 3] : l1[j & 3];
                    const float gl = fminf(acc[ai][0][m][j >> 2][j & 3] * rs + gb, 7.0f), ln = fminf(fmaxf(acc[ai][1][m][j >> 2][j & 3] * rs + lb, -7.0f), 7.0f);
                    a[j] = gl * __builtin_amdgcn_rcpf(1.0f + __builtin_amdgcn_exp2f(-1.702f * 1.4426950408889634f * gl)) * (ln + 1.0f); }
                v2u w; w.x = pk4_fp8(a[0], a[1], a[2], a[3]); w.y = pk4_fp8(a[4], a[5], a[6], a[7]);
                *(v2u*)(ACT + ((size_t)u.z * 256 + r) * FF + c0) = w; }
    }
};
constexpr float Y8_SCALE = 32.0f, Y8_INV = 1.0f / 32.0f;
struct EpiMoeDown {
    static constexpr bool PERM = true, AFTER_DRAIN = false, FP8 = true;
    const LAS int* blkE; const float* bdn; unsigned char* YK;
    __device__ __forceinline__ void operator()(const f32x4 (&acc)[2][2][4][2], const Unit& u, int wr, int wc, int fr, int fq) const {
        const int e = blkE[u.z], row0 = wr * 64 + fr;
        f32x4 bq[2][2];
#pragma unroll
        for (int bj = 0; bj < 2; ++bj) { const int c0 = u.pn * 256 + bj * 128 + wc * 32 + 8 * fq; bq[bj][0] = *(const f32x4*)(bdn + (size_t)e * D + c0); bq[bj][1] = *(const f32x4*)(bdn + (size_t)e * D + c0 + 4); }
#pragma unroll
        for (int bj = 0; bj < 2; ++bj) { const int c0 = u.pn * 256 + bj * 128 + wc * 32 + 8 * fq; const f32x4 b0 = bq[bj][0] * Y8_SCALE, b1 = bq[bj][1] * Y8_SCALE;
#pragma unroll
            for (int ai = 0; ai < 2; ++ai)
#pragma unroll
                for (int m = 0; m < 4; ++m) { const int r = row0 + ai * 128 + m * 16; const f32x4 v0 = acc[ai][bj][m][0] * (W8_INV * Y8_SCALE) + b0, v1 = acc[ai][bj][m][1] * (W8_INV * Y8_SCALE) + b1; v2u w;
                    w.x = pk4_fp8(v0[0], v0[1], v0[2], v0[3]); w.y = pk4_fp8(v1[0], v1[1], v1[2], v1[3]);
                    *(v2u*)(YK + ((size_t)u.z * 256 + r) * D + c0) = w; } }
    }
};
__device__ __forceinline__ int moe_block_table(const unsigned* counts, LAS int* blkE, int tid) {
    if (tid < 64) {
        const int cnt = tid < E ? (int)counts[tid * CNT_STRIDE] : 0, nb = (cnt + 255) >> 8;
        int inc = nb;
#pragma unroll
        for (int o = 1; o < 64; o <<= 1) { const int v = __shfl_up(inc, o); if (tid >= o) inc += v; }
        const int base = inc - nb;
        for (int j = 0; j < nb; ++j) { blkE[base + j] = tid; blkE[160 + base + j] = j; const int left = cnt - j * 256; blkE[320 + base + j] = left < 256 ? left : 256; }
        if (tid == 63) blkE[480] = inc;
    }
    __syncthreads();
    return blkE[480];
}

struct TItem { const float* src; bf16* dst; const float* gain; int N, ldk; };
template <bool GAIN> __device__ __forceinline__ void titem_load(const TItem& d, int lane, f32x4 (&r)[16], f32x4 (&g)[4]) {
    const int q = lane & 15, kg = lane >> 4; const float* p = d.src + (size_t)(8 * kg) * d.N + 4 * q;
#pragma unroll
    for (int j = 0; j < 16; ++j) r[j] = *(const GAS f32x4*)(p + (size_t)(32 * (j >> 3) + (j & 7)) * d.N);
    if constexpr (GAIN) {
#pragma unroll
        for (int j4 = 0; j4 < 4; ++j4) g[j4] = *(const GAS f32x4*)(d.gain + 32 * (j4 >> 1) + 8 * kg + 4 * (j4 & 1)); }
    asm volatile("" ::: "memory"); __builtin_amdgcn_sched_barrier(0);
}
template <bool GAIN> __device__ __forceinline__ void titem_store(const TItem& d, int lane, const f32x4 (&r)[16], const f32x4 (&g)[4]) {
    const int q = lane & 15, kg = lane >> 4;
    bf16* o = d.dst + (size_t)(4 * q) * d.ldk + 8 * kg;
#define TG(j) (GAIN ? g[(j) >> 2][(j) & 3] : 1.0f)
#pragma unroll
    for (int i = 0; i < 4; ++i)
#pragma unroll
        for (int h = 0; h < 2; ++h) { v4u w;
            w.x = pg8::cvt_pk_bf16(r[8 * h + 0][i] * TG(8 * h + 0), r[8 * h + 1][i] * TG(8 * h + 1)); w.y = pg8::cvt_pk_bf16(r[8 * h + 2][i] * TG(8 * h + 2), r[8 * h + 3][i] * TG(8 * h + 3));
            w.z = pg8::cvt_pk_bf16(r[8 * h + 4][i] * TG(8 * h + 4), r[8 * h + 5][i] * TG(8 * h + 5)); w.w = pg8::cvt_pk_bf16(r[8 * h + 6][i] * TG(8 * h + 6), r[8 * h + 7][i] * TG(8 * h + 7));
            *(GAS v4u*)(o + (size_t)i * d.ldk + 32 * h) = w; }
#undef TG
}
template <bool GAIN, bool NT = false> __device__ __forceinline__ void titem8_load(const TItem& d, int lane, f32x4 (&r)[16], f32x4 (&g)[4]) {
    const int q = lane & 7, kg = lane >> 3; const unsigned lo = (unsigned)((16 * kg) * d.N + 4 * q) * 4u;
    const GAS char* base = (const GAS char*)d.src;
#pragma unroll
    for (int j = 0; j < 16; ++j) { const GAS f32x4* p = (const GAS f32x4*)(base + (size_t)j * (size_t)d.N * 4 + lo); r[j] = NT ? __builtin_nontemporal_load(p) : *p; }
    if constexpr (GAIN) { const GAS char* gb = (const GAS char*)d.gain; const unsigned go = (unsigned)(16 * kg) * 4u;
#pragma unroll
        for (int j4 = 0; j4 < 4; ++j4) g[j4] = *(const GAS f32x4*)(gb + 16 * j4 + go); }
    asm volatile("" ::: "memory"); __builtin_amdgcn_sched_barrier(0);
}
template <bool GAIN, bool NT = false> __device__ __forceinline__ void titem8_store(const TItem& d, int lane, const f32x4 (&r)[16], const f32x4 (&g)[4]) {
    const int q = lane & 7, kg = lane >> 3; const unsigned lo = (unsigned)((4 * q) * d.ldk + 16 * kg);
    GAS char* base = (GAS char*)d.dst;
    f32x4 s[16];
#pragma unroll
    for (int j = 0; j < 16; ++j) s[j] = r[j] * ((GAIN ? g[j >> 2][j & 3] : 1.0f) * W8_SCALE);
#pragma unroll
    for (int i = 0; i < 4; ++i) { v4u w;
        w.x = pk4_fp8w(s[0][i], s[1][i], s[2][i], s[3][i]); w.y = pk4_fp8w(s[4][i], s[5][i], s[6][i], s[7][i]);
        w.z = pk4_fp8w(s[8][i], s[9][i], s[10][i], s[11][i]); w.w = pk4_fp8w(s[12][i], s[13][i], s[14][i], s[15][i]);
        GAS v4u* p = (GAS v4u*)(base + (size_t)i * (size_t)d.ldk + lo);
        if (NT) __builtin_nontemporal_store(w, p); else *p = w; }
}
#define TSTREAM(n_, DEC, LOAD, STORE) do { f32x4 ra[16], rb[16], ga[4], gb[4]; int it0 = gw; \
        if (it0 < (n_)) { TItem d0 = DEC(it0); LOAD(d0, lane, ra, ga); \
            for (;;) { const int it1 = it0 + NGW; \
                if (!(it1 < (n_))) { STORE(d0, lane, ra, ga); break; } \
                TItem d1 = DEC(it1); LOAD(d1, lane, rb, gb); STORE(d0, lane, ra, ga);            \
                it0 = it1 + NGW; \
                if (!(it0 < (n_))) { STORE(d1, lane, rb, gb); break; } \
                d0 = DEC(it0); LOAD(d0, lane, ra, ga); STORE(d1, lane, rb, gb); } } } while (0)

#define TI8S_NT titem8_store<false, true>
#define TI8L_NT titem8_load<false, true>
struct MoeSchedUpCv : MoeSched<true> {
    const float* wdn; unsigned char* wdn8; int wave;
    __device__ __forceinline__ TItem dec_dn(int it) const { constexpr int I_DN = (FF / 128) * (D / 32); TItem d; int r = it; const int e = r / I_DN; r -= e * I_DN;
        const int nb_ = D / 32, kb = r / nb_, nbi = r % nb_; d.src = wdn + (size_t)e * FF * D + (size_t)(128 * kb) * D + 32 * nbi; d.dst = (bf16*)(wdn8 + (size_t)e * D * FF + (size_t)(32 * nbi) * FF + 128 * kb);
        d.gain = wdn; d.N = D; d.ldk = FF; return d; }
    __device__ __forceinline__ void convert_share() const {
        const int lane = lane_id_now(), gw = c * NWAVES + wave, NGW = G * NWAVES;
        constexpr int NIT = E * (FF / 128) * (D / 32);
        TSTREAM(NIT, dec_dn, TI8L_NT, TI8S_NT);
    }
    __device__ __forceinline__ void done(const Unit& u) const { if (u.pm == (c & 7)) convert_share(); }
};

constexpr int CV_I_UP = (D / 128) * (2 * FF / 32), CV_ITEMS = E * CV_I_UP;
constexpr int CV_BATCH = 4;
struct CvWork { const float* wup; const float* gain; unsigned char* wup8; volatile LAS int* cur; volatile LAS unsigned* rel; unsigned* q; int wave; };
__device__ __forceinline__ bool cv_one(const CvWork& w) {
    if (w.wave == 0) return false;
    int it = __builtin_amdgcn_readfirstlane(w.cur[2 * w.wave]); const int end = __builtin_amdgcn_readfirstlane(w.cur[2 * w.wave + 1]);
    if (it >= end) {
        if (it > CV_ITEMS) return false;
        unsigned base = 0u; if (lane_id_now() == 0) base = __hip_atomic_fetch_add(w.q, (unsigned)CV_BATCH, __ATOMIC_RELAXED, __HIP_MEMORY_SCOPE_AGENT);
        base = __builtin_amdgcn_readfirstlane(base);
        if (base >= (unsigned)CV_ITEMS) { w.cur[2 * w.wave] = CV_ITEMS + 1; w.cur[2 * w.wave + 1] = 0; return false; }
        it = (int)base; w.cur[2 * w.wave + 1] = (int)base + CV_BATCH;
    }
    TItem d; { int r = it; const int e = r / CV_I_UP; r -= e * CV_I_UP; const int nb_ = 2 * FF / 32, kb = r / nb_, nbi = r % nb_;
        d.src = w.wup + (size_t)e * D * 2 * FF + (size_t)(128 * kb) * (2 * FF) + 32 * nbi; d.dst = (bf16*)(w.wup8 + (size_t)e * 2 * FF * D + (size_t)(32 * nbi) * D + 128 * kb);
        d.gain = w.gain + 128 * kb; d.N = 2 * FF; d.ldk = D; }
    const int lane = lane_id_now();
    f32x4 r[16], g[4]; titem8_load<true, true>(d, lane, r, g); titem8_store<true, true>(d, lane, r, g);
    w.cur[2 * w.wave] = it + 1;
    return true;
}
__device__ __forceinline__ void cv_flush(const CvWork& w) { while (cv_one(w)) {} }
__device__ __forceinline__ void xcd_barrier_cv(const XcdBarrier& b, const CvWork& w) {
    asm volatile("s_waitcnt vmcnt(0)" ::: "memory");
    const unsigned g0 = w.rel[0];
    __syncthreads();
    if (b.wave == 0) {
        xb_wave0(b, w.rel + 1, g0 + 1u);
        w.rel[0] = g0 + 1u;
    } else if (b.wave != 0) {
        unsigned guard = 0;
        while (w.rel[0] == g0) { if (w.rel[1] == g0 + 1u) { __builtin_amdgcn_s_sleep(1); continue; }
            if (!cv_one(w)) __builtin_amdgcn_s_sleep(4); if (++guard > (1u << 22)) break; }
    }
    asm volatile("s_waitcnt lgkmcnt(0)" ::: "memory"); __builtin_amdgcn_s_barrier(); asm volatile("" ::: "memory");
}

namespace mla {
typedef short s16x4 __attribute__((ext_vector_type(4)));
typedef float f32x16 __attribute__((ext_vector_type(16)));
constexpr int KVBLK = 64, QB = 256;
constexpr int SHM_V = KVBLK * 128 * 2, SHM_K = KVBLK * 128 * 2, SHM_P = KVBLK * 64 * 2;
constexpr int BUFB = SHM_V + SHM_K + SHM_P, V_OFF = 0, K_OFF = SHM_V, P_OFF = SHM_V + SHM_K, NBUF = 3, W_OFF = NBUF * BUFB;
constexpr float C2 = 1.4426950408889634f * 0.07216878364870322f;
#define KSWZ(row, colB) ((row) * 256 + ((colB) ^ (((row) & 7) << 4)))
#define KPSWZ(row, colB) ((row) * 128 + ((colB) ^ ((((row) >> 1) & 7) << 4)))
#define SBAR() __builtin_amdgcn_sched_barrier(0)
__device__ __forceinline__ int v_st(int k, int c) { const int kk = (k & ~0xC) | ((k & 4) << 1) | ((k & 8) >> 1); return ((kk >> 3) * 4 + (c >> 5)) * 512 + ((kk & 7) * 32 + (c & 31)) * 2; }
__device__ __forceinline__ int v_rd_base(int lane) { return ((lane & 3) << 3) | (((lane >> 2) & 3) << 6) | (((lane >> 4) & 1) << 5) | (((lane >> 5) & 1) << 8); }
constexpr int v_rd_off(int d0, int ks, int half) { return d0 * 512 + ks * 4096 + half * 2048; }
__device__ __forceinline__ int crow(int r, int hi) { return (r & 3) + 8 * (r >> 2) + 4 * hi; }
__device__ __forceinline__ unsigned cvtpk(float lo, float hi) { unsigned r; asm volatile("v_cvt_pk_bf16_f32 %0, %1, %2" : "=v"(r) : "v"(lo), "v"(hi)); return r; }

__device__ __forceinline__ void mask_tile(f32x16& p0, f32x16& p1, int dq) {
    const float NEG = -__builtin_inff();
#pragma unroll
    for (int r = 0; r < 16; ++r) { const int c = (r & 3) + 8 * (r >> 2);
        if (dq - c < 0) p0[r] = NEG;
        if (dq - c - 32 < 0) p1[r] = NEG; }
}
__device__ __forceinline__ void partialSM(f32x16& p0, f32x16& p1, float& m_reg, float& mn, float& alpha) {
    float pmax = p0[0];
#pragma unroll
    for (int r = 1; r < 16; ++r) pmax = fmaxf(pmax, p0[r]);
#pragma unroll
    for (int r = 0; r < 16; ++r) pmax = fmaxf(pmax, p1[r]);
    { auto rr = __builtin_amdgcn_permlane32_swap(__float_as_uint(pmax), __float_as_uint(pmax), false, false);
      pmax = fmaxf(__uint_as_float(rr[0]), __uint_as_float(rr[1])); }
    mn = fmaxf(m_reg, pmax); alpha = __builtin_amdgcn_exp2f((m_reg - mn) * C2); m_reg = mn;
    const float mnL = -mn * C2;
#pragma unroll
    for (int r = 0; r < 16; ++r) p0[r] = __builtin_amdgcn_exp2f(fmaf(p0[r], C2, mnL));
#pragma unroll
    for (int r = 0; r < 16; ++r) p1[r] = __builtin_amdgcn_exp2f(fmaf(p1[r], C2, mnL));
}
__device__ __forceinline__ void finishSM(f32x16& p0, f32x16& p1, float alpha, float& l_reg, bf16x8& pa0, bf16x8& pa1, bf16x8& pa2, bf16x8& pa3) {
    float ps = 0;
#pragma unroll
    for (int r = 0; r < 16; ++r) ps += p0[r];
#pragma unroll
    for (int r = 0; r < 16; ++r) ps += p1[r];
    { auto rr = __builtin_amdgcn_permlane32_swap(__float_as_uint(ps), __float_as_uint(ps), false, false);
      ps = __uint_as_float(rr[0]) + __uint_as_float(rr[1]); }
    l_reg = l_reg * alpha + ps;
#define PK4(P, B_, OUT) do { unsigned a0 = cvtpk(P[B_+0], P[B_+1]), a1 = cvtpk(P[B_+2], P[B_+3]);                          \
        unsigned b0 = cvtpk(P[B_+4], P[B_+5]), b1 = cvtpk(P[B_+6], P[B_+7]);                                             \
        auto r0 = __builtin_amdgcn_permlane32_swap(a0, b0, false, false); auto r1 = __builtin_amdgcn_permlane32_swap(a1, b1, false, false); \
        v4u w = {r0[0], r1[0], r0[1], r1[1]}; OUT = *reinterpret_cast<bf16x8*>(&w); } while (0)
    PK4(p0, 0, pa0); PK4(p0, 8, pa1); PK4(p1, 0, pa2); PK4(p1, 8, pa3);
#undef PK4
}
__device__ __forceinline__ void qkt(f32x16& p0, f32x16& p1, LAS unsigned char* lds  , int r32, int hi, const bf16x8* qr) {
    p0 = f32x16{}; p1 = f32x16{};
    const LAS unsigned char* kb[4];
#pragma unroll
    for (int dd = 0; dd < 4; ++dd) kb[dd] = lds + K_OFF + KSWZ(r32, (dd * 16 + hi * 8) * 2);
#pragma unroll
    for (int d0 = 0; d0 < 8; ++d0) { const LAS unsigned char* a = kb[d0 & 3] + (d0 >> 2) * 128;
        const bf16x8 b0 = *(const LAS bf16x8*)(a);
        const bf16x8 b1 = *(const LAS bf16x8*)(a + 32 * 256);
        p0 = __builtin_amdgcn_mfma_f32_32x32x16_bf16(b0, qr[d0], p0, 0, 0, 0);
        p1 = __builtin_amdgcn_mfma_f32_32x32x16_bf16(b1, qr[d0], p1, 0, 0, 0); }
#pragma unroll
    for (int e = 0; e < 4; ++e) { const LAS unsigned char* a = lds + P_OFF + KPSWZ(r32, (e * 2 + hi) * 16);
        const bf16x8 b0 = *(const LAS bf16x8*)(a);
        const bf16x8 b1 = *(const LAS bf16x8*)(a + 32 * 128);
        p0 = __builtin_amdgcn_mfma_f32_32x32x16_bf16(b0, qr[8 + e], p0, 0, 0, 0);
        p1 = __builtin_amdgcn_mfma_f32_32x32x16_bf16(b1, qr[8 + e], p1, 0, 0, 0); }
}
__device__ __forceinline__ void pv_tile(f32x16* o, int vb0  , bf16x8 pa0, bf16x8 pa1, bf16x8 pa2, bf16x8 pa3) {
#define TRRD(dst, off) asm volatile("ds_read_b64_tr_b16 %0, %1 offset:%2" : "=&v"(dst) : "v"(vb0), "i"(off) : "memory")
#define PV_D0(d0) do { s16x4 l0, l1, l2, l3, h0, h1, h2, h3; constexpr int b_ = V_OFF + v_rd_off(d0, 0, 0); \
        TRRD(l0, b_); TRRD(h0, b_ + 2048); TRRD(l1, b_ + 4096); TRRD(h1, b_ + 6144); TRRD(l2, b_ + 8192); TRRD(h2, b_ + 10240); TRRD(l3, b_ + 12288); TRRD(h3, b_ + 14336); \
        asm volatile("s_waitcnt lgkmcnt(0)" ::: "memory"); SBAR();   \
        o[d0] = __builtin_amdgcn_mfma_f32_32x32x16_bf16(pa0, (bf16x8){l0[0], l0[1], l0[2], l0[3], h0[0], h0[1], h0[2], h0[3]}, o[d0], 0, 0, 0);   \
        o[d0] = __builtin_amdgcn_mfma_f32_32x32x16_bf16(pa1, (bf16x8){l1[0], l1[1], l1[2], l1[3], h1[0], h1[1], h1[2], h1[3]}, o[d0], 0, 0, 0);   \
        o[d0] = __builtin_amdgcn_mfma_f32_32x32x16_bf16(pa2, (bf16x8){l2[0], l2[1], l2[2], l2[3], h2[0], h2[1], h2[2], h2[3]}, o[d0], 0, 0, 0);   \
        o[d0] = __builtin_amdgcn_mfma_f32_32x32x16_bf16(pa3, (bf16x8){l3[0], l3[1], l3[2], l3[3], h3[0], h3[1], h3[2], h3[3]}, o[d0], 0, 0, 0); } while (0)
    PV_D0(0); PV_D0(1); PV_D0(2); PV_D0(3);
#undef PV_D0
#undef TRRD
}

__device__ __forceinline__ void attn_unit(LAS unsigned char* lds, int b, int h, int qb, const bf16* Q  , const bf16* KV  , const bf16* KPE  ,
                                          const float* ROPE  , bf16* O  , const int wave_) {
    int tid_ = wave_ * 64 + lane_id_now(); asm volatile("" : "+v"(tid_));
    const int tid = tid_, wid = __builtin_amdgcn_readfirstlane(tid >> 6), lane = tid & 63, r32 = lane & 31, hi = lane >> 5;
    const int NT = ((15 - qb) * 128 + 128) / KVBLK;
    const int qlo = (wid < 4 ? qb * 128 + wid * 32 : (15 - qb) * 128 + (wid - 4) * 32), qm = qlo + r32 - 4 * hi;
    const size_t tok0 = (size_t)b * SEQ;
    bf16x8 qr[12];
    { const size_t t = tok0 + qlo + r32; const bf16* qp = Q + t * 1536 + h * 192 + hi * 8;
#pragma unroll
      for (int d0 = 0; d0 < 12; ++d0) qr[d0] = *(const bf16x8*)(qp + d0 * 16);
      const float* rp = ROPE + t * 64 + hi * 8;
#pragma unroll
      for (int e = 0; e < 2; ++e) {
          const f32x4 c0 = *(const f32x4*)(rp + 16 * e), c1 = *(const f32x4*)(rp + 16 * e + 4), s0 = *(const f32x4*)(rp + 32 + 16 * e), s1 = *(const f32x4*)(rp + 32 + 16 * e + 4);
          const v4u xa = *reinterpret_cast<v4u*>(&qr[8 + e]), xb = *reinterpret_cast<v4u*>(&qr[10 + e]); v4u ya, yb;
#define ROPE2(W, CL, CH, SL, SH) { const float a0 = bflo(xa.W), a1 = bfhi(xa.W), b0 = bflo(xb.W), b1 = bfhi(xb.W); \
          ya.W = cvtpk(a0 * CL - b0 * SL, a1 * CH - b1 * SH); yb.W = cvtpk(b0 * CL + a0 * SL, b1 * CH + a1 * SH); }
          ROPE2(x, c0[0], c0[1], s0[0], s0[1]); ROPE2(y, c0[2], c0[3], s0[2], s0[3]); ROPE2(z, c1[0], c1[1], s1[0], s1[1]); ROPE2(w, c1[2], c1[3], s1[2], s1[3]);
#undef ROPE2
          qr[8 + e] = *reinterpret_cast<bf16x8*>(&ya); qr[10 + e] = *reinterpret_cast<bf16x8*>(&yb); } }
    const int vb0 = (int)(uintptr_t)(lds) + v_rd_base(lane);
    LAS float* wsf = (LAS float*)(lds + W_OFF) + wid * 64; LAS float* li_l = wsf; LAS float* al_l = wsf + 32;
    unsigned so[5];
#pragma unroll
    for (int p = 0; p < 2; ++p) { const int s = p * 512 + tid;
        { const int sub = s >> 5, within = s & 31, kk = (sub >> 2) * 8 + (within >> 2), k = (kk & ~0xC) | ((kk & 4) << 1) | ((kk & 8) >> 1), c = (sub & 3) * 32 + (within & 3) * 8;
          so[p] = (unsigned)(k * 2048 + h * 256 + 128 + c); }
        { const int row = s >> 4, chunk = (s & 15) ^ (row & 7); so[2 + p] = (unsigned)(row * 2048 + h * 256 + chunk * 8); } }
    { const int row = tid >> 3, chunk = (tid & 7) ^ ((row >> 1) & 7); so[4] = (unsigned)(row * 64 + chunk * 8); }
    const bf16* KVt = KV + tok0 * 2048; const bf16* KPt = KPE + tok0 * 64;
#define AISSUE(tile, bufoff) do { const bf16* kv_ = KVt + (size_t)(tile) * (KVBLK * 2048); const bf16* kp_ = KPt + (size_t)(tile) * (KVBLK * 64); \
        __builtin_amdgcn_global_load_lds((const unsigned*)(kv_ + so[0]), (LAS unsigned*)(lds + (bufoff) + V_OFF + wid * 1024), 16, 0, 0); \
        __builtin_amdgcn_global_load_lds((const unsigned*)(kv_ + so[1]), (LAS unsigned*)(lds + (bufoff) + V_OFF + 8192 + wid * 1024), 16, 0, 0); \
        __builtin_amdgcn_global_load_lds((const unsigned*)(kv_ + so[2]), (LAS unsigned*)(lds + (bufoff) + K_OFF + wid * 1024), 16, 0, 0); \
        __builtin_amdgcn_global_load_lds((const unsigned*)(kv_ + so[3]), (LAS unsigned*)(lds + (bufoff) + K_OFF + 8192 + wid * 1024), 16, 0, 0); \
        __builtin_amdgcn_global_load_lds((const unsigned*)(kp_ + so[4]), (LAS unsigned*)(lds + (bufoff) + P_OFF + wid * 1024), 16, 0, 0); } while (0)
    float m_reg = -1e30f, l_reg = 0.f; f32x16 o[4] = {};
    f32x16 p0, p1; float mn, alpha; bf16x8 pa0, pa1, pa2, pa3;
    asm volatile("s_waitcnt vmcnt(0)" ::: "memory");
    AISSUE(0, 0); AISSUE(1, BUFB);
    int bc = 0, bl = 2 * BUFB;
    for (int t = 0; t < NT; ++t) {
        asm volatile("s_waitcnt vmcnt(5)" ::: "memory"); __builtin_amdgcn_s_barrier();
        { const int tn = (t + 2 < NT) ? t + 2 : NT - 1; AISSUE(tn, bl); }
        const int kb_ = t * KVBLK;
        if (kb_ <= qlo + 31) {
            SBAR(); qkt(p0, p1, lds + bc, r32, hi, qr);
            if (kb_ + KVBLK - 1 > qlo) mask_tile(p0, p1, qm - kb_);
            partialSM(p0, p1, m_reg, mn, alpha);
            if (__any(alpha < 1.f)) { if (hi == 0) al_l[r32] = alpha; LDS_WAIT();
#pragma unroll
                for (int d_ = 0; d_ < 4; ++d_)
#pragma unroll
                    for (int r = 0; r < 16; ++r) o[d_][r] *= al_l[crow(r, hi)]; }
            finishSM(p0, p1, alpha, l_reg, pa0, pa1, pa2, pa3); SBAR();
            pv_tile(o, vb0 + bc, pa0, pa1, pa2, pa3); }
        bc = (bc == 2 * BUFB) ? 0 : bc + BUFB; bl = (bl == 2 * BUFB) ? 0 : bl + BUFB;
    }
#undef AISSUE
    asm volatile("s_waitcnt vmcnt(0)" ::: "memory");
    if (hi == 0) li_l[r32] = l_reg; LDS_WAIT();
    bf16* Ow = O + (tok0 + qlo) * 1024 + h * 128;
#pragma unroll
    for (int r = 0; r < 16; ++r) { const int orow = crow(r, hi); const float rl = __builtin_amdgcn_rcpf(li_l[orow]);
#pragma unroll
        for (int d0 = 0; d0 < 4; ++d0) { const float v = o[d0][r] * rl; const float vn = __shfl_xor(v, 1);
            if ((r32 & 1) == 0) *(unsigned*)(Ow + (size_t)orow * 1024 + d0 * 32 + r32) = cvtpk(v, vn); } }
    __syncthreads();
}
#undef KSWZ
#undef KPSWZ
#undef SBAR
}

struct Args { const void* in[36]; float* out; unsigned char* ws; int ph_lo, ph_hi, li, pad; };
constexpr int N_PHASES = 15;

__device__ __forceinline__ void mla_thin_token(int t, int lane, const bf16* projb, const float* qg, const float* kvg, const int* pos, bf16* cqn, bf16* ckvn, bf16* kpe, float* rope) {
    const unsigned* pr = (const unsigned*)(projb + (size_t)t * PJW);
    unsigned wq[3], wk[2]; float sq = 0.f, sk = 0.f;
    v2f gq[3], gk[2];
#pragma unroll
    for (int j = 0; j < 3; ++j) { wq[j] = pr[lane + 64 * j]; gq[j] = *(const v2f*)(qg + 2 * (lane + 64 * j)); }
#pragma unroll
    for (int j = 0; j < 2; ++j) { wk[j] = pr[192 + lane + 64 * j]; gk[j] = *(const v2f*)(kvg + 2 * (lane + 64 * j)); }
    const int pos_t = pos[t]; const bf16* kp = projb + (size_t)t * PJW + 640; const float x1 = bf2f(kp[lane & 31]), x2 = bf2f(kp[(lane & 31) + 32]);
#pragma unroll
    for (int j = 0; j < 3; ++j) { const float a = bflo(wq[j]), b = bfhi(wq[j]); sq += a * a + b * b; }
#pragma unroll
    for (int j = 0; j < 2; ++j) { const float a = bflo(wk[j]), b = bfhi(wk[j]); sk += a * a + b * b; }
    const float rq = rsqrtf(wave_sum(sq) * (1.f / QL) + EPS), rk = rsqrtf(wave_sum(sk) * (1.f / KVL) + EPS);
#pragma unroll
    for (int j = 0; j < 3; ++j) ((unsigned*)(cqn + (size_t)t * QL))[lane + 64 * j] = pk2(bflo(wq[j]) * rq * gq[j][0], bfhi(wq[j]) * rq * gq[j][1]);
#pragma unroll
    for (int j = 0; j < 2; ++j) ((unsigned*)(ckvn + (size_t)t * KVL))[lane + 64 * j] = pk2(bflo(wk[j]) * rk * gk[j][0], bfhi(wk[j]) * rk * gk[j][1]);
    if (lane < 32) {
        const float inv = 1.0f / powf(10000.0f, (float)(2 * lane) / 64.0f), ang = (float)pos_t * inv, c = cosf(ang), s = sinf(ang);
        rope[(size_t)t * 64 + lane] = c; rope[(size_t)t * 64 + 32 + lane] = s;
        kpe[(size_t)t * 64 + lane] = (bf16)f2bf(x1 * c - x2 * s); kpe[(size_t)t * 64 + 32 + lane] = (bf16)f2bf(x2 * c + x1 * s);
    }
}
__device__ __forceinline__ void s5_scan_group(int g, LAS unsigned char* lds, const float* Sc, const float* AP32, bf16* Ag, int tid) {
    LAS f32x4* S4 = (LAS f32x4*)lds;
    const GAS f32x4* src = (const GAS f32x4*)(Sc + (size_t)g * 256 * 128);
#pragma unroll 16
    for (int i = tid; i < 256 * 32; i += NTHR) S4[i] = src[i];
    __syncthreads();
    if (tid < 256) { const int b = tid >> 6, p = tid & 63; const float ar = AP32[(g * 64 + p) * 2], ai = AP32[(g * 64 + p) * 2 + 1]; float xr = 0.f, xi = 0.f;
        const LAS float* S = (const LAS float*)lds;
        for (int ch = 0; ch < NCH; ++ch) { const int row = b * NCH + ch; bf16* o = Ag + ((size_t)g * 256 + row) * AGW + 512;
            o[p] = (bf16)f2bf(xr); o[64 + p] = (bf16)f2bf(xi);
            const float sr = S[row * 128 + p], si = S[row * 128 + 64 + p];
            const float nr = ar * xr - ai * xi + sr, ni = ar * xi + ai * xr + si; xr = nr; xi = ni; } }
    VM_WAIT(); __syncthreads();
}

__device__ __forceinline__ void route_tile(int tile, LAS unsigned char* lds, const float* X2, const float* ssq2, float* rstd2, const bf16* WRH, const bf16* WRL, const float* brt,
                                           unsigned* counts, int* SELE, int* SELP, float* SELG, int* LIST, int tid) {
    typedef float f32x16 __attribute__((ext_vector_type(16)));
    const int wid = tid >> 6, lane = tid & 63, r32 = lane & 31, hi = lane >> 5, t0 = tile * 32;
    f32x16 acc = {};
    const float* xp = X2 + (size_t)(t0 + r32) * D + wid * 256 + hi * 8;
    const bf16* wh = WRH + (size_t)r32 * D + wid * 256 + hi * 8; const bf16* wl = WRL + (size_t)r32 * D + wid * 256 + hi * 8;
#pragma unroll 4
    for (int s = 0; s < 16; ++s) {
        const f32x4 a = *(const f32x4*)(xp + 16 * s), b = *(const f32x4*)(xp + 16 * s + 4);
        float xv[8] = {a[0], a[1], a[2], a[3], b[0], b[1], b[2], b[3]}; unsigned hh[8], ll[8];
#pragma unroll
        for (int j = 0; j < 8; ++j) { hh[j] = f2bf(xv[j]); ll[j] = f2bf(xv[j] - __builtin_bit_cast(float, hh[j] << 16)); }
        v4u ph = {hh[0] | (hh[1] << 16), hh[2] | (hh[3] << 16), hh[4] | (hh[5] << 16), hh[6] | (hh[7] << 16)}, pl = {ll[0] | (ll[1] << 16), ll[2] | (ll[3] << 16), ll[4] | (ll[5] << 16), ll[6] | (ll[7] << 16)};
        const bf16x8 xh = *reinterpret_cast<bf16x8*>(&ph), xl = *reinterpret_cast<bf16x8*>(&pl);
        const bf16x8 bh = *(const bf16x8*)(wh + 16 * s), bl = *(const bf16x8*)(wl + 16 * s);
        acc = __builtin_amdgcn_mfma_f32_32x32x16_bf16(xh, bh, acc, 0, 0, 0);
        acc = __builtin_amdgcn_mfma_f32_32x32x16_bf16(xl, bh, acc, 0, 0, 0);
        acc = __builtin_amdgcn_mfma_f32_32x32x16_bf16(xh, bl, acc, 0, 0, 0);
    }
    LAS float* red = (LAS float*)lds;
    LAS float* lg = red + 8 * 32 * 33;
#pragma unroll
    for (int r = 0; r < 16; ++r) red[(wid * 32 + ((r & 3) + 8 * (r >> 2) + 4 * hi)) * 33 + r32] = acc[r];
    __syncthreads();
    for (int idx = tid; idx < 1024; idx += NTHR) { const int tk = idx >> 5, e = idx & 31; float s = 0.f;
#pragma unroll
        for (int w = 0; w < 8; ++w) s += red[(w * 32 + tk) * 33 + e];
        lg[tk * 33 + e] = s; }
    __syncthreads();
    if (tid < 32) { const int t = t0 + tid; float sq = 0.f;
#pragma unroll
        for (int k = 0; k < 8; ++k) { const f32x4 v = *(const f32x4*)(ssq2 + (size_t)t * 32 + 4 * k); sq += v[0]; sq += v[1]; sq += v[2]; sq += v[3]; }
        const float rs = rsqrtf(sq * (1.f / D) + EPS); rstd2[t] = rs;
        float l[E];
#pragma unroll
        for (int e = 0; e < E; ++e) l[e] = lg[tid * 33 + e] * rs + brt[e];
        float tv[TOPK]; int ti[TOPK];
#pragma unroll
        for (int k = 0; k < TOPK; ++k) { float best = -INFINITY; int bi = 0;
#pragma unroll
            for (int e = 0; e < E; ++e) if (l[e] > best) { best = l[e]; bi = e; }
            tv[k] = best; ti[k] = bi;
#pragma unroll
            for (int e = 0; e < E; ++e) if (e == bi) l[e] = -INFINITY; }
        float sum = 0.f, ex[TOPK];
#pragma unroll
        for (int k = 0; k < TOPK; ++k) { ex[k] = expf(tv[k] - tv[0]); sum += ex[k]; }
        LAS unsigned* lcnt = (LAS unsigned*)(lg + 32 * 33); LAS unsigned* lbase = lcnt + 32;
        lcnt[tid] = 0u; LDS_WAIT();
        int lp[TOPK];
#pragma unroll
        for (int k = 0; k < TOPK; ++k) lp[k] = (int)__hip_atomic_fetch_add(&lcnt[ti[k]], 1u, __ATOMIC_RELAXED, __HIP_MEMORY_SCOPE_WORKGROUP);
        LDS_WAIT();
        { const unsigned n = lcnt[tid]; lbase[tid] = n ? atomicAdd(&counts[tid * CNT_STRIDE], n) : 0u; }
        LDS_WAIT();
#pragma unroll
        for (int k = 0; k < TOPK; ++k) { const int pos = (int)lbase[ti[k]] + lp[k];
            SELE[t * TOPK + k] = ti[k]; SELP[t * TOPK + k] = pos; SELG[t * TOPK + k] = ex[k] / sum; LIST[(size_t)ti[k] * T + pos] = t; } }
    __syncthreads();
}

__global__ void __launch_bounds__(NTHR, 2) fwd(Args args) {
    extern __shared__ __attribute__((aligned(16))) unsigned char lds_raw[];
    LAS unsigned char* lds = (LAS unsigned char*)lds_raw;
    volatile LAS unsigned* MISC = (volatile LAS unsigned*)(lds + MISC_OFF);
    int wave_ = __builtin_amdgcn_readfirstlane((int)threadIdx.x >> 6); asm volatile("" : "+s"(wave_));
    const int wave = wave_;
#define LANE_NOW() ({ int l_ = lane_id_now(); asm volatile("" : "+v"(l_)); l_; })
    const int NG = gridDim.x, bx = blockIdx.x;
    unsigned char* ws = args.ws;
    unsigned* ctl = (unsigned*)(ws + WS_CTL);
    { const int tid = wave * 64 + LANE_NOW();
      for (int u = tid; u < (LDS_BYTES - LDSCTL_OFF) / 4; u += NTHR) ((LAS unsigned*)(lds + LDSCTL_OFF))[u] = 0u; }
    __syncthreads();
    const int lo = args.ph_lo, hi = args.ph_hi;
    const bool multi = (hi - lo) > 1;
    XcdBarrier bar; bar.bar = ctl + CW_BAR + args.li * XCD_BAR_WORDS; bar.x = 0; bar.st = nullptr; bar.wave = wave;
    if (multi) bar = xcd_barrier_post(ctl + CW_BAR + args.li * XCD_BAR_WORDS, MISC + 8, wave);
#define IN(k) (lo <= (k) && (k) < hi)
#define BOTH(k) (IN(k) && IN((k) + 1))
#define GRID_BAR() xcd_barrier(bar)
#define GRID_BAR_CV() xcd_barrier_cv(bar, cvw)
#if defined(PROBE_PHASE) || defined(PROBE_RANGE)
#define PRB(p, T_) ((args.li == 1) ? (T_)(ws + WS_END1 + (8u << 20)) : (T_)(p))
#else
#define PRB(p, T_) ((T_)(p))
#endif
#define INP(i) ((const float*)args.in[i])
#define WSP(T_, off) ((T_*)(ws + (off)))
    const CvWork cvw{INP(31), INP(28), WSP(unsigned char, WS_WUP), (volatile LAS int*)(MISC + 16), MISC + 12, ctl + CW_CVQ, wave};
    if (IN(0)) {
        const int lane = LANE_NOW(), tid = wave * 64 + lane; (void)tid; (void)lane;
        const int gw = bx * NWAVES + wave, NGW = NG * NWAVES;
        constexpr int I_IN = (D / 64) * (INC / 64), I_QB = (QL / 64) * (1536 / 64), I_KVB = (KVL / 64) * (2048 / 64), I_GLU = (SSMW / 64) * (SSMW / 64), I_SQ = (D / 64) * (D / 64);
        constexpr int I_UP = (D / 64) * (2 * FF / 64), I_DN = (FF / 64) * (D / 64);
#define TI_MAT(W_, K_, N_, WT_, G_) { const int nb_ = (N_) / 64, kb = r / nb_, nbi = r % nb_; d.src = (W_) + (size_t)(64 * kb) * (N_) + 64 * nbi; d.dst = (WT_) + (size_t)(64 * nbi) * (K_) + 64 * kb; \
            d.gain = (G_) + 64 * kb; d.N = (N_); d.ldk = (K_); }
#define TI_MAT8(W_, K_, N_, WT_, G_) { const int nb_ = (N_) / 32, kb = r / nb_, nbi = r % nb_; d.src = (W_) + (size_t)(128 * kb) * (N_) + 32 * nbi; d.dst = (bf16*)((unsigned char*)(WT_) + (size_t)(32 * nbi) * (K_) + 128 * kb); \
            d.gain = (G_) + 128 * kb; d.N = (N_); d.ldk = (K_); }
        auto dec_up = [&](int it) { TItem d; int r = it; const int e = r / I_UP; r -= e * I_UP; TI_MAT8(INP(31) + (size_t)e * D * 2 * FF, D, 2 * FF, WSP(unsigned char, WS_WUP) + (size_t)e * 2 * FF * D, INP(28)); return d; };
        auto dec_dn = [&](int it) { TItem d; int r = it; const int e = r / I_DN; r -= e * I_DN; TI_MAT8(INP(33) + (size_t)e * FF * D, FF, D, WSP(unsigned char, WS_WDN) + (size_t)e * D * FF, INP(28)); return d; };
        auto dec_xq = [&](int it) { TItem d; int r = it; TI_MAT8(INP(24), D, D, WSP(unsigned char, WS_WXQ8), INP(22)); return d; };
        auto dec_xo = [&](int it) { TItem d; int r = it; TI_MAT8(INP(27), D, D, WSP(unsigned char, WS_WXO8), INP(22)); return d; };
        auto dec_16 = [&](int it) { TItem d; int r = it;
            if (r < I_IN) { TI_MAT(INP(4), D, INC, WSP(bf16, WS_WIN), INP(22)); return d; } r -= I_IN;
            if (r < I_QB) { TI_MAT(INP(6), QL, 1536, WSP(bf16, WS_WQB), INP(22)); return d; } r -= I_QB;
            if (r < I_KVB) { TI_MAT(INP(8), KVL, 2048, WSP(bf16, WS_WKVB), INP(22)); return d; } r -= I_KVB;
            if (r < I_GLU) { TI_MAT(INP(17), SSMW, SSMW, WSP(bf16, WS_WGLU), INP(22)); return d; } r -= I_GLU;
            if (r < I_SQ) { TI_MAT(INP(25), D, D, WSP(bf16, WS_WXK), INP(22)); return d; } r -= I_SQ;
            if (r < I_SQ) { TI_MAT(INP(26), D, D, WSP(bf16, WS_WXV), INP(22)); return d; } r -= I_SQ;
            TI_MAT(INP(21), D, D, WSP(bf16, WS_WOUT), INP(22)); return d; };
#undef TI_MAT
#undef TI_MAT8
        if (bx < G) { s5_setup(bx, lds, INP(9), INP(10), INP(11), INP(12), INP(13), INP(14), INP(15), WSP(bf16, WS_BTY), WSP(bf16, WS_BTS), WSP(float, WS_AP32), tid); }
        else {
            const int gw = (bx - G) * NWAVES + wave, NGW = (NG - G) * NWAVES, gt = (bx - G) * NTHR + tid, NGT = (NG - G) * NTHR;
            for (int i = gt; i < D * D / 4; i += NGT) { const int row = (i * 4) / D; const f32x4 w = ((const GAS f32x4*)INP(24))[i]; const float g = INP(22)[row]; v2u o; o.x = pk2(w.x * g, w.y * g); o.y = pk2(w.z * g, w.w * g);
                ((GAS v2u*)WSP(bf16, WS_WXQN))[i] = o; }
            TSTREAM(I_SQ, dec_xo, titem8_load<false>, titem8_store<false>);
            TSTREAM(I_IN + I_QB + I_KVB + I_GLU + 3 * I_SQ, dec_16, titem_load<false>, titem_store<false>);
            for (int i = gt; i < E * D; i += NGT) { const int e = i / D, k = i % D; const float w = INP(29)[(size_t)k * E + e] * INP(28)[k]; const unsigned h = f2bf(w);
                WSP(bf16, WS_WRH)[i] = (bf16)h; WSP(bf16, WS_WRL)[i] = (bf16)f2bf(w - __builtin_bit_cast(float, h << 16)); }
            for (int i = gt; i < (INCP - INC) * D / 8; i += NGT) ((GAS v4u*)(WSP(bf16, WS_WIN) + (size_t)INC * D))[i] = (v4u){0u, 0u, 0u, 0u};
            for (int m = gw; m < T; m += NGW) rms_row_to_bf16(INP(0) + (size_t)m * D, INP(3), WSP(bf16, WS_HB) + (size_t)m * D, lane);
            for (int m = gw; m < TM; m += NGW) rms_row_to_bf16(INP(1) + (size_t)m * D, INP(23), WSP(bf16, WS_MEMN) + (size_t)m * D, lane);
        }
        if (BOTH(0)) GRID_BAR_CV();
    }
    if (IN(1)) {
        const int lane = LANE_NOW(), tid = wave * 64 + lane; (void)tid; (void)lane;
        { pg8::Geo geo{D * 2, D * 2, 128L * D * 2, 128L * D * 2, D / 64};
          pg8::Sched S; S.init(0, T / 256, INCP / 256, 1, NG, bx, WSP(bf16, WS_HB), 256L * D * 2, 0, WSP(bf16, WS_WIN), 256L * D * 2, 0);
          EpiProj Ep{WSP(bf16, WS_PROJB), WSP(bf16, WS_AG)};
          pg8::gemm_phase<EpiProj, pg8::Sched, true, true>(lds + RING_OFF, geo, S, Ep, wave); }
        { pg8::Geo geo{D * 2, D * 2, 128L * D * 2, 128L * D * 2, D / 64};
          const int c = (bx >= 224) ? bx - 224 : (1 << 30);
          pg8::Sched S; S.init(1, TM / 256, D / 256, 1, 32, c, WSP(bf16, WS_MEMN), 256L * D * 2, 0, WSP(bf16, WS_WXK), 256L * D * 2, 0);
          EpiPlain<false> Ep{WSP(bf16, WS_XK), D, 1, 0, 0, nullptr};
          pg8::gemm_phase<EpiPlain<false>, pg8::Sched, true, true>(lds + RING_OFF, geo, S, Ep, wave); }
        if (BOTH(1)) GRID_BAR_CV();
    }
    if (IN(2)) {
        const int lane = LANE_NOW(), tid = wave * 64 + lane; (void)tid; (void)lane;
        { const int gw = bx * NWAVES + wave, NGW = NG * NWAVES;
          for (int t = gw; t < T; t += NGW) mla_thin_token(t, lane, WSP(bf16, WS_PROJB), INP(5), INP(7), ((const int*)args.in[2]), WSP(bf16, WS_CQN), WSP(bf16, WS_CKVN), WSP(bf16, WS_KPE), WSP(float, WS_ROPE)); }
        __syncthreads();
        { pg8::Geo geo{AGW * 2, 512 * 2, 128L * AGW * 2, 0, 512 / 64};
          pg8::Sched S; S.init(1, 1, 1, G, NG, bx, WSP(bf16, WS_AG), 0, 256L * AGW * 2, WSP(bf16, WS_BTS), 0, 128L * 512 * 2);
          EpiS5State Ep{WSP(float, WS_SC)};
          pg8::gemm_phase<EpiS5State, pg8::Sched, true, true>(lds + RING_OFF, geo, S, Ep, wave); }
        { pg8::Geo geo{D * 2, D * 2, 128L * D * 2, 128L * D * 2, D / 64};
          const int c = (bx >= 64 && bx < 96) ? bx - 64 : (1 << 30);
          pg8::Sched S; S.init(1, TM / 256, D / 256, 1, 32, c, WSP(bf16, WS_MEMN), 256L * D * 2, 0, WSP(bf16, WS_WXV), 256L * D * 2, 0);
          EpiPlain<false, false, true> Ep{(bf16*)WSP(unsigned char, WS_XV8), D, 1, 0, 0, nullptr};
          pg8::gemm_phase<EpiPlain<false, false, true>, pg8::Sched, true, true>(lds + RING_OFF, geo, S, Ep, wave); }
        if (BOTH(2)) GRID_BAR_CV();
    }
    if (IN(3)) {
        const int lane = LANE_NOW(), tid = wave * 64 + lane; (void)tid; (void)lane;
        if (bx < 128) {
            s5_scan_group(bx >> 1, lds, WSP(float, WS_SC), WSP(float, WS_AP32), WSP(bf16, WS_AG), tid);
            pg8::Geo geo{AGW * 2, AGW * 2, 128L * AGW * 2, 128L * AGW * 2, AGW / 64};
            pg8::Sched S; S.init(1, 1, 2, G, 128, bx, WSP(bf16, WS_AG), 0, 256L * AGW * 2, WSP(bf16, WS_BTY), 256L * AGW * 2, 512L * AGW * 2);
            EpiS5Y Ep{WSP(bf16, WS_AG), INP(16), WSP(bf16, WS_Y)};
            pg8::gemm_phase<EpiS5Y, pg8::Sched, true, true>(lds + RING_OFF, geo, S, Ep, wave);
        }
        { pg8::Geo geo{KVL * 2, KVL * 2, 128L * KVL * 2, 128L * KVL * 2, KVL / 64};
          pg8::Sched S; S.init(0, T / 256, 2048 / 256, 1, NG, bx, WSP(bf16, WS_CKVN), 256L * KVL * 2, 0, WSP(bf16, WS_WKVB), 256L * KVL * 2, 0);
          EpiPlain<false> Ep{WSP(bf16, WS_KV), 2048, 1, 0, 0, nullptr};
          pg8::gemm_phase<EpiPlain<false>, pg8::Sched, true, true>(lds + RING_OFF, geo, S, Ep, wave); }
        { pg8::Geo geo{QL * 2, QL * 2, 128L * QL * 2, 128L * QL * 2, QL / 64};
          const int c = (bx >= 128) ? bx - 128 : (1 << 30);
          pg8::Sched S; S.init(0, T / 256, 1536 / 256, 1, 128, c, WSP(bf16, WS_CQN), 256L * QL * 2, 0, WSP(bf16, WS_WQB), 256L * QL * 2, 0);
          EpiPlain<false> Ep{WSP(bf16, WS_Q), 1536, 1, 0, 0, nullptr};
          pg8::gemm_phase<EpiPlain<false>, pg8::Sched, true, true>(lds + RING_OFF, geo, S, Ep, wave); }
        { pg8::Geo geo{D * 2, D * 2, 128L * D * 2, 128L * D * 2, XD / 64};
          const int c = (bx >= 128) ? bx - 128 : (1 << 30);
          pg8::Sched S; S.init(1, 1, D / 256, BATCH * XH, 128, c, WSP(bf16, WS_XK), 0, (long)MEM * D * 2, WSP(bf16, WS_WXQN), 256L * D * 2, 0);
          S.split_z(XH, XD * 2, XD * 2);
          EpiPlain<false, false, true> Ep{(bf16*)WSP(unsigned char, WS_WKT8), D, 1, 256L * D, 0, nullptr};
          pg8::gemm_phase<EpiPlain<false, false, true>, pg8::Sched, true, true>(lds + RING_OFF, geo, S, Ep, wave); }
        if (BOTH(3)) GRID_BAR_CV();
    }
    if (IN(4)) {
        const int lane = LANE_NOW(), tid = wave * 64 + lane; (void)tid; (void)lane;
        const int vcu = (NG % 8 == 0) ? (bx % 8) * (NG / 8) + bx / 8 : bx;
        if (vcu < BATCH * H * 8) { const int L = vcu, bh = L >> 3, qb = L & 7;
            mla::attn_unit(lds + RING_OFF, bh >> 3, bh & 7, qb, WSP(bf16, WS_Q), WSP(bf16, WS_KV), WSP(bf16, WS_KPE), WSP(float, WS_ROPE), WSP(bf16, WS_ATTO), wave); }
        { const int qb = vcu & 7, c = (vcu < 256 && qb >= 4) ? (vcu >> 3) * 4 + (qb - 4) : (1 << 30);
          pg8::Geo geo{SSMW * 2, SSMW * 2, 128L * SSMW * 2, 128L * SSMW * 2, SSMW / 64};
          pg8::Sched S; S.init(1, T / 256, SSMW / 256, 1, 128, c, WSP(bf16, WS_Y), 256L * SSMW * 2, 0, WSP(bf16, WS_WGLU), 256L * SSMW * 2, 0);
          EpiGlu Ep{WSP(bf16, WS_Y), INP(18), WSP(bf16, WS_SSMO)};
          pg8::gemm_phase<EpiGlu, pg8::Sched, true, true>(lds + RING_OFF, geo, S, Ep, wave); }
        { const int qb = vcu & 7, c = (vcu < 256 && qb < 4) ? (vcu >> 3) * 4 + qb : (1 << 30);
          pg8::Geo geo{D, D, 128L * D, 128L * D, XD / 128};
          pg8::Sched S; S.init(1, D / 256, TM / 256, XH, 128, c, WSP(unsigned char, WS_WXO8), 256L * D, (long)XD, WSP(unsigned char, WS_XV8), 256L * D, (long)XD);
          EpiVW Ep{WSP(bf16, WS_VWT)};
          pg8::gemm_phase<EpiVW, pg8::Sched, true, true>(lds + RING_OFF, geo, S, Ep, wave); }
        if (BOTH(4)) GRID_BAR_CV();
    }
    if (IN(5)) {
        const int lane = LANE_NOW(), tid = wave * 64 + lane; (void)tid; (void)lane;
        const int gw = bx * NWAVES + wave, NGW = NG * NWAVES;
        for (int t = gw; t < T; t += NGW) {
#pragma unroll
            for (int half = 0; half < 2; ++half) { const bf16* src = (half ? WSP(bf16, WS_SSMO) : WSP(bf16, WS_ATTO)) + (size_t)t * 1024; const float* gn = half ? INP(20) : INP(19);
                const v4u a = ((const v4u*)src)[lane], b = ((const v4u*)src)[64 + lane];
                f32x4 gpre[4];
#pragma unroll
                for (int jj = 0; jj < 2; ++jj) { const int k0 = (jj * 64 + lane) * 8; gpre[2 * jj] = *(const f32x4*)(gn + k0); gpre[2 * jj + 1] = *(const f32x4*)(gn + k0 + 4); }
                float v[16] = {bflo(a.x), bfhi(a.x), bflo(a.y), bfhi(a.y), bflo(a.z), bfhi(a.z), bflo(a.w), bfhi(a.w), bflo(b.x), bfhi(b.x), bflo(b.y), bfhi(b.y), bflo(b.z), bfhi(b.z), bflo(b.w), bfhi(b.w)};
                float s = 0.f;
#pragma unroll
                for (int e = 0; e < 16; ++e) s += v[e] * v[e];
                const float r = rsqrtf(wave_sum(s) * (1.f / 1024) + EPS);
#pragma unroll
                for (int jj = 0; jj < 2; ++jj) { const int k0 = (jj * 64 + lane) * 8; const f32x4 g0 = gpre[2 * jj], g1 = gpre[2 * jj + 1]; v4u w;
                    w.x = pk2(v[8 * jj + 0] * r * g0[0], v[8 * jj + 1] * r * g0[1]); w.y = pk2(v[8 * jj + 2] * r * g0[2], v[8 * jj + 3] * r * g0[3]);
                    w.z = pk2(v[8 * jj + 4] * r * g1[0], v[8 * jj + 5] * r * g1[1]); w.w = pk2(v[8 * jj + 6] * r * g1[2], v[8 * jj + 7] * r * g1[3]);
                    *(v4u*)(WSP(bf16, WS_MIXED) + (size_t)t * D + half * 1024 + k0) = w; } } }
        if (BOTH(5)) GRID_BAR_CV();
#if defined(PROBE_BAR)
        if (BOTH(5)) { for (int i_ = 0; i_ < 10; ++i_) GRID_BAR(); }
#endif
    }
    if (IN(6)) {
        const int lane = LANE_NOW(), tid = wave * 64 + lane; (void)tid; (void)lane;
        pg8::Geo geo{D * 2, D * 2, 128L * D * 2, 128L * D * 2, D / 64};
        pg8::Sched S; S.init(0, T / 256, D / 256, 1, NG, bx, WSP(bf16, WS_MIXED), 256L * D * 2, 0, WSP(bf16, WS_WOUT), 256L * D * 2, 0);
        EpiResid<> Ep{INP(0), WSP(float, WS_X1), nullptr, WSP(float, WS_SSQP1), WSP(unsigned char, WS_X1F8)};
        pg8::gemm_phase<EpiResid<>, pg8::Sched, true, true>(lds + RING_OFF, geo, S, Ep, wave);
        if (BOTH(6)) GRID_BAR_CV();
    }
    if (IN(7)) {
        const int lane = LANE_NOW(), tid = wave * 64 + lane; (void)tid; (void)lane;
        pg8::Geo geo{D, D, 128L * D, 128L * D, D / 128};
        const int c7 = (NG == 256 && (bx >> 3) < 16) ? (bx & 7) * 16 + (bx >> 3) : (NG == 256 ? (1 << 30) : bx);
        pg8::Sched S; S.init(1, SEQ / 256, XH, BATCH, NG, c7, WSP(unsigned char, WS_X1F8), 256L * D, (long)SEQ * D, WSP(unsigned char, WS_WKT8), 256L * D, (long)XH * MEM * D);
        LAS float* rt = (LAS float*)(lds + TOK_OFF);
        { pg8::Unit u0; if (S.next(0, u0) && tid < 256) { const float* pp = WSP(float, WS_SSQP1) + (size_t)((u0.z * (SEQ / 256) + u0.pm) * 256 + tid) * 32; float sq = 0.f;
#pragma unroll
                for (int k = 0; k < 8; ++k) { const f32x4 v = *(const f32x4*)(pp + 4 * k); sq += v[0]; sq += v[1]; sq += v[2]; sq += v[3]; }
                rt[tid] = rsqrtf(sq * (1.f / D) + EPS); }
            __syncthreads(); }
        EpiSoftmax<true> Ep{WSP(bf16, WS_PX), rt};
        pg8::gemm_phase<EpiSoftmax<true>, pg8::Sched, false, true>(lds + RING_OFF, geo, S, Ep, wave);
        if (BOTH(7)) GRID_BAR_CV();
    }
    if (IN(10)) {
        const int lane = LANE_NOW(), tid = wave * 64 + lane; (void)tid; (void)lane;
        constexpr int PK = XH * MEM;
        pg8::Geo geo{PK, PK, 128L * PK, 128L * PK, PK / 128};
        const int c10 = (NG % 8 == 0) ? (bx % 8) * (NG / 8) + bx / 8 : bx;
        pg8::Sched S; S.init(1, SEQ / 256, D / 256, BATCH, NG, c10, WSP(unsigned char, WS_PX), 256L * PK, (long)SEQ * PK, WSP(unsigned char, WS_VWT), 256L * PK, (long)D * PK);
        EpiResid<true> Ep{WSP(float, WS_X1), WSP(float, WS_X2), nullptr, WSP(float, WS_SSQP2), WSP(unsigned char, WS_X2F8), SEQ / 256};
        pg8::gemm_phase<EpiResid<true>, pg8::Sched, true, true>(lds + RING_OFF, geo, S, Ep, wave);
        if (BOTH(10)) GRID_BAR_CV();
    }
    if (IN(11)) {
        const int lane = LANE_NOW(), tid = wave * 64 + lane; (void)tid; (void)lane;
        for (int tile = bx; tile < T / 32; tile += NG)
            route_tile(tile, lds, WSP(float, WS_X2), WSP(float, WS_SSQP2), WSP(float, WS_RSTD2), WSP(bf16, WS_WRH), WSP(bf16, WS_WRL), INP(30), PRB(ctl + CW_CNT, unsigned*), PRB(WSP(int, WS_SELE), int*), PRB(WSP(int, WS_SELP), int*), PRB(WSP(float, WS_SELG), float*), PRB(WSP(int, WS_LIST), int*) + (args.li == 1 ? (1 << 20) : 0), tid);
        cv_flush(cvw);
        if (BOTH(11)) GRID_BAR();
    }
    if (IN(12)) {
        const int lane = LANE_NOW(), tid = wave * 64 + lane; (void)tid; (void)lane;
        LAS int* blkE = (LAS int*)(lds + BLK_OFF); LAS int* tokTab = (LAS int*)(lds + TOK_OFF);
        const unsigned* counts = ctl + CW_CNT;
        const int NBt = moe_block_table(counts, blkE, tid);
        { int tokv[MAXU / 2];
#pragma unroll
          for (int k = 0; k < MAXU / 2; ++k) { const int i = 2 * k + (tid >> 8), L = i * NG + bx, r = tid & 255; int v = 0;
              if (L < NBt * 16) { const int blk = L >> 4, e = blkE[blk], j = blkE[160 + blk]; if (r < blkE[320 + blk]) v = WSP(int, WS_LIST)[(size_t)e * T + j * 256 + r]; }
              tokv[k] = v; }
#pragma unroll
          for (int k = 0; k < MAXU / 2; ++k) tokTab[(2 * k + (tid >> 8)) * 256 + (tid & 255)] = tokv[k]; }
        __syncthreads();
        pg8::Geo geo{D, D, 0, (long)FF * D, D / 128};
        MoeSchedUpCv S{{NBt, 16, NG, bx, D, (const char*)WSP(unsigned char, WS_X2F8), (const char*)WSP(unsigned char, WS_WUP), 0, (long)2 * FF * D, 128L * D, blkE, tokTab}, INP(33), WSP(unsigned char, WS_WDN), wave};
        EpiMoeUp Ep{blkE, tokTab, WSP(float, WS_RSTD2), INP(32), WSP(unsigned char, WS_ACT)};
        pg8::gemm_phase<EpiMoeUp, MoeSchedUpCv, true, true>(lds + RING_OFF, geo, S, Ep, wave);
        if (BOTH(12)) GRID_BAR();
    }
    if (IN(13)) {
        const int lane = LANE_NOW(), tid = wave * 64 + lane; (void)tid; (void)lane;
        LAS int* blkE = (LAS int*)(lds + BLK_OFF);
        __syncthreads();
        const int NBt = moe_block_table(ctl + CW_CNT, blkE, tid);
        pg8::Geo geo{FF, FF, 128L * FF, 128L * FF, FF / 128};
        MoeSched<false> S{NBt, 8, NG, bx, FF, (const char*)WSP(unsigned char, WS_ACT), (const char*)WSP(unsigned char, WS_WDN), 256L * FF, (long)D * FF, 256L * FF, blkE, nullptr};
        EpiMoeDown Ep{blkE, INP(34), WSP(unsigned char, WS_YK)};
        pg8::gemm_phase<EpiMoeDown, MoeSched<false>, true, true>(lds + RING_OFF, geo, S, Ep, wave);
        if (BOTH(13)) GRID_BAR();
    }
    if (IN(14)) {
        const int lane = LANE_NOW(), tid = wave * 64 + lane; (void)tid; (void)lane;
        const int gw = bx * NWAVES + wave, NGW = NG * NWAVES;
        const unsigned* counts = ctl + CW_CNT;
        int pb = 0;
        { const int nb = (lane < E) ? (((int)counts[(lane & 31) * CNT_STRIDE] + 255) >> 8) : 0; int inc = nb;
#pragma unroll
          for (int o = 1; o < 32; o <<= 1) { const int v = __shfl_up(inc, o); if ((lane & 31) >= o) inc += v; }
          pb = inc - nb; }
        const float* X2 = WSP(float, WS_X2); const unsigned char* YK = WSP(unsigned char, WS_YK); const float* fn = INP(35); float* out = args.out;
        f32x4 fg[8];
#pragma unroll
        for (int j = 0; j < 8; ++j) fg[j] = *(const f32x4*)(fn + (j * 64 + lane) * 4);
        for (int t = gw; t < T; t += NGW) {
            size_t so[TOPK]; float gk[TOPK];
#pragma unroll
            for (int k = 0; k < TOPK; ++k) { const int e = WSP(int, WS_SELE)[t * TOPK + k], p = WSP(int, WS_SELP)[t * TOPK + k]; gk[k] = WSP(float, WS_SELG)[t * TOPK + k] * Y8_INV;
                so[k] = ((size_t)__shfl(pb, e) * 256 + p) * D; }
            f32x4 v[8]; float s = 0.f;
#pragma unroll
            for (int j = 0; j < 8; ++j) { const int cidx = (j * 64 + lane) * 4; f32x4 a = *(const f32x4*)(X2 + (size_t)t * D + cidx);
#pragma unroll
                for (int k = 0; k < TOPK; ++k) { const unsigned y = *(const unsigned*)(YK + so[k] + cidx); const v2f lo = __builtin_amdgcn_cvt_pk_f32_fp8(y, false), hi = __builtin_amdgcn_cvt_pk_f32_fp8(y, true);
                    a[0] += gk[k] * lo[0]; a[1] += gk[k] * lo[1]; a[2] += gk[k] * hi[0]; a[3] += gk[k] * hi[1]; }
                v[j] = a; s += (a[0] * a[0] + a[1] * a[1]) + (a[2] * a[2] + a[3] * a[3]); }
            const float r = rsqrtf(wave_sum(s) * (1.f / D) + EPS);
#pragma unroll
            for (int j = 0; j < 8; ++j) { const int cidx = (j * 64 + lane) * 4; *(f32x4*)(out + (size_t)t * D + cidx) = v[j] * r * fg[j]; }
        }
    }
#if defined(PROBE_READ)
    if (IN(15)) {
        const int lane = LANE_NOW(), tid = wave * 64 + lane; (void)tid; (void)lane;
        const int gw = bx * NWAVES + wave, NGW = NG * NWAVES;
        constexpr int I_UP = (D / 64) * (2 * FF / 64), I_DN = (FF / 64) * (D / 64);
        f32x4 sum = {0.f, 0.f, 0.f, 0.f};
#define TI_MAT8(W_, K_, N_, WT_, G_) { const int nb_ = (N_) / 64, kb = r / nb_, nbi = r % nb_; d.src = (W_) + (size_t)(64 * kb) * (N_) + 64 * nbi; d.dst = (bf16*)((unsigned char*)(WT_) + (size_t)(64 * nbi) * (K_) + 64 * kb); \
            d.gain = (G_) + 64 * kb; d.N = (N_); d.ldk = (K_); }
        auto dec_up = [&](int it) { TItem d; int r = it; const int e = r / I_UP; r -= e * I_UP; TI_MAT8(INP(31) + (size_t)e * D * 2 * FF, D, 2 * FF, WSP(unsigned char, WS_WUP) + (size_t)e * 2 * FF * D, INP(28)); return d; };
        auto dec_dn = [&](int it) { TItem d; int r = it; const int e = r / I_DN; r -= e * I_DN; TI_MAT8(INP(33) + (size_t)e * FF * D, FF, D, WSP(unsigned char, WS_WDN) + (size_t)e * D * FF, INP(28)); return d; };
#undef TI_MAT8
#define PR_STORE(d_, lane_, r_, g_) do { _Pragma("unroll") for (int j_ = 0; j_ < 16; ++j_) sum += r_[j_]; } while (0)
        TSTREAM(E * I_UP, dec_up, titem8_load<false>, PR_STORE);
        TSTREAM(E * I_DN, dec_dn, titem8_load<false>, PR_STORE);
#undef PR_STORE
        *(f32x4*)(ws + WS_END1 + (16u << 20) + ((size_t)gw * 64 + lane) * 16) = sum;
    }
#endif
#undef IN
#undef BOTH
#undef GRID_BAR
}

extern "C" void kernel_launch(void* const* d_in, const int* in_sizes, int n_in, void* d_out, int out_size, void* d_ws, size_t ws_size, hipStream_t stream) {
    static int grid = 0;
    if (grid == 0) {
        if (n_in != 36 || out_size != T * D || ws_size < WS_END1) { fprintf(stderr, "kernel_launch: built for 36 inputs, %d outputs, >= %zu bytes of workspace; got %d, %d, %zu; nothing launched\n", T * D, (size_t)WS_END1, n_in, out_size, ws_size); grid = -1; return; }
        int dev = 0, cus = 0, per_cu = 0;
        if (hipGetDevice(&dev) != hipSuccess || hipDeviceGetAttribute(&cus, hipDeviceAttributeMultiprocessorCount, dev) != hipSuccess) { fprintf(stderr, "kernel_launch: device query failed\n"); grid = -1; return; }
        if (hipFuncSetAttribute((const void*)fwd, hipFuncAttributeMaxDynamicSharedMemorySize, LDS_BYTES) != hipSuccess) { fprintf(stderr, "kernel_launch: hipFuncSetAttribute failed\n"); grid = -1; return; }
        if (hipOccupancyMaxActiveBlocksPerMultiprocessor(&per_cu, (const void*)fwd, NTHR, LDS_BYTES) != hipSuccess || per_cu < 1) fprintf(stderr, "kernel_launch: occupancy query reports %d\n", per_cu);
        (void)hipGetLastError();
        grid = 256;
        if (cus < 256) { fprintf(stderr, "kernel_launch: %d CUs < 256: the grid would not be resident; nothing launched\n", cus); grid = -1; return; }
    }
    if (grid < 0) return;
    (void)hipMemsetAsync((char*)d_ws + WS_CTL, 0, CTL_ZERO_BYTES, stream);
    Args a{};
    for (int i = 0; i < 36; ++i) a.in[i] = d_in[i];
    a.out = (float*)d_out; a.ws = (unsigned char*)d_ws;
#if defined(PROBE_RANGE)
    a.ph_lo = 0; a.ph_hi = PROBE_RANGE_HI; a.li = 0; hipLaunchKernelGGL(fwd, dim3(grid), dim3(NTHR), LDS_BYTES, stream, a);
    a.ph_lo = PROBE_RANGE_LO; a.ph_hi = PROBE_RANGE_HI; a.li = 1; hipLaunchKernelGGL(fwd, dim3(grid), dim3(NTHR), LDS_BYTES, stream, a);
    a.ph_lo = PROBE_RANGE_HI; a.ph_hi = N_PHASES; a.li = 2; hipLaunchKernelGGL(fwd, dim3(grid), dim3(NTHR), LDS_BYTES, stream, a);
#elif defined(PROBE_READ)
    a.ph_lo = 0; a.ph_hi = N_PHASES; a.li = 0; hipLaunchKernelGGL(fwd, dim3(grid), dim3(NTHR), LDS_BYTES, stream, a);
    a.ph_lo = 15; a.ph_hi = 16; a.li = 1; hipLaunchKernelGGL(fwd, dim3(grid), dim3(NTHR), LDS_BYTES, stream, a);
#elif defined(PROBE_PHASE)
    a.ph_lo = 0; a.ph_hi = PROBE_PHASE + 1; a.li = 0; hipLaunchKernelGGL(fwd, dim3(grid), dim3(NTHR), LDS_BYTES, stream, a);
    a.ph_lo = PROBE_PHASE; a.ph_hi = PROBE_PHASE + 1; a.li = 1; hipLaunchKernelGGL(fwd, dim3(grid), dim3(NTHR), LDS_BYTES, stream, a);
    if (PROBE_PHASE + 1 < N_PHASES) { a.ph_lo = PROBE_PHASE + 1; a.ph_hi = N_PHASES; a.li = 2; hipLaunchKernelGGL(fwd, dim3(grid), dim3(NTHR), LDS_BYTES, stream, a); }
#else
    a.ph_lo = 0; a.ph_hi = N_PHASES;
    hipLaunchKernelGGL(fwd, dim3(grid), dim3(NTHR), LDS_BYTES, stream, a);
#endif
}
```
